# Optimizing an MI355X kernel written in HIP

```python
import math
import jax, jax.numpy as jnp
from jax import lax
import numpy as np

D_MODEL = 1024
BATCH = 8
SEQ = 2048
DEPTH = 2

N_MEM = 256
NORM_EPS = 1e-6
NEG_INF = -1e30
ATTN_BLOCK = 128

LRU_WIDTH = 1024
LRU_BLOCKS = 16
LRU_BLOCK_DIM = LRU_WIDTH // LRU_BLOCKS
CONV_WIDTH = 4
LRU_C = 8.0
LRU_A_MIN = 0.9
LRU_A_MAX = 0.999

DIL_GROUPS = ((128, 1), (512, 4), (2048, 16))
DIL_HEADS = 4
DIL_HEAD_DIM = 128
DIL_WIDTH = DIL_HEADS * DIL_HEAD_DIM
DIL_QKV = len(DIL_GROUPS) * DIL_WIDTH

MEM_HEADS = 4
MEM_HEAD_DIM = 64
MEM_WIDTH = MEM_HEADS * MEM_HEAD_DIM

NSA_HEADS = 16
NSA_KV_GROUPS = 2
NSA_HEADS_PER_GROUP = NSA_HEADS // NSA_KV_GROUPS
NSA_HEAD_DIM = 64
NSA_WIDTH = NSA_HEADS * NSA_HEAD_DIM
NSA_KV = NSA_KV_GROUPS * NSA_HEAD_DIM
CMP_BLOCK = 32
CMP_STRIDE = 16
SLC_BLOCK = 64
SLC_TOP_N = 8
WIN_SIZE = 512
PHI_HIDDEN = 256
SEL_FORCE = 1e6

N_EVEN = (DEPTH + 1) // 2
N_ODD = DEPTH // 2

HAWK_IN_SPLITS = (LRU_WIDTH, LRU_WIDTH, DIL_QKV, DIL_QKV, DIL_QKV, DIL_WIDTH, MEM_WIDTH, MEM_WIDTH)
HAWK_IN = sum(HAWK_IN_SPLITS)
HAWK_OUT = LRU_WIDTH + DIL_WIDTH + MEM_WIDTH
NSA_IN_SPLITS = (NSA_WIDTH, 6 * NSA_KV, 3 * NSA_HEADS, NSA_WIDTH, MEM_WIDTH, MEM_WIDTH)
NSA_IN = sum(NSA_IN_SPLITS)
NSA_OUT = NSA_WIDTH + MEM_WIDTH

kernel_name = "hybrid_rglru_dilated_nsa_memory"


def rms_norm(x, g):
    xf = x.astype(jnp.float32)
    y = xf * lax.rsqrt(jnp.mean(xf * xf, axis=-1, keepdims=True) + NORM_EPS)
    return (y * g.astype(jnp.float32)).astype(x.dtype)


def split_cols(h, sizes):
    return jnp.split(h, np.cumsum(sizes)[:-1].tolist(), axis=-1)


def alibi_slopes(n):
    return np.exp2(-8.0 * np.arange(1, n + 1) / n).astype(np.float32)


def banded_attention(q, k, v, slopes, max_dist, pos_scale):
    n, g, r, length, hd = q.shape
    blk = ATTN_BLOCK
    nb = -(-length // blk)
    pad_end = nb * blk - length
    p = -(-max_dist // blk)
    width = (p + 1) * blk
    q = jnp.pad(q, ((0, 0), (0, 0), (0, 0), (0, pad_end), (0, 0)))
    k = jnp.pad(k, ((0, 0), (0, 0), (p * blk, pad_end), (0, 0))).reshape(n, g, nb + p, blk, hd)
    v = jnp.pad(v, ((0, 0), (0, 0), (p * blk, pad_end), (0, 0))).reshape(n, g, nb + p, blk, hd)
    k_win = jnp.concatenate([k[:, :, i:i + nb] for i in range(p + 1)], axis=3).transpose(2, 0, 1, 3, 4)
    v_win = jnp.concatenate([v[:, :, i:i + nb] for i in range(p + 1)], axis=3).transpose(2, 0, 1, 3, 4)
    q_blk = q.reshape(n, g, r, nb, blk, hd).transpose(3, 0, 1, 2, 4, 5)
    dist = p * blk + np.arange(blk)[:, None] - np.arange(width)[None, :]
    key_idx = (np.arange(nb)[:, None] - p) * blk + np.arange(width)[None, :]
    valid = (dist >= 0)[None] & (dist <= max_dist)[None] & (key_idx >= 0)[:, None, :]
    bias = -(slopes[:, :, None, None] * (dist * pos_scale).astype(np.float32)[None, None])
    scale = hd ** -0.5

    def one_block(args):
        qb, kb, vb, ok = args
        s = jnp.einsum('ngrqd,ngkd->ngrqk', qb, kb, preferred_element_type=jnp.float32) * scale + bias
        s = jnp.where(ok, s, NEG_INF)
        m = jnp.max(s, axis=-1, keepdims=True)
        e = jnp.exp(s - m)
        den = jnp.sum(e, axis=-1, keepdims=True)
        o = jnp.einsum('ngrqk,ngkd->ngrqd', (e / den).astype(vb.dtype), vb,
                       preferred_element_type=jnp.float32)
        return o.astype(qb.dtype), (m + jnp.log(den))[..., 0]

    o, lse = lax.map(one_block, (q_blk, k_win, v_win, jnp.asarray(valid)))
    o = o.transpose(1, 2, 3, 0, 4, 5).reshape(n, g, r, nb * blk, hd)[:, :, :, :length]
    lse = lse.transpose(1, 2, 3, 0, 4).reshape(n, g, r, nb * blk)[..., :length]
    return o, lse


def dilated_attention(q, k, v):
    b, s, _, hd = q.shape
    slopes_all = alibi_slopes(len(DIL_GROUPS) * DIL_HEADS).reshape(len(DIL_GROUPS), DIL_HEADS)
    outs, lses = [], []
    for gi, (window, dil) in enumerate(DIL_GROUPS):
        sub = s // dil

        def to_sub(t):
            t = t[:, :, gi * DIL_HEADS:(gi + 1) * DIL_HEADS]
            return t.reshape(b, sub, dil, DIL_HEADS, hd).transpose(0, 2, 3, 1, 4).reshape(
                b * dil, DIL_HEADS, sub, hd)

        o, lse = banded_attention(to_sub(q)[:, :, None], to_sub(k), to_sub(v),
                                  slopes_all[gi][:, None], window // dil, dil)
        outs.append(o[:, :, 0].reshape(b, dil, DIL_HEADS, sub, hd).transpose(0, 3, 1, 2, 4).reshape(
            b, s, DIL_HEADS, hd))
        lses.append(lse[:, :, 0].reshape(b, dil, DIL_HEADS, sub).transpose(0, 3, 1, 2).reshape(
            b, s, DIL_HEADS))
    w = jax.nn.softmax(jnp.stack(lses, axis=0), axis=0)
    o = jnp.einsum('gbsh,gbshd->bshd', w, jnp.stack(outs, axis=0).astype(jnp.float32))
    return o.astype(q.dtype)


def causal_depthwise_conv(x, w, bias):
    y = lax.conv_general_dilated(x, w[:, None, :], window_strides=(1,),
                                 padding=((CONV_WIDTH - 1, 0),),
                                 dimension_numbers=('NWC', 'WIO', 'NWC'),
                                 feature_group_count=x.shape[-1])
    return y + bias


def rg_lru(x, gate_a_w, gate_a_b, gate_x_w, gate_x_b, lam):
    b, s, w = x.shape
    xb = x.reshape(b, s, LRU_BLOCKS, LRU_BLOCK_DIM)
    r = jax.nn.sigmoid((jnp.einsum('bshi,hij->bshj', xb, gate_a_w) + gate_a_b).astype(jnp.float32)).reshape(b, s, w)
    i = jax.nn.sigmoid((jnp.einsum('bshi,hij->bshj', xb, gate_x_w) + gate_x_b).astype(jnp.float32)).reshape(b, s, w)
    log_a = -LRU_C * r * jax.nn.softplus(-lam.astype(jnp.float32))
    a = jnp.exp(log_a)
    mult = jnp.sqrt(-jnp.expm1(2.0 * log_a))
    mult = jnp.where((jnp.arange(s) == 0)[None, :, None], 1.0, mult)
    u = x.astype(jnp.float32) * i * mult

    def combine(c1, c2):
        a1, b1 = c1
        a2, b2 = c2
        return a1 * a2, a2 * b1 + b2

    _, h = lax.associative_scan(combine, (a, u), axis=1)
    return h.astype(x.dtype)


def memory_attention(q, mem_n, w_mem_kv):
    b, s, _ = q.shape
    k, v = jnp.split(mem_n @ w_mem_kv, 2, axis=-1)
    q = q.reshape(b, s, MEM_HEADS, MEM_HEAD_DIM)
    k = k.reshape(b, -1, MEM_HEADS, MEM_HEAD_DIM)
    v = v.reshape(b, -1, MEM_HEADS, MEM_HEAD_DIM)
    sc = jnp.einsum('bshd,bmhd->bhsm', q, k, preferred_element_type=jnp.float32) * MEM_HEAD_DIM ** -0.5
    p = jax.nn.softmax(sc, axis=-1)
    o = jnp.einsum('bhsm,bmhd->bshd', p.astype(v.dtype), v)
    return o.reshape(b, s, MEM_WIDTH)


def hawk_dilated_layer(x, mem, norm_g, w_in, conv_w, conv_b, ga_w, ga_b, gx_w, gx_b, lam,
                       mem_norm_g, w_mem_kv, w_out):
    b, s, _ = x.shape
    h = rms_norm(x, norm_g) @ w_in
    xa, za, q, k, v, zb, qm, zm = split_cols(h, HAWK_IN_SPLITS)
    ya = rg_lru(causal_depthwise_conv(xa, conv_w, conv_b), ga_w, ga_b, gx_w, gx_b, lam)
    nh = len(DIL_GROUPS) * DIL_HEADS
    shp = (b, s, nh, DIL_HEAD_DIM)
    yb = dilated_attention(q.reshape(shp), k.reshape(shp), v.reshape(shp)).reshape(b, s, DIL_WIDTH)
    ym = memory_attention(qm, rms_norm(mem, mem_norm_g), w_mem_kv)
    y = jnp.concatenate([ya * jax.nn.silu(za), yb * jax.nn.silu(zb), ym * jax.nn.silu(zm)], axis=-1)
    return x + (y.astype(x.dtype) @ w_out)


def compress_tokens(t, pe, w1, w2):
    s, hd = t.shape[2], t.shape[3]
    n_cmp = (s - CMP_BLOCK) // CMP_STRIDE + 1
    idx = np.arange(n_cmp)[:, None] * CMP_STRIDE + np.arange(CMP_BLOCK)[None, :]
    blocks = t[:, :, idx] + pe
    flat = blocks.reshape(blocks.shape[0], blocks.shape[1], n_cmp, CMP_BLOCK * hd)
    return jax.nn.silu(flat @ w1) @ w2


def compressed_attention(q, k, v, slopes):
    s, hd = q.shape[3], q.shape[4]
    n_cmp = k.shape[2]
    block_end = np.arange(n_cmp) * CMP_STRIDE + CMP_BLOCK - 1
    dist = (np.arange(s)[:, None] - block_end[None, :]).astype(np.float32)
    visible = dist >= 0
    bias = -jnp.asarray(slopes)[:, :, None, None] * jnp.asarray(dist)
    sc = jnp.einsum('bgrsd,bgnd->bgrsn', q, k, preferred_element_type=jnp.float32) * hd ** -0.5 + bias
    sc = jnp.where(visible, sc, NEG_INF)
    p = jax.nn.softmax(sc, axis=-1) * visible.any(axis=-1, keepdims=True).astype(np.float32)
    o = jnp.einsum('bgrsn,bgnd->bgrsd', p.astype(v.dtype), v)
    return o, p


def selected_attention(q, k, v, p_cmp, slopes):
    b, g, r, s, hd = q.shape
    n_slc = s // SLC_BLOCK
    top_n = min(SLC_TOP_N, n_slc)
    n_cmp = p_cmp.shape[-1]
    c_start = np.arange(n_cmp)[:, None] * CMP_STRIDE
    s_start = np.arange(n_slc)[None, :] * SLC_BLOCK
    overlap = ((c_start < s_start + SLC_BLOCK) & (c_start + CMP_BLOCK > s_start)).astype(np.float32)
    imp = jnp.einsum('bgrsn,nj->bgsj', p_cmp, overlap)
    cur = (np.arange(s) // SLC_BLOCK)[:, None]
    j = np.arange(n_slc)[None, :]
    forced = (j == 0) | (j == cur) | (j == cur - 1)
    imp = jnp.where(forced, SEL_FORCE, jnp.where(j > cur, -SEL_FORCE, imp))
    _, sel = lax.top_k(imp, top_n)
    nqb = s // ATTN_BLOCK
    k_blocks = k.reshape(b, g, n_slc, SLC_BLOCK, hd)
    v_blocks = v.reshape(b, g, n_slc, SLC_BLOCK, hd)
    q_blk = q.reshape(b, g, r, nqb, ATTN_BLOCK, hd).transpose(3, 0, 1, 2, 4, 5)
    sel_blk = sel.reshape(b, g, nqb, ATTN_BLOCK, top_n).transpose(2, 0, 1, 3, 4)
    qpos_blk = jnp.arange(s, dtype=jnp.int32).reshape(nqb, ATTN_BLOCK)
    bi = jnp.arange(b)[:, None, None]
    gi = jnp.arange(g)[None, :, None]
    slope_b = jnp.asarray(slopes)[None, :, :, None, None]
    n_keys = top_n * SLC_BLOCK

    def one_block(args):
        qb, ib, qpos = args
        flat = ib.reshape(b, g, ATTN_BLOCK * top_n)
        kg = k_blocks[bi, gi, flat].reshape(b, g, ATTN_BLOCK, n_keys, hd)
        vg = v_blocks[bi, gi, flat].reshape(b, g, ATTN_BLOCK, n_keys, hd)
        kpos = (ib[..., None] * SLC_BLOCK + jnp.arange(SLC_BLOCK)).reshape(b, g, ATTN_BLOCK, n_keys)
        dist = (qpos[None, None, :, None] - kpos)[:, :, None]
        sc = jnp.einsum('bgrqd,bgqkd->bgrqk', qb, kg, preferred_element_type=jnp.float32) * hd ** -0.5
        sc = jnp.where(dist >= 0, sc - slope_b * dist.astype(jnp.float32), NEG_INF)
        p = jax.nn.softmax(sc, axis=-1)
        return jnp.einsum('bgrqk,bgqkd->bgrqd', p.astype(vg.dtype), vg)

    o = lax.map(one_block, (q_blk, sel_blk, qpos_blk))
    return o.transpose(1, 2, 3, 0, 4, 5).reshape(b, g, r, s, hd)


def nsa_layer(x, mem, norm_g, w_in, pe_k, pe_v, phik_w1, phik_w2, phiv_w1, phiv_w2,
              mem_norm_g, w_mem_kv, w_out):
    b, s, _ = x.shape
    g, r, hd = NSA_KV_GROUPS, NSA_HEADS_PER_GROUP, NSA_HEAD_DIM
    h = rms_norm(x, norm_g) @ w_in
    q, kv, gate_logits, z, qm, zm = split_cols(h, NSA_IN_SPLITS)
    q = q.reshape(b, s, g, r, hd).transpose(0, 2, 3, 1, 4)
    kc, vc, ks, vs, kw, vw = [t.reshape(b, s, g, hd).transpose(0, 2, 1, 3)
                              for t in jnp.split(kv, 6, axis=-1)]
    slopes = alibi_slopes(NSA_HEADS).reshape(g, r)
    k_cmp = compress_tokens(kc, pe_k, phik_w1, phik_w2)
    v_cmp = compress_tokens(vc, pe_v, phiv_w1, phiv_w2)
    o_cmp, p_cmp = compressed_attention(q, k_cmp, v_cmp, slopes)
    o_slc = selected_attention(q, ks, vs, p_cmp, slopes)
    o_win, _ = banded_attention(q, kw, vw, slopes, WIN_SIZE - 1, 1)
    gates = jax.nn.sigmoid(gate_logits.astype(jnp.float32)).reshape(b, s, g, r, 3).transpose(0, 2, 3, 1, 4)
    o = gates[..., 0:1] * o_cmp + gates[..., 1:2] * o_slc + gates[..., 2:3] * o_win
    o = o.transpose(0, 3, 1, 2, 4).reshape(b, s, NSA_WIDTH).astype(x.dtype)
    ym = memory_attention(qm, rms_norm(mem, mem_norm_g), w_mem_kv)
    y = jnp.concatenate([o * jax.nn.silu(z), ym * jax.nn.silu(zm)], axis=-1)
    return x + (y.astype(x.dtype) @ w_out)


def setup_inputs(seed: int = 0) -> dict:
    key = jax.random.key(seed)
    keys = iter(jax.random.split(key, 40))

    def nrm(shape, scale):
        return jax.random.normal(next(keys), shape, jnp.float32) * scale

    def gain(shape):
        return 1.0 + 0.02 * jax.random.normal(next(keys), shape, jnp.float32)

    x = nrm((BATCH, SEQ, D_MODEL), 1.0)
    mem = nrm((BATCH, N_MEM, D_MODEL), 1.0)
    u = jax.random.uniform(next(keys), (N_EVEN, LRU_WIDTH), jnp.float32, LRU_A_MIN, LRU_A_MAX)
    a_base = u ** (1.0 / LRU_C)
    hawk_lambda = jnp.log(a_base) - jnp.log1p(-a_base)
    phi_in = CMP_BLOCK * NSA_HEAD_DIM
    return {
        "x": x,
        "mem": mem,
        "hawk_norm": gain((N_EVEN, D_MODEL)),
        "hawk_w_in": nrm((N_EVEN, D_MODEL, HAWK_IN), D_MODEL ** -0.5),
        "hawk_conv_w": nrm((N_EVEN, CONV_WIDTH, LRU_WIDTH), CONV_WIDTH ** -0.5),
        "hawk_conv_b": nrm((N_EVEN, LRU_WIDTH), 0.02),
        "hawk_gate_a_w": nrm((N_EVEN, LRU_BLOCKS, LRU_BLOCK_DIM, LRU_BLOCK_DIM), LRU_BLOCK_DIM ** -0.5),
        "hawk_gate_a_b": nrm((N_EVEN, LRU_BLOCKS, LRU_BLOCK_DIM), 0.02),
        "hawk_gate_x_w": nrm((N_EVEN, LRU_BLOCKS, LRU_BLOCK_DIM, LRU_BLOCK_DIM), LRU_BLOCK_DIM ** -0.5),
        "hawk_gate_x_b": nrm((N_EVEN, LRU_BLOCKS, LRU_BLOCK_DIM), 0.02),
        "hawk_lambda": hawk_lambda,
        "hawk_mem_norm": gain((N_EVEN, D_MODEL)),
        "hawk_w_mem_kv": nrm((N_EVEN, D_MODEL, 2 * MEM_WIDTH), D_MODEL ** -0.5),
        "hawk_w_out": nrm((N_EVEN, HAWK_OUT, D_MODEL), HAWK_OUT ** -0.5),
        "nsa_norm": gain((N_ODD, D_MODEL)),
        "nsa_w_in": nrm((N_ODD, D_MODEL, NSA_IN), D_MODEL ** -0.5),
        "nsa_pe_k": nrm((N_ODD, CMP_BLOCK, NSA_HEAD_DIM), 0.1),
        "nsa_pe_v": nrm((N_ODD, CMP_BLOCK, NSA_HEAD_DIM), 0.1),
        "nsa_phi_k_w1": nrm((N_ODD, phi_in, PHI_HIDDEN), phi_in ** -0.5),
        "nsa_phi_k_w2": nrm((N_ODD, PHI_HIDDEN, NSA_HEAD_DIM), PHI_HIDDEN ** -0.5),
        "nsa_phi_v_w1": nrm((N_ODD, phi_in, PHI_HIDDEN), phi_in ** -0.5),
        "nsa_phi_v_w2": nrm((N_ODD, PHI_HIDDEN, NSA_HEAD_DIM), PHI_HIDDEN ** -0.5),
        "nsa_mem_norm": gain((N_ODD, D_MODEL)),
        "nsa_w_mem_kv": nrm((N_ODD, D_MODEL, 2 * MEM_WIDTH), D_MODEL ** -0.5),
        "nsa_w_out": nrm((N_ODD, NSA_OUT, D_MODEL), NSA_OUT ** -0.5),
        "final_norm": gain((D_MODEL,)),
    }


def reference(x, mem, hawk_norm, hawk_w_in, hawk_conv_w, hawk_conv_b, hawk_gate_a_w, hawk_gate_a_b,
              hawk_gate_x_w, hawk_gate_x_b, hawk_lambda, hawk_mem_norm, hawk_w_mem_kv, hawk_w_out,
              nsa_norm, nsa_w_in, nsa_pe_k, nsa_pe_v, nsa_phi_k_w1, nsa_phi_k_w2, nsa_phi_v_w1,
              nsa_phi_v_w2, nsa_mem_norm, nsa_w_mem_kv, nsa_w_out, final_norm):
    for layer in range(DEPTH):
        i = layer // 2
        if layer % 2 == 0:
            x = hawk_dilated_layer(x, mem, hawk_norm[i], hawk_w_in[i], hawk_conv_w[i], hawk_conv_b[i],
                                   hawk_gate_a_w[i], hawk_gate_a_b[i], hawk_gate_x_w[i], hawk_gate_x_b[i],
                                   hawk_lambda[i], hawk_mem_norm[i], hawk_w_mem_kv[i], hawk_w_out[i])
        else:
            x = nsa_layer(x, mem, nsa_norm[i], nsa_w_in[i], nsa_pe_k[i], nsa_pe_v[i], nsa_phi_k_w1[i],
                          nsa_phi_k_w2[i], nsa_phi_v_w1[i], nsa_phi_v_w2[i], nsa_mem_norm[i],
                          nsa_w_mem_kv[i], nsa_w_out[i])
    return rms_norm(x, final_norm)
```

```cpp
#ifndef HOST_EMU
#include <hip/hip_runtime.h>
#include <hip/hip_cooperative_groups.h>
namespace cg = cooperative_groups;
#define DEVFN __device__ __forceinline__
#define DEVNI __device__ __forceinline__
#else
#include <cmath>
#include <cstdint>
#include <cstring>
#define DEVFN static inline
#define DEVNI static
#endif
#include <cstdio>
#include <cstdint>

#ifndef BATCH_
#define BATCH_ 8
#endif
#ifndef DM_
#define DM_ 1024
#endif

typedef unsigned short bf16_t;
constexpr int SEQ = 2048, NB = BATCH_, T_ = NB * SEQ, DM = DM_, NMEM = 256;
constexpr int HAWK_IN = 7680, HAWK_OUT = 1792, NSA_IN = 3376, NSA_INP = 3584, NSA_OUT = 1280;
constexpr float EPS = 1e-6f;

DEVFN float bf2f(bf16_t h) { union { unsigned u; float f; } c; c.u = (unsigned)h << 16; return c.f; }
DEVFN bf16_t f2bf(float f) { union { unsigned u; float f; } c; c.f = f; unsigned u = c.u; u += 0x7fffu + ((u >> 16) & 1u); return (bf16_t)(u >> 16); }
DEVFN float sigmoidf_(float x) { return 1.0f / (1.0f + expf(-x)); }
DEVFN float siluf_(float x) { return x / (1.0f + expf(-x)); }

constexpr size_t al256(size_t x) { return (x + 255) & ~(size_t)255; }
constexpr size_t OFF_CTRL = 0;
constexpr size_t OFF_W0IN = 65536;
constexpr size_t OFF_W0OUT = OFF_W0IN + al256((size_t)HAWK_IN * DM * 2);
constexpr size_t OFF_W1IN = OFF_W0OUT + al256((size_t)DM * HAWK_OUT * 2);
constexpr size_t OFF_W1OUT = OFF_W1IN + al256((size_t)NSA_INP * DM * 2);
constexpr size_t OFF_PHIW1 = OFF_W1OUT + al256((size_t)DM * NSA_OUT * 2);
constexpr size_t OFF_MEMKV = OFF_PHIW1 + al256((size_t)2 * 256 * 2048 * 2);
constexpr size_t OFF_LSE = OFF_MEMKV + al256((size_t)2 * NB * NMEM * 512 * 2);
constexpr size_t OFF_CMPH = OFF_LSE + al256((size_t)3 * T_ * 4 * 4);
constexpr size_t OFF_CMPKV = OFF_CMPH + al256((size_t)2 * NB * 2 * 128 * 256 * 4);
constexpr size_t OFF_SEL = OFF_CMPKV + al256((size_t)2 * NB * 2 * 128 * 64 * 4);
constexpr size_t OFF_IMP = OFF_SEL + al256((size_t)NB * 2 * SEQ * 4);
constexpr size_t OFF_XN = OFF_IMP + al256((size_t)NB * 2 * SEQ * 32 * 4);
constexpr size_t OFF_Q = OFF_XN + al256((size_t)T_ * DM * 2);
constexpr size_t OFF_K = OFF_Q + (size_t)T_ * 1536 * 2;
constexpr size_t OFF_V = OFF_K + (size_t)T_ * 1536 * 2;
constexpr size_t OFF_ZB = OFF_V + (size_t)T_ * 1536 * 2;
constexpr size_t OFF_QM = OFF_ZB + (size_t)T_ * 512 * 2;
constexpr size_t OFF_ZM = OFF_QM + (size_t)T_ * 256 * 2;
constexpr size_t WS_END = OFF_ZM + (size_t)T_ * 256 * 2;
constexpr size_t OFF_X1 = OFF_K;
constexpr size_t OFF_Z1 = OFF_K + (size_t)T_ * 1024 * 4;
constexpr size_t OFF_Q1 = OFF_Q;
constexpr size_t OFF_QM1 = OFF_Q + (size_t)T_ * 1024 * 2;
constexpr size_t OFF_ZM1 = OFF_QM1 + (size_t)T_ * 256 * 2;
constexpr size_t OFF_KV1 = OFF_ZB;
constexpr size_t OFF_GATE = OFF_ZM;
static_assert(OFF_Z1 + (size_t)T_ * 1024 * 2 <= OFF_ZB, "Z1 overlay");
static_assert(BATCH_ != 8 || DM_ != 1024 || WS_END <= (size_t)256 * 1024 * 1024, "workspace too big");

struct Params {
    const float *x, *mem, *hawk_norm, *hawk_w_in, *conv_w, *conv_b, *ga_w, *ga_b, *gx_w, *gx_b, *lam, *hawk_mem_norm, *hawk_w_mem_kv, *hawk_w_out;
    const float *nsa_norm, *nsa_w_in, *pe_k, *pe_v, *phik_w1, *phik_w2, *phiv_w1, *phiv_w2, *nsa_mem_norm, *nsa_w_mem_kv, *nsa_w_out, *final_norm;
    float* out; unsigned char* ws;
};

DEVFN int nsa_col_orig(int n) {
    if (n < 1792) return n;
    if (n < 2816) return n - 1792 + 1840;
    if (n < 3072) return n - 2816 + 2864;
    if (n < 3328) return n - 3072 + 3120;
    if (n < 3376) return n - 3328 + 1792;
    return -1;
}

DEVFN void p0_convert(const Params& p, long gt, long nt) {
    bf16_t* w0in = (bf16_t*)(p.ws + OFF_W0IN); bf16_t* w0out = (bf16_t*)(p.ws + OFF_W0OUT);
    bf16_t* w1in = (bf16_t*)(p.ws + OFF_W1IN); bf16_t* w1out = (bf16_t*)(p.ws + OFF_W1OUT); bf16_t* phiw1 = (bf16_t*)(p.ws + OFF_PHIW1);
    for (long i = gt; i < (long)DM * HAWK_IN; i += nt) { const int k = (int)(i / HAWK_IN), n = (int)(i % HAWK_IN); w0in[(size_t)n * DM + k] = f2bf(p.hawk_w_in[i]); }
    for (long i = gt; i < (long)HAWK_OUT * DM; i += nt) { const int k = (int)(i / DM), n = (int)(i % DM); w0out[(size_t)n * HAWK_OUT + k] = f2bf(p.hawk_w_out[i]); }
    for (long i = gt; i < (long)DM * NSA_INP; i += nt) { const int k = (int)(i / NSA_INP), n = (int)(i % NSA_INP); const int no = nsa_col_orig(n);
        w1in[(size_t)n * DM + k] = no >= 0 ? f2bf(p.nsa_w_in[(size_t)k * NSA_IN + no]) : (bf16_t)0; }
    for (long i = gt; i < (long)NSA_OUT * DM; i += nt) { const int k = (int)(i / DM), n = (int)(i % DM); w1out[(size_t)n * NSA_OUT + k] = f2bf(p.nsa_w_out[i]); }
    for (long i = gt; i < (long)2 * 2048 * 256; i += nt) { const int kv = (int)(i / (2048 * 256)), r = (int)(i % (2048 * 256)), k = r / 256, n = r % 256;
        phiw1[(size_t)kv * 256 * 2048 + (size_t)n * 2048 + k] = f2bf((kv ? p.phiv_w1 : p.phik_w1)[r]); }
}
DEVFN void rows_rmsnorm(const float* x, const float* g, bf16_t* xn, long gt, long nt) {
    for (long r = gt; r < T_; r += nt) {
        const float* xr = x + (size_t)r * DM; float ss = 0.f;
        for (int k = 0; k < DM; ++k) ss += xr[k] * xr[k];
        const float rs = 1.0f / sqrtf(ss / DM + EPS);
        for (int k = 0; k < DM; ++k) xn[(size_t)r * DM + k] = f2bf(xr[k] * rs * g[k]);
    }
}
DEVFN void p0_memkv(const Params& p, long gt, long nt) {
    bf16_t* mkv = (bf16_t*)(p.ws + OFF_MEMKV);
    for (long i = gt; i < (long)2 * NB * NMEM * 512; i += nt) {
        const int l = (int)(i / ((long)NB * NMEM * 512)), r = (int)((i / 512) % (NB * NMEM)), c = (int)(i % 512);
        const float* mr = p.mem + (size_t)r * DM; const float* g = l ? p.nsa_mem_norm : p.hawk_mem_norm; const float* w = l ? p.nsa_w_mem_kv : p.hawk_w_mem_kv;
        float ss = 0.f, acc = 0.f;
        for (int k = 0; k < DM; ++k) { const float v = mr[k]; ss += v * v; acc += v * g[k] * w[(size_t)k * 512 + c]; }
        mkv[i] = f2bf(acc / sqrtf(ss / DM + EPS));
    }
}

struct __attribute__((aligned(16))) U4 { unsigned x, y, z, w; };
DEVFN float lo16(unsigned u) { union { unsigned u; float f; } c; c.u = u << 16; return c.f; }
DEVFN float hi16(unsigned u) { union { unsigned u; float f; } c; c.u = u & 0xffff0000u; return c.f; }
DEVFN float dot_bf16(const bf16_t* a, const bf16_t* b, int n) {
    float s0 = 0.f, s1 = 0.f, s2 = 0.f, s3 = 0.f;
    for (int k = 0; k < n; k += 8) { const U4 va = *(const U4*)(a + k), vb = *(const U4*)(b + k);
        s0 += lo16(va.x) * lo16(vb.x) + hi16(va.x) * hi16(vb.x); s1 += lo16(va.y) * lo16(vb.y) + hi16(va.y) * hi16(vb.y);
        s2 += lo16(va.z) * lo16(vb.z) + hi16(va.z) * hi16(vb.z); s3 += lo16(va.w) * lo16(vb.w) + hi16(va.w) * hi16(vb.w); }
    return (s0 + s1) + (s2 + s3);
}

DEVFN void p1_gemm(const Params& p, long gt, long nt) {
    const bf16_t* xn = (const bf16_t*)(p.ws + OFF_XN); const bf16_t* w = (const bf16_t*)(p.ws + OFF_W0IN);
    bf16_t* xaza = (bf16_t*)p.out;
    for (long i = gt; i < (long)T_ * HAWK_IN; i += nt) {
        const int t = (int)(i / HAWK_IN), n = (int)(i % HAWK_IN);
        const bf16_t v = f2bf(dot_bf16(xn + (size_t)t * DM, w + (size_t)n * DM, DM));
        if (n < 2048) xaza[(size_t)t * 2048 + n] = v;
        else if (n < 3584) ((bf16_t*)(p.ws + OFF_Q))[(size_t)t * 1536 + n - 2048] = v;
        else if (n < 5120) ((bf16_t*)(p.ws + OFF_K))[(size_t)t * 1536 + n - 3584] = v;
        else if (n < 6656) ((bf16_t*)(p.ws + OFF_V))[(size_t)t * 1536 + n - 5120] = v;
        else if (n < 7168) ((bf16_t*)(p.ws + OFF_ZB))[(size_t)t * 512 + n - 6656] = v;
        else if (n < 7424) ((bf16_t*)(p.ws + OFF_QM))[(size_t)t * 256 + n - 7168] = v;
        else ((bf16_t*)(p.ws + OFF_ZM))[(size_t)t * 256 + n - 7424] = v;
    }
}

DEVFN void p2_lru(const Params& p, long gt, long nt) {
    bf16_t* xaza = (bf16_t*)p.out;
    for (long i = gt; i < (long)NB * 1024; i += nt) {
        const int b = (int)(i / 1024), c = (int)(i % 1024), blk = c >> 6, j = c & 63;
        const float sp = log1pf(expf(-p.lam[c]));
        const float* gaw = p.ga_w + (size_t)blk * 4096; const float* gxw = p.gx_w + (size_t)blk * 4096;
        float h = 0.f;
        for (int t = 0; t < SEQ; ++t) {
            float ra = p.ga_b[c], ri = p.gx_b[c], xcj = 0.f;
            for (int ii = 0; ii < 64; ++ii) {
                const int cc = blk * 64 + ii; float xc = p.conv_b[cc];
                for (int k = 0; k < 4; ++k) { const int tt = t - 3 + k; if (tt >= 0) xc += p.conv_w[k * 1024 + cc] * bf2f(xaza[((size_t)b * SEQ + tt) * 2048 + cc]); }
                ra += xc * gaw[ii * 64 + j]; ri += xc * gxw[ii * 64 + j];
                if (ii == j) xcj = xc;
            }
            const float r = sigmoidf_(ra), ig = sigmoidf_(ri);
            const float log_a = -8.0f * r * sp, a = expf(log_a);
            const float mult = t == 0 ? 1.0f : sqrtf(-expm1f(2.0f * log_a));
            h = a * h + xcj * ig * mult;
            const size_t zi = ((size_t)b * SEQ + t) * 2048 + 1024 + c;
            xaza[zi] = f2bf(h * siluf_(bf2f(xaza[zi])));
        }
    }
}
DEVNI void p2_dilated(const Params& p, long gt, long nt) {
    bf16_t* Q = (bf16_t*)(p.ws + OFF_Q); const bf16_t* K = (const bf16_t*)(p.ws + OFF_K); const bf16_t* V = (const bf16_t*)(p.ws + OFF_V);
    float* LSE = (float*)(p.ws + OFF_LSE);
    for (long i = gt; i < (long)T_ * 12; i += nt) {
        const int t = (int)(i / 12), hh = (int)(i % 12), g = hh >> 2, h = hh & 3, s = t % SEQ;
        const int dil = g == 0 ? 1 : (g == 1 ? 4 : 16);
        const float slope = exp2f(-8.0f * (float)(hh + 1) / 12.0f), scale = 0.08838834764831845f;
        bf16_t* qp = Q + (size_t)t * 1536 + hh * 128;
        float o[128], m = -1e30f, l = 0.f;
#pragma unroll
        for (int d = 0; d < 128; ++d) o[d] = 0.f;
        for (int jj = 0; jj <= 128; ++jj) {
            const int sk = s - jj * dil; if (sk < 0) break;
            const bf16_t* kp = K + (size_t)(t - jj * dil) * 1536 + hh * 128; const bf16_t* vp = V + (size_t)(t - jj * dil) * 1536 + hh * 128;
            float sc = 0.f;
#pragma nounroll
            for (int d = 0; d < 128; ++d) sc += bf2f(qp[d]) * bf2f(kp[d]);
            sc = sc * scale - slope * (float)(jj * dil);
            const float mn = fmaxf(m, sc), al = expf(m - mn), pe = expf(sc - mn);
            l = l * al + pe; m = mn;
#pragma unroll
            for (int d = 0; d < 128; ++d) o[d] = o[d] * al + pe * bf2f(vp[d]);
        }
        const float inv = 1.0f / l;
#pragma unroll
        for (int d = 0; d < 128; ++d) qp[d] = f2bf(o[d] * inv);
        LSE[((size_t)g * T_ + t) * 4 + h] = m + logf(l);
    }
}
DEVFN void p2_combine(const Params& p, long gt, long nt) {
    const bf16_t* Q = (const bf16_t*)(p.ws + OFF_Q); bf16_t* ZB = (bf16_t*)(p.ws + OFF_ZB); const float* LSE = (const float*)(p.ws + OFF_LSE);
    for (long i = gt; i < (long)T_ * 512; i += nt) {
        const int t = (int)(i / 512), c = (int)(i % 512), h = c >> 7;
        const float l0 = LSE[((size_t)0 * T_ + t) * 4 + h], l1 = LSE[((size_t)1 * T_ + t) * 4 + h], l2 = LSE[((size_t)2 * T_ + t) * 4 + h];
        const float mx = fmaxf(l0, fmaxf(l1, l2)), e0 = expf(l0 - mx), e1 = expf(l1 - mx), e2 = expf(l2 - mx), inv = 1.0f / (e0 + e1 + e2);
        const float o = (e0 * bf2f(Q[(size_t)t * 1536 + c]) + e1 * bf2f(Q[(size_t)t * 1536 + 512 + c]) + e2 * bf2f(Q[(size_t)t * 1536 + 1024 + c])) * inv;
        ZB[i] = f2bf(o * siluf_(bf2f(ZB[i])));
    }
}
DEVNI void mem_attn(const bf16_t* mkv, bf16_t* QMb, const bf16_t* ZMb, long gt, long nt) {
    for (long i = gt; i < (long)T_ * 4; i += nt) {
        const int t = (int)(i / 4), h = (int)(i % 4), b = t / SEQ;
        bf16_t* qp = QMb + (size_t)t * 256 + h * 64;
        float o[64], m = -1e30f, l = 0.f;
#pragma unroll
        for (int d = 0; d < 64; ++d) o[d] = 0.f;
        for (int j = 0; j < NMEM; ++j) {
            const bf16_t* kp = mkv + ((size_t)b * NMEM + j) * 512 + h * 64; const bf16_t* vp = kp + 256;
            float sc = 0.f;
#pragma nounroll
            for (int d = 0; d < 64; ++d) sc += bf2f(qp[d]) * bf2f(kp[d]);
            sc *= 0.125f;
            const float mn = fmaxf(m, sc), al = expf(m - mn), pe = expf(sc - mn);
            l = l * al + pe; m = mn;
#pragma unroll
            for (int d = 0; d < 64; ++d) o[d] = o[d] * al + pe * bf2f(vp[d]);
        }
        const float inv = 1.0f / l;
#pragma unroll
        for (int d = 0; d < 64; ++d) qp[d] = f2bf(o[d] * inv * siluf_(bf2f(ZMb[(size_t)t * 256 + h * 64 + d])));
    }
}

DEVFN void p3_gemm(const Params& p, long gt, long nt) {
    const bf16_t* ya = (const bf16_t*)p.out; const bf16_t* yb = (const bf16_t*)(p.ws + OFF_ZB); const bf16_t* ym = (const bf16_t*)(p.ws + OFF_QM);
    const bf16_t* w = (const bf16_t*)(p.ws + OFF_W0OUT); float* x1 = (float*)(p.ws + OFF_X1);
    for (long i = gt; i < (long)T_ * DM; i += nt) {
        const int t = (int)(i / DM), n = (int)(i % DM); const bf16_t* wr = w + (size_t)n * HAWK_OUT;
        float acc = dot_bf16(ya + (size_t)t * 2048 + 1024, wr, 1024) + dot_bf16(yb + (size_t)t * 512, wr + 1024, 512) + dot_bf16(ym + (size_t)t * 256, wr + 1536, 256);
        x1[i] = p.x[i] + acc;
    }
}
DEVFN void p4_gemm(const Params& p, long gt, long nt) {
    const bf16_t* xn = (const bf16_t*)(p.ws + OFF_XN); const bf16_t* w = (const bf16_t*)(p.ws + OFF_W1IN);
    for (long i = gt; i < (long)T_ * NSA_IN; i += nt) {
        const int t = (int)(i / NSA_IN), n = (int)(i % NSA_IN);
        const float a = dot_bf16(xn + (size_t)t * DM, w + (size_t)n * DM, DM); const bf16_t v = f2bf(a);
        if (n < 1024) ((bf16_t*)(p.ws + OFF_Q1))[(size_t)t * 1024 + n] = v;
        else if (n < 1792) ((bf16_t*)(p.ws + OFF_KV1))[(size_t)t * 768 + n - 1024] = v;
        else if (n < 2816) ((bf16_t*)(p.ws + OFF_Z1))[(size_t)t * 1024 + n - 1792] = v;
        else if (n < 3072) ((bf16_t*)(p.ws + OFF_QM1))[(size_t)t * 256 + n - 2816] = v;
        else if (n < 3328) ((bf16_t*)(p.ws + OFF_ZM1))[(size_t)t * 256 + n - 3072] = v;
        else ((float*)(p.ws + OFF_GATE))[(size_t)t * 48 + n - 3328] = a;
    }
}
DEVFN void p5_cmp1(const Params& p, long gt, long nt) {
    const bf16_t* KV = (const bf16_t*)(p.ws + OFF_KV1); const bf16_t* w1 = (const bf16_t*)(p.ws + OFF_PHIW1); float* hid = (float*)(p.ws + OFF_CMPH);
    for (long i = gt; i < (long)2 * NB * 2 * 127 * 256; i += nt) {
        const int j = (int)(i % 256); long r = i / 256; const int n = (int)(r % 127); r /= 127; const int g = (int)(r % 2); r /= 2; const int b = (int)(r % NB), kv = (int)(r / NB);
        const float* pe = kv ? p.pe_v : p.pe_k; const bf16_t* wj = w1 + ((size_t)kv * 256 + j) * 2048;
        float acc = 0.f;
        for (int ii = 0; ii < 32; ++ii) { const bf16_t* tp = KV + ((size_t)b * SEQ + 16 * n + ii) * 768 + kv * 128 + g * 64;
            for (int d = 0; d < 64; ++d) acc += (bf2f(tp[d]) + pe[ii * 64 + d]) * bf2f(wj[ii * 64 + d]); }
        hid[((((size_t)kv * NB + b) * 2 + g) * 128 + n) * 256 + j] = siluf_(acc);
    }
}
DEVFN void p5_cmp2(const Params& p, long gt, long nt) {
    const float* hid = (const float*)(p.ws + OFF_CMPH); float* ckv = (float*)(p.ws + OFF_CMPKV);
    for (long i = gt; i < (long)2 * NB * 2 * 127 * 64; i += nt) {
        const int d = (int)(i % 64); long r = i / 64; const int n = (int)(r % 127); r /= 127; const int g = (int)(r % 2); r /= 2; const int b = (int)(r % NB), kv = (int)(r / NB);
        const float* w2 = kv ? p.phiv_w2 : p.phik_w2; const size_t row = (((size_t)kv * NB + b) * 2 + g) * 128 + n;
        float acc = 0.f;
        for (int j = 0; j < 256; ++j) acc += hid[row * 256 + j] * w2[j * 64 + d];
        ckv[row * 64 + d] = acc;
    }
}
DEVNI void p5_cmp_attn(const Params& p, long gt, long nt) {
    const bf16_t* Q1 = (const bf16_t*)(p.ws + OFF_Q1); const float* ckv = (const float*)(p.ws + OFF_CMPKV); const float* gate = (const float*)(p.ws + OFF_GATE);
    unsigned* SEL = (unsigned*)(p.ws + OFF_SEL); float* ocmp = p.out; float* IMP = (float*)(p.ws + OFF_IMP);
    for (long i = gt; i < (long)NB * 2 * SEQ; i += nt) {
        const int s = (int)(i % SEQ), g = (int)((i / SEQ) % 2), b = (int)(i / (2 * SEQ)); const int t = b * SEQ + s;
        const float* kc = ckv + (((size_t)0 * NB + b) * 2 + g) * 128 * 64; const float* vc = ckv + (((size_t)1 * NB + b) * 2 + g) * 128 * 64;
        const int nvis = s >= 31 ? (s - 31) / 16 + 1 : 0;
        float* imp = IMP + (size_t)i * 32;
        for (int r = 0; r < 8; ++r) {
            const int hidx = g * 8 + r; const float slope = exp2f(-0.5f * (float)(hidx + 1));
            const bf16_t* qp = Q1 + (size_t)t * 1024 + hidx * 64;
            float m = -1e30f;
            for (int n = 0; n < nvis; ++n) { float sc = 0.f;
_Pragma("nounroll") for (int d = 0; d < 64; ++d) sc += bf2f(qp[d]) * kc[n * 64 + d];
                sc = sc * 0.125f - slope * (float)(s - (16 * n + 31)); m = fmaxf(m, sc); }
            float l = 0.f;
            for (int n = 0; n < nvis; ++n) { float sc = 0.f;
_Pragma("nounroll") for (int d = 0; d < 64; ++d) sc += bf2f(qp[d]) * kc[n * 64 + d];
                sc = sc * 0.125f - slope * (float)(s - (16 * n + 31)); l += expf(sc - m); }
            const float inv = nvis > 0 ? 1.0f / l : 0.f;
            float o[64];
#pragma unroll
            for (int d = 0; d < 64; ++d) o[d] = 0.f;
            float carry = 0.f;
            for (int j = 0; j < 32; ++j) {
                float acc = carry; carry = 0.f;
                for (int q4 = 0; q4 < 4; ++q4) { const int n = 4 * j + q4;
                    if (n < nvis) { float sc = 0.f;
_Pragma("nounroll") for (int d = 0; d < 64; ++d) sc += bf2f(qp[d]) * kc[n * 64 + d];
                        sc = sc * 0.125f - slope * (float)(s - (16 * n + 31)); const float pr = expf(sc - m) * inv;
                        acc += pr; if (q4 == 3) carry = pr;
#pragma unroll
                        for (int d = 0; d < 64; ++d) o[d] += pr * vc[n * 64 + d]; } }
                imp[j] = (r == 0 ? 0.f : imp[j]) + acc;
            }
            const float g0 = sigmoidf_(gate[(size_t)t * 48 + hidx * 3 + 0]);
#pragma unroll
            for (int d = 0; d < 64; ++d) ocmp[(size_t)t * 1024 + hidx * 64 + d] = g0 * o[d];
        }
        const int cur = s >> 6; unsigned mask = 1u | (1u << cur) | (cur > 0 ? (1u << (cur - 1)) : 0u);
        const int nf = cur == 0 ? 1 : (cur == 1 ? 2 : 3), need = 8 - nf;
        for (int j = 1; j < 30; ++j) {
            if (j <= cur - 2) { int rank = 0;
                for (int j2 = 1; j2 < 30; ++j2) if (j2 <= cur - 2 && j2 != j) rank += (imp[j2] > imp[j] || (imp[j2] == imp[j] && j2 < j)) ? 1 : 0;
                if (rank < need) mask |= 1u << j; }
        }
        SEL[i] = mask;
    }
}
DEVNI void p5_slc_win(const Params& p, long gt, long nt) {
    const bf16_t* Q1 = (const bf16_t*)(p.ws + OFF_Q1); const bf16_t* KV = (const bf16_t*)(p.ws + OFF_KV1); const float* gate = (const float*)(p.ws + OFF_GATE);
    const unsigned* SEL = (const unsigned*)(p.ws + OFF_SEL); const float* ocmp = p.out; bf16_t* Z1 = (bf16_t*)(p.ws + OFF_Z1);
    for (long i = gt; i < (long)T_ * 16; i += nt) {
        const int t = (int)(i / 16), hidx = (int)(i % 16), g = hidx >> 3, b = t / SEQ, s = t % SEQ;
        const float slope = exp2f(-0.5f * (float)(hidx + 1));
        const bf16_t* qp = Q1 + (size_t)t * 1024 + hidx * 64;
        const unsigned mask = SEL[((size_t)b * 2 + g) * SEQ + s];
        float res[64];
        {
            float o[64], m = -1e30f, l = 0.f;
#pragma unroll
            for (int d = 0; d < 64; ++d) o[d] = 0.f;
            for (int j = 0; j < 32; ++j) { if (!((mask >> j) & 1u)) continue;
                for (int kk = 0; kk < 64; ++kk) { const int kpos = j * 64 + kk; if (kpos > s) break;
                    const bf16_t* kp = KV + ((size_t)b * SEQ + kpos) * 768 + 2 * 128 + g * 64; const bf16_t* vp = kp + 128;
                    float sc = 0.f;
#pragma nounroll
                    for (int d = 0; d < 64; ++d) sc += bf2f(qp[d]) * bf2f(kp[d]);
                    sc = sc * 0.125f - slope * (float)(s - kpos);
                    const float mn = fmaxf(m, sc), al = expf(m - mn), pe = expf(sc - mn); l = l * al + pe; m = mn;
#pragma unroll
                    for (int d = 0; d < 64; ++d) o[d] = o[d] * al + pe * bf2f(vp[d]); } }
            const float g1 = sigmoidf_(gate[(size_t)t * 48 + hidx * 3 + 1]) / l;
#pragma unroll
            for (int d = 0; d < 64; ++d) res[d] = ocmp[(size_t)t * 1024 + hidx * 64 + d] + g1 * o[d];
        }
        {
            float o[64], m = -1e30f, l = 0.f;
#pragma unroll
            for (int d = 0; d < 64; ++d) o[d] = 0.f;
            for (int kpos = (s - 511 > 0 ? s - 511 : 0); kpos <= s; ++kpos) {
                const bf16_t* kp = KV + ((size_t)b * SEQ + kpos) * 768 + 4 * 128 + g * 64; const bf16_t* vp = kp + 128;
                float sc = 0.f;
#pragma nounroll
                for (int d = 0; d < 64; ++d) sc += bf2f(qp[d]) * bf2f(kp[d]);
                sc = sc * 0.125f - slope * (float)(s - kpos);
                const float mn = fmaxf(m, sc), al = expf(m - mn), pe = expf(sc - mn); l = l * al + pe; m = mn;
#pragma unroll
                for (int d = 0; d < 64; ++d) o[d] = o[d] * al + pe * bf2f(vp[d]); }
            const float g2 = sigmoidf_(gate[(size_t)t * 48 + hidx * 3 + 2]) / l;
#pragma unroll
            for (int d = 0; d < 64; ++d) res[d] += g2 * o[d];
        }
#pragma unroll
        for (int d = 0; d < 64; ++d) { const size_t zi = (size_t)t * 1024 + hidx * 64 + d; Z1[zi] = f2bf(res[d] * siluf_(bf2f(Z1[zi]))); }
    }
}
DEVFN void p6_gemm(const Params& p, long gt, long nt) {
    const bf16_t* y = (const bf16_t*)(p.ws + OFF_Z1); const bf16_t* ym = (const bf16_t*)(p.ws + OFF_QM1); const bf16_t* w = (const bf16_t*)(p.ws + OFF_W1OUT);
    const float* x1 = (const float*)(p.ws + OFF_X1);
    for (long i = gt; i < (long)T_ * DM; i += nt) {
        const int t = (int)(i / DM), n = (int)(i % DM); const bf16_t* wr = w + (size_t)n * NSA_OUT;
        p.out[i] = x1[i] + dot_bf16(y + (size_t)t * 1024, wr, 1024) + dot_bf16(ym + (size_t)t * 256, wr + 1024, 256);
    }
}
DEVFN void p7_final(const Params& p, long gt, long nt) {
    for (long r = gt; r < T_; r += nt) {
        float* xr = p.out + (size_t)r * DM; float ss = 0.f;
        for (int k = 0; k < DM; ++k) ss += xr[k] * xr[k];
        const float rs = 1.0f / sqrtf(ss / DM + EPS);
        for (int k = 0; k < DM; ++k) xr[k] = xr[k] * rs * p.final_norm[k];
    }
}

#ifndef HOST_EMU
#define GSYNC() grid.sync()
__global__ void __launch_bounds__(512) mega(Params p) {
    cg::grid_group grid = cg::this_grid();
    const long gt = (long)blockIdx.x * blockDim.x + threadIdx.x, nt = (long)gridDim.x * blockDim.x;
    p0_convert(p, gt, nt); rows_rmsnorm(p.x, p.hawk_norm, (bf16_t*)(p.ws + OFF_XN), gt, nt); p0_memkv(p, gt, nt);
    GSYNC();
    p1_gemm(p, gt, nt);
    GSYNC();
    p2_lru(p, gt, nt); p2_dilated(p, gt, nt); mem_attn((const bf16_t*)(p.ws + OFF_MEMKV), (bf16_t*)(p.ws + OFF_QM), (const bf16_t*)(p.ws + OFF_ZM), gt, nt);
    GSYNC();
    p2_combine(p, gt, nt);
    GSYNC();
    p3_gemm(p, gt, nt);
    GSYNC();
    rows_rmsnorm((const float*)(p.ws + OFF_X1), p.nsa_norm, (bf16_t*)(p.ws + OFF_XN), gt, nt);
    GSYNC();
    p4_gemm(p, gt, nt);
    GSYNC();
    p5_cmp1(p, gt, nt); mem_attn((const bf16_t*)(p.ws + OFF_MEMKV) + (size_t)NB * NMEM * 512, (bf16_t*)(p.ws + OFF_QM1), (const bf16_t*)(p.ws + OFF_ZM1), gt, nt);
    GSYNC();
    p5_cmp2(p, gt, nt);
    GSYNC();
    p5_cmp_attn(p, gt, nt);
    GSYNC();
    p5_slc_win(p, gt, nt);
    GSYNC();
    p6_gemm(p, gt, nt);
    GSYNC();
    p7_final(p, gt, nt);
}

extern "C" void kernel_launch(void* const* d_in, const int* in_sizes, int n_in, void* d_out, int out_size, void* d_ws, size_t ws_size, hipStream_t stream) {
    static int grid_blocks = 0;
    if (!grid_blocks) {
        int dev = 0, cus = 0, per_cu = 0;
        (void)hipGetDevice(&dev);
        (void)hipDeviceGetAttribute(&cus, hipDeviceAttributeMultiprocessorCount, dev);
        (void)hipOccupancyMaxActiveBlocksPerMultiprocessor(&per_cu, mega, 512, 0);
        if (per_cu > 1) per_cu = 1;
        grid_blocks = cus * per_cu;
    }
    Params p{};
    const float** f = (const float**)&p;
    for (int i = 0; i < 26; ++i) f[i] = (const float*)d_in[i];
    p.out = (float*)d_out; p.ws = (unsigned char*)d_ws;
    void* args[] = {&p};
    hipError_t e = hipLaunchCooperativeKernel((void*)mega, dim3(grid_blocks), dim3(512), args, 0, stream);
    if (e != hipSuccess) fprintf(stderr, "cooperative launch failed: %s (grid %d)\n", hipGetErrorString(e), grid_blocks);
}
#endif
```

```cpp
#ifndef HOST_EMU
#include <hip/hip_runtime.h>
#include <hip/hip_cooperative_groups.h>
namespace cg = cooperative_groups;
#define DEVFN __device__ __forceinline__
#define DEVNI __device__ __forceinline__
#else
#include <cmath>
#include <cstdint>
#include <cstring>
#define DEVFN static inline
#define DEVNI static
#endif
#include <cstdio>
#include <cstdint>

#ifndef BATCH_
#define BATCH_ 8
#endif
#ifndef DM_
#define DM_ 1024
#endif

typedef unsigned short bf16_t;
constexpr int SEQ = 2048, NB = BATCH_, T_ = NB * SEQ, DM = DM_, NMEM = 256;
constexpr int HAWK_IN = 7680, HAWK_OUT = 1792, NSA_IN = 3376, NSA_INP = 3584, NSA_OUT = 1280;
constexpr float EPS = 1e-6f;

DEVFN float bf2f(bf16_t h) { union { unsigned u; float f; } c; c.u = (unsigned)h << 16; return c.f; }
DEVFN bf16_t f2bf(float f) { union { unsigned u; float f; } c; c.f = f; unsigned u = c.u; u += 0x7fffu + ((u >> 16) & 1u); return (bf16_t)(u >> 16); }
DEVFN float sigmoidf_(float x) { return 1.0f / (1.0f + expf(-x)); }
DEVFN float siluf_(float x) { return x / (1.0f + expf(-x)); }

constexpr size_t al256(size_t x) { return (x + 255) & ~(size_t)255; }
constexpr size_t OFF_CTRL = 0;
constexpr size_t OFF_W0OUT = 65536;
constexpr size_t OFF_W1IN = OFF_W0OUT + al256((size_t)DM * HAWK_OUT * 2);
constexpr size_t OFF_W1OUT = OFF_W1IN + al256((size_t)NSA_INP * DM * 2);
constexpr size_t OFF_PHIW1 = OFF_W1OUT + al256((size_t)DM * NSA_OUT * 2);
constexpr size_t OFF_MEMKV = OFF_PHIW1 + al256((size_t)2 * 256 * 2048 * 2);
constexpr size_t OFF_LSE = OFF_MEMKV + al256((size_t)2 * NB * NMEM * 512 * 2);
constexpr size_t OFF_RA = OFF_LSE + al256((size_t)3 * T_ * 4 * 4);
constexpr size_t RA_BYTES = (size_t)T_ * 1792 * 2;
constexpr size_t OFF_XN = OFF_RA;
constexpr size_t OFF_W0IN = OFF_RA + (size_t)T_ * 1024 * 2;
constexpr size_t OFF_Y0 = OFF_RA;
constexpr size_t OFF_Y1 = OFF_RA;
constexpr size_t OFF_CMPH = OFF_RA + (size_t)T_ * 1280 * 2;
constexpr size_t OFF_CMPKV = OFF_CMPH + al256((size_t)2 * NB * 2 * 128 * 256 * 4);
constexpr size_t OFF_SEL = OFF_CMPKV + al256((size_t)2 * NB * 2 * 128 * 64 * 4);
constexpr size_t OFF_IMP = OFF_SEL + al256((size_t)NB * 2 * SEQ * 4);
static_assert(OFF_W0IN + (size_t)HAWK_IN * DM * 2 <= OFF_RA + RA_BYTES, "region A: XN0 | W0IN");
static_assert(OFF_IMP + (size_t)NB * 2 * SEQ * 32 * 4 <= OFF_RA + RA_BYTES, "region A: layer-1 temporaries");
constexpr size_t OFF_Q = OFF_RA + RA_BYTES;
constexpr size_t OFF_K = OFF_Q + (size_t)T_ * 1536 * 2;
constexpr size_t OFF_V = OFF_K + (size_t)T_ * 1536 * 2;
constexpr size_t OFF_ZB = OFF_V + (size_t)T_ * 1536 * 2;
constexpr size_t OFF_QM = OFF_ZB + (size_t)T_ * 512 * 2;
constexpr size_t OFF_ZM = OFF_QM + (size_t)T_ * 256 * 2;
constexpr size_t WS_END = OFF_ZM + (size_t)T_ * 256 * 2;
constexpr size_t OFF_X1 = OFF_K;
constexpr size_t OFF_Z1 = OFF_K + (size_t)T_ * 1024 * 4;
constexpr size_t OFF_Q1 = OFF_Q;
constexpr size_t OFF_QM1 = OFF_Q + (size_t)T_ * 1024 * 2;
constexpr size_t OFF_ZM1 = OFF_QM1 + (size_t)T_ * 256 * 2;
constexpr size_t OFF_KV1 = OFF_ZB;
constexpr size_t OFF_GATE = OFF_ZM;
static_assert(OFF_Z1 + (size_t)T_ * 1024 * 2 <= OFF_ZB, "Z1 overlay");
static_assert(BATCH_ != 8 || DM_ != 1024 || WS_END <= (size_t)256 * 1024 * 1024, "workspace too big");

struct Params {
    const float *x, *mem, *hawk_norm, *hawk_w_in, *conv_w, *conv_b, *ga_w, *ga_b, *gx_w, *gx_b, *lam, *hawk_mem_norm, *hawk_w_mem_kv, *hawk_w_out;
    const float *nsa_norm, *nsa_w_in, *pe_k, *pe_v, *phik_w1, *phik_w2, *phiv_w1, *phiv_w2, *nsa_mem_norm, *nsa_w_mem_kv, *nsa_w_out, *final_norm;
    float* out; unsigned char* ws;
};

DEVFN int nsa_col_orig(int n) {
    if (n < 1792) return n;
    if (n < 2816) return n - 1792 + 1840;
    if (n < 3072) return n - 2816 + 2864;
    if (n < 3328) return n - 3072 + 3120;
    if (n < 3376) return n - 3328 + 1792;
    return -1;
}

DEVFN void p0_convert(const Params& p, long gt, long nt) {
    bf16_t* w0in = (bf16_t*)(p.ws + OFF_W0IN); bf16_t* w0out = (bf16_t*)(p.ws + OFF_W0OUT);
    bf16_t* w1in = (bf16_t*)(p.ws + OFF_W1IN); bf16_t* w1out = (bf16_t*)(p.ws + OFF_W1OUT); bf16_t* phiw1 = (bf16_t*)(p.ws + OFF_PHIW1);
    for (long i = gt; i < (long)DM * HAWK_IN; i += nt) { const int k = (int)(i / HAWK_IN), n = (int)(i % HAWK_IN); w0in[(size_t)n * DM + k] = f2bf(p.hawk_w_in[i]); }
    for (long i = gt; i < (long)HAWK_OUT * DM; i += nt) { const int k = (int)(i / DM), n = (int)(i % DM); w0out[(size_t)n * HAWK_OUT + k] = f2bf(p.hawk_w_out[i]); }
    for (long i = gt; i < (long)DM * NSA_INP; i += nt) { const int k = (int)(i / NSA_INP), n = (int)(i % NSA_INP); const int no = nsa_col_orig(n);
        w1in[(size_t)n * DM + k] = no >= 0 ? f2bf(p.nsa_w_in[(size_t)k * NSA_IN + no]) : (bf16_t)0; }
    for (long i = gt; i < (long)NSA_OUT * DM; i += nt) { const int k = (int)(i / DM), n = (int)(i % DM); w1out[(size_t)n * NSA_OUT + k] = f2bf(p.nsa_w_out[i]); }
    for (long i = gt; i < (long)2 * 2048 * 256; i += nt) { const int kv = (int)(i / (2048 * 256)), r = (int)(i % (2048 * 256)), k = r / 256, n = r % 256;
        phiw1[(size_t)kv * 256 * 2048 + (size_t)n * 2048 + k] = f2bf((kv ? p.phiv_w1 : p.phik_w1)[r]); }
}
DEVFN void rows_rmsnorm(const float* x, const float* g, bf16_t* xn, long gt, long nt) {
    for (long r = gt; r < T_; r += nt) {
        const float* xr = x + (size_t)r * DM; float ss = 0.f;
        for (int k = 0; k < DM; ++k) ss += xr[k] * xr[k];
        const float rs = 1.0f / sqrtf(ss / DM + EPS);
        for (int k = 0; k < DM; ++k) xn[(size_t)r * DM + k] = f2bf(xr[k] * rs * g[k]);
    }
}
DEVFN void p0_memkv(const Params& p, long gt, long nt) {
    bf16_t* mkv = (bf16_t*)(p.ws + OFF_MEMKV);
    for (long i = gt; i < (long)2 * NB * NMEM * 512; i += nt) {
        const int l = (int)(i / ((long)NB * NMEM * 512)), r = (int)((i / 512) % (NB * NMEM)), c = (int)(i % 512);
        const float* mr = p.mem + (size_t)r * DM; const float* g = l ? p.nsa_mem_norm : p.hawk_mem_norm; const float* w = l ? p.nsa_w_mem_kv : p.hawk_w_mem_kv;
        float ss = 0.f, acc = 0.f;
        for (int k = 0; k < DM; ++k) { const float v = mr[k]; ss += v * v; acc += v * g[k] * w[(size_t)k * 512 + c]; }
        mkv[i] = f2bf(acc / sqrtf(ss / DM + EPS));
    }
}

struct __attribute__((aligned(16))) U4 { unsigned x, y, z, w; };
DEVFN float lo16(unsigned u) { union { unsigned u; float f; } c; c.u = u << 16; return c.f; }
DEVFN float hi16(unsigned u) { union { unsigned u; float f; } c; c.u = u & 0xffff0000u; return c.f; }
DEVFN float dot_bf16(const bf16_t* a, const bf16_t* b, int n) {
    float s0 = 0.f, s1 = 0.f, s2 = 0.f, s3 = 0.f;
    for (int k = 0; k < n; k += 8) { const U4 va = *(const U4*)(a + k), vb = *(const U4*)(b + k);
        s0 += lo16(va.x) * lo16(vb.x) + hi16(va.x) * hi16(vb.x); s1 += lo16(va.y) * lo16(vb.y) + hi16(va.y) * hi16(vb.y);
        s2 += lo16(va.z) * lo16(vb.z) + hi16(va.z) * hi16(vb.z); s3 += lo16(va.w) * lo16(vb.w) + hi16(va.w) * hi16(vb.w); }
    return (s0 + s1) + (s2 + s3);
}

DEVFN void p1_gemm(const Params& p, long gt, long nt) {
    const bf16_t* xn = (const bf16_t*)(p.ws + OFF_XN); const bf16_t* w = (const bf16_t*)(p.ws + OFF_W0IN);
    bf16_t* xaza = (bf16_t*)p.out;
    for (long i = gt; i < (long)T_ * HAWK_IN; i += nt) {
        const int t = (int)(i / HAWK_IN), n = (int)(i % HAWK_IN);
        const bf16_t v = f2bf(dot_bf16(xn + (size_t)t * DM, w + (size_t)n * DM, DM));
        if (n < 2048) xaza[(size_t)t * 2048 + n] = v;
        else if (n < 3584) ((bf16_t*)(p.ws + OFF_Q))[(size_t)t * 1536 + n - 2048] = v;
        else if (n < 5120) ((bf16_t*)(p.ws + OFF_K))[(size_t)t * 1536 + n - 3584] = v;
        else if (n < 6656) ((bf16_t*)(p.ws + OFF_V))[(size_t)t * 1536 + n - 5120] = v;
        else if (n < 7168) ((bf16_t*)(p.ws + OFF_ZB))[(size_t)t * 512 + n - 6656] = v;
        else if (n < 7424) ((bf16_t*)(p.ws + OFF_QM))[(size_t)t * 256 + n - 7168] = v;
        else ((bf16_t*)(p.ws + OFF_ZM))[(size_t)t * 256 + n - 7424] = v;
    }
}

DEVFN void p2_lru(const Params& p, long gt, long nt) {
    const bf16_t* xaza = (const bf16_t*)p.out; bf16_t* Y0 = (bf16_t*)(p.ws + OFF_Y0);
    for (long i = gt; i < (long)NB * 1024; i += nt) {
        const int b = (int)(i / 1024), c = (int)(i % 1024), blk = c >> 6, j = c & 63;
        const float sp = log1pf(expf(-p.lam[c]));
        const float* gaw = p.ga_w + (size_t)blk * 4096; const float* gxw = p.gx_w + (size_t)blk * 4096;
        float h = 0.f;
        for (int t = 0; t < SEQ; ++t) {
            float ra = p.ga_b[c], ri = p.gx_b[c], xcj = 0.f;
            for (int ii = 0; ii < 64; ++ii) {
                const int cc = blk * 64 + ii; float xc = p.conv_b[cc];
                for (int k = 0; k < 4; ++k) { const int tt = t - 3 + k; if (tt >= 0) xc += p.conv_w[k * 1024 + cc] * bf2f(xaza[((size_t)b * SEQ + tt) * 2048 + cc]); }
                ra += xc * gaw[ii * 64 + j]; ri += xc * gxw[ii * 64 + j];
                if (ii == j) xcj = xc;
            }
            const float r = sigmoidf_(ra), ig = sigmoidf_(ri);
            const float log_a = -8.0f * r * sp, a = expf(log_a);
            const float mult = t == 0 ? 1.0f : sqrtf(-expm1f(2.0f * log_a));
            h = a * h + xcj * ig * mult;
            const size_t tt0 = (size_t)b * SEQ + t;
            Y0[tt0 * 1792 + c] = f2bf(h * siluf_(bf2f(xaza[tt0 * 2048 + 1024 + c])));
        }
    }
}
DEVNI void p2_dilated(const Params& p, long gt, long nt) {
    bf16_t* Q = (bf16_t*)(p.ws + OFF_Q); const bf16_t* K = (const bf16_t*)(p.ws + OFF_K); const bf16_t* V = (const bf16_t*)(p.ws + OFF_V);
    float* LSE = (float*)(p.ws + OFF_LSE);
    for (long i = gt; i < (long)T_ * 12; i += nt) {
        const int t = (int)(i / 12), hh = (int)(i % 12), g = hh >> 2, h = hh & 3, s = t % SEQ;
        const int dil = g == 0 ? 1 : (g == 1 ? 4 : 16);
        const float slope = exp2f(-8.0f * (float)(hh + 1) / 12.0f), scale = 0.08838834764831845f;
        bf16_t* qp = Q + (size_t)t * 1536 + hh * 128;
        float o[128], m = -1e30f, l = 0.f;
#pragma unroll
        for (int d = 0; d < 128; ++d) o[d] = 0.f;
        for (int jj = 0; jj <= 128; ++jj) {
            const int sk = s - jj * dil; if (sk < 0) break;
            const bf16_t* kp = K + (size_t)(t - jj * dil) * 1536 + hh * 128; const bf16_t* vp = V + (size_t)(t - jj * dil) * 1536 + hh * 128;
            float sc = 0.f;
#pragma nounroll
            for (int d = 0; d < 128; ++d) sc += bf2f(qp[d]) * bf2f(kp[d]);
            sc = sc * scale - slope * (float)(jj * dil);
            const float mn = fmaxf(m, sc), al = expf(m - mn), pe = expf(sc - mn);
            l = l * al + pe; m = mn;
#pragma unroll
            for (int d = 0; d < 128; ++d) o[d] = o[d] * al + pe * bf2f(vp[d]);
        }
        const float inv = 1.0f / l;
#pragma unroll
        for (int d = 0; d < 128; ++d) qp[d] = f2bf(o[d] * inv);
        LSE[((size_t)g * T_ + t) * 4 + h] = m + logf(l);
    }
}
DEVFN void p2_combine(const Params& p, long gt, long nt) {
    const bf16_t* Q = (const bf16_t*)(p.ws + OFF_Q); const bf16_t* ZB = (const bf16_t*)(p.ws + OFF_ZB); const float* LSE = (const float*)(p.ws + OFF_LSE); bf16_t* Y0 = (bf16_t*)(p.ws + OFF_Y0);
    for (long i = gt; i < (long)T_ * 512; i += nt) {
        const int t = (int)(i / 512), c = (int)(i % 512), h = c >> 7;
        const float l0 = LSE[((size_t)0 * T_ + t) * 4 + h], l1 = LSE[((size_t)1 * T_ + t) * 4 + h], l2 = LSE[((size_t)2 * T_ + t) * 4 + h];
        const float mx = fmaxf(l0, fmaxf(l1, l2)), e0 = expf(l0 - mx), e1 = expf(l1 - mx), e2 = expf(l2 - mx), inv = 1.0f / (e0 + e1 + e2);
        const float o = (e0 * bf2f(Q[(size_t)t * 1536 + c]) + e1 * bf2f(Q[(size_t)t * 1536 + 512 + c]) + e2 * bf2f(Q[(size_t)t * 1536 + 1024 + c])) * inv;
        Y0[(size_t)t * 1792 + 1024 + c] = f2bf(o * siluf_(bf2f(ZB[i])));
    }
}
DEVNI void mem_attn(const bf16_t* mkv, const bf16_t* QMb, const bf16_t* ZMb, bf16_t* Y, int ldy, long gt, long nt) {
    for (long i = gt; i < (long)T_ * 4; i += nt) {
        const int t = (int)(i / 4), h = (int)(i % 4), b = t / SEQ;
        const bf16_t* qp = QMb + (size_t)t * 256 + h * 64;
        float o[64], m = -1e30f, l = 0.f;
#pragma unroll
        for (int d = 0; d < 64; ++d) o[d] = 0.f;
        for (int j = 0; j < NMEM; ++j) {
            const bf16_t* kp = mkv + ((size_t)b * NMEM + j) * 512 + h * 64; const bf16_t* vp = kp + 256;
            float sc = 0.f;
#pragma nounroll
            for (int d = 0; d < 64; ++d) sc += bf2f(qp[d]) * bf2f(kp[d]);
            sc *= 0.125f;
            const float mn = fmaxf(m, sc), al = expf(m - mn), pe = expf(sc - mn);
            l = l * al + pe; m = mn;
#pragma unroll
            for (int d = 0; d < 64; ++d) o[d] = o[d] * al + pe * bf2f(vp[d]);
        }
        const float inv = 1.0f / l;
#pragma unroll
        for (int d = 0; d < 64; ++d) Y[(size_t)t * ldy + h * 64 + d] = f2bf(o[d] * inv * siluf_(bf2f(ZMb[(size_t)t * 256 + h * 64 + d])));
    }
}

DEVFN void p3_gemm(const Params& p, long gt, long nt) {
    const bf16_t* y = (const bf16_t*)(p.ws + OFF_Y0); const bf16_t* w = (const bf16_t*)(p.ws + OFF_W0OUT); float* x1 = (float*)(p.ws + OFF_X1);
    for (long i = gt; i < (long)T_ * DM; i += nt) {
        const int t = (int)(i / DM), n = (int)(i % DM);
        x1[i] = p.x[i] + dot_bf16(y + (size_t)t * HAWK_OUT, w + (size_t)n * HAWK_OUT, HAWK_OUT);
    }
}
DEVFN void p4_gemm(const Params& p, long gt, long nt) {
    const bf16_t* xn = (const bf16_t*)(p.ws + OFF_XN); const bf16_t* w = (const bf16_t*)(p.ws + OFF_W1IN);
    for (long i = gt; i < (long)T_ * NSA_IN; i += nt) {
        const int t = (int)(i / NSA_IN), n = (int)(i % NSA_IN);
        const float a = dot_bf16(xn + (size_t)t * DM, w + (size_t)n * DM, DM); const bf16_t v = f2bf(a);
        if (n < 1024) ((bf16_t*)(p.ws + OFF_Q1))[(size_t)t * 1024 + n] = v;
        else if (n < 1792) ((bf16_t*)(p.ws + OFF_KV1))[(size_t)t * 768 + n - 1024] = v;
        else if (n < 2816) ((bf16_t*)(p.ws + OFF_Z1))[(size_t)t * 1024 + n - 1792] = v;
        else if (n < 3072) ((bf16_t*)(p.ws + OFF_QM1))[(size_t)t * 256 + n - 2816] = v;
        else if (n < 3328) ((bf16_t*)(p.ws + OFF_ZM1))[(size_t)t * 256 + n - 3072] = v;
        else ((bf16_t*)(p.ws + OFF_GATE))[(size_t)t * 256 + n - 3328] = v;
    }
}
DEVFN void p5_cmp1(const Params& p, long gt, long nt) {
    const bf16_t* KV = (const bf16_t*)(p.ws + OFF_KV1); const bf16_t* w1 = (const bf16_t*)(p.ws + OFF_PHIW1); float* hid = (float*)(p.ws + OFF_CMPH);
    for (long i = gt; i < (long)2 * NB * 2 * 127 * 256; i += nt) {
        const int j = (int)(i % 256); long r = i / 256; const int n = (int)(r % 127); r /= 127; const int g = (int)(r % 2); r /= 2; const int b = (int)(r % NB), kv = (int)(r / NB);
        const float* pe = kv ? p.pe_v : p.pe_k; const bf16_t* wj = w1 + ((size_t)kv * 256 + j) * 2048;
        float acc = 0.f;
        for (int ii = 0; ii < 32; ++ii) { const bf16_t* tp = KV + ((size_t)b * SEQ + 16 * n + ii) * 768 + kv * 128 + g * 64;
            for (int d = 0; d < 64; ++d) acc += (bf2f(tp[d]) + pe[ii * 64 + d]) * bf2f(wj[ii * 64 + d]); }
        hid[((((size_t)kv * NB + b) * 2 + g) * 128 + n) * 256 + j] = siluf_(acc);
    }
}
DEVFN void p5_cmp2(const Params& p, long gt, long nt) {
    const float* hid = (const float*)(p.ws + OFF_CMPH); bf16_t* ckv = (bf16_t*)(p.ws + OFF_CMPKV);
    for (long i = gt; i < (long)2 * NB * 2 * 128 * 64; i += nt) {
        const int d = (int)(i % 64); long r = i / 64; const int n = (int)(r % 128); r /= 128; const int g = (int)(r % 2); r /= 2; const int b = (int)(r % NB), kv = (int)(r / NB);
        const float* w2 = kv ? p.phiv_w2 : p.phik_w2; const size_t row = (((size_t)kv * NB + b) * 2 + g) * 128 + n;
        float acc = 0.f;
        if (n < 127) for (int j = 0; j < 256; ++j) acc += hid[row * 256 + j] * w2[j * 64 + d];
        ckv[row * 64 + d] = f2bf(acc);
    }
}
DEVNI void p5_cmp_attn(const Params& p, long gt, long nt) {
    const bf16_t* Q1 = (const bf16_t*)(p.ws + OFF_Q1); const bf16_t* ckv = (const bf16_t*)(p.ws + OFF_CMPKV); const bf16_t* gate = (const bf16_t*)(p.ws + OFF_GATE);
    unsigned* SEL = (unsigned*)(p.ws + OFF_SEL); float* ocmp = p.out; float* IMP = (float*)(p.ws + OFF_IMP);
    for (long i = gt; i < (long)NB * 2 * SEQ; i += nt) {
        const int s = (int)(i % SEQ), g = (int)((i / SEQ) % 2), b = (int)(i / (2 * SEQ)); const int t = b * SEQ + s;
        const bf16_t* kc = ckv + (((size_t)0 * NB + b) * 2 + g) * 128 * 64; const bf16_t* vc = ckv + (((size_t)1 * NB + b) * 2 + g) * 128 * 64;
        const int nvis = s >= 31 ? (s - 31) / 16 + 1 : 0;
        float* imp = IMP + (size_t)i * 32;
        for (int r = 0; r < 8; ++r) {
            const int hidx = g * 8 + r; const float slope = exp2f(-0.5f * (float)(hidx + 1));
            const bf16_t* qp = Q1 + (size_t)t * 1024 + hidx * 64;
            float m = -1e30f;
            for (int n = 0; n < nvis; ++n) { float sc = 0.f;
_Pragma("nounroll") for (int d = 0; d < 64; ++d) sc += bf2f(qp[d]) * bf2f(kc[n * 64 + d]);
                sc = sc * 0.125f - slope * (float)(s - (16 * n + 31)); m = fmaxf(m, sc); }
            float l = 0.f;
            for (int n = 0; n < nvis; ++n) { float sc = 0.f;
_Pragma("nounroll") for (int d = 0; d < 64; ++d) sc += bf2f(qp[d]) * bf2f(kc[n * 64 + d]);
                sc = sc * 0.125f - slope * (float)(s - (16 * n + 31)); l += expf(sc - m); }
            const float inv = nvis > 0 ? 1.0f / l : 0.f;
            float o[64];
#pragma unroll
            for (int d = 0; d < 64; ++d) o[d] = 0.f;
            float carry = 0.f;
            for (int j = 0; j < 32; ++j) {
                float acc = carry; carry = 0.f;
                for (int q4 = 0; q4 < 4; ++q4) { const int n = 4 * j + q4;
                    if (n < nvis) { float sc = 0.f;
_Pragma("nounroll") for (int d = 0; d < 64; ++d) sc += bf2f(qp[d]) * bf2f(kc[n * 64 + d]);
                        sc = sc * 0.125f - slope * (float)(s - (16 * n + 31)); const float pr = expf(sc - m) * inv;
                        acc += pr; if (q4 == 3) carry = pr;
#pragma unroll
                        for (int d = 0; d < 64; ++d) o[d] += pr * bf2f(vc[n * 64 + d]); } }
                imp[j] = (r == 0 ? 0.f : imp[j]) + acc;
            }
            const float g0 = sigmoidf_(bf2f(gate[(size_t)t * 256 + hidx * 3 + 0]));
#pragma unroll
            for (int d = 0; d < 64; ++d) ocmp[(size_t)t * 1024 + hidx * 64 + d] = g0 * o[d];
        }
        const int cur = s >> 6; unsigned mask = 1u | (1u << cur) | (cur > 0 ? (1u << (cur - 1)) : 0u);
        const int nf = cur == 0 ? 1 : (cur == 1 ? 2 : 3), need = 8 - nf;
        for (int j = 1; j < 30; ++j) {
            if (j <= cur - 2) { int rank = 0;
                for (int j2 = 1; j2 < 30; ++j2) if (j2 <= cur - 2 && j2 != j) rank += (imp[j2] > imp[j] || (imp[j2] == imp[j] && j2 < j)) ? 1 : 0;
                if (rank < need) mask |= 1u << j; }
        }
        SEL[i] = mask;
    }
}
DEVNI void p5_slc_win(const Params& p, long gt, long nt) {
    const bf16_t* Q1 = (const bf16_t*)(p.ws + OFF_Q1); const bf16_t* KV = (const bf16_t*)(p.ws + OFF_KV1); const bf16_t* gate = (const bf16_t*)(p.ws + OFF_GATE);
    const unsigned* SEL = (const unsigned*)(p.ws + OFF_SEL); const float* ocmp = p.out; const bf16_t* Z1 = (const bf16_t*)(p.ws + OFF_Z1); bf16_t* Y1 = (bf16_t*)(p.ws + OFF_Y1);
    for (long i = gt; i < (long)T_ * 16; i += nt) {
        const int t = (int)(i / 16), hidx = (int)(i % 16), g = hidx >> 3, b = t / SEQ, s = t % SEQ;
        const float slope = exp2f(-0.5f * (float)(hidx + 1));
        const bf16_t* qp = Q1 + (size_t)t * 1024 + hidx * 64;
        const unsigned mask = SEL[((size_t)b * 2 + g) * SEQ + s];
        float res[64];
        {
            float o[64], m = -1e30f, l = 0.f;
#pragma unroll
            for (int d = 0; d < 64; ++d) o[d] = 0.f;
            for (int j = 0; j < 32; ++j) { if (!((mask >> j) & 1u)) continue;
                for (int kk = 0; kk < 64; ++kk) { const int kpos = j * 64 + kk; if (kpos > s) break;
                    const bf16_t* kp = KV + ((size_t)b * SEQ + kpos) * 768 + 2 * 128 + g * 64; const bf16_t* vp = kp + 128;
                    float sc = 0.f;
#pragma nounroll
                    for (int d = 0; d < 64; ++d) sc += bf2f(qp[d]) * bf2f(kp[d]);
                    sc = sc * 0.125f - slope * (float)(s - kpos);
                    const float mn = fmaxf(m, sc), al = expf(m - mn), pe = expf(sc - mn); l = l * al + pe; m = mn;
#pragma unroll
                    for (int d = 0; d < 64; ++d) o[d] = o[d] * al + pe * bf2f(vp[d]); } }
            const float g1 = sigmoidf_(bf2f(gate[(size_t)t * 256 + hidx * 3 + 1])) / l;
#pragma unroll
            for (int d = 0; d < 64; ++d) res[d] = ocmp[(size_t)t * 1024 + hidx * 64 + d] + g1 * o[d];
        }
        {
            float o[64], m = -1e30f, l = 0.f;
#pragma unroll
            for (int d = 0; d < 64; ++d) o[d] = 0.f;
            for (int kpos = (s - 511 > 0 ? s - 511 : 0); kpos <= s; ++kpos) {
                const bf16_t* kp = KV + ((size_t)b * SEQ + kpos) * 768 + 4 * 128 + g * 64; const bf16_t* vp = kp + 128;
                float sc = 0.f;
#pragma nounroll
                for (int d = 0; d < 64; ++d) sc += bf2f(qp[d]) * bf2f(kp[d]);
                sc = sc * 0.125f - slope * (float)(s - kpos);
                const float mn = fmaxf(m, sc), al = expf(m - mn), pe = expf(sc - mn); l = l * al + pe; m = mn;
#pragma unroll
                for (int d = 0; d < 64; ++d) o[d] = o[d] * al + pe * bf2f(vp[d]); }
            const float g2 = sigmoidf_(bf2f(gate[(size_t)t * 256 + hidx * 3 + 2])) / l;
#pragma unroll
            for (int d = 0; d < 64; ++d) res[d] += g2 * o[d];
        }
#pragma unroll
        for (int d = 0; d < 64; ++d) Y1[(size_t)t * 1280 + hidx * 64 + d] = f2bf(res[d] * siluf_(bf2f(Z1[(size_t)t * 1024 + hidx * 64 + d])));
    }
}
DEVFN void p6_gemm(const Params& p, long gt, long nt) {
    const bf16_t* y = (const bf16_t*)(p.ws + OFF_Y1); const bf16_t* w = (const bf16_t*)(p.ws + OFF_W1OUT); const float* x1 = (const float*)(p.ws + OFF_X1);
    for (long i = gt; i < (long)T_ * DM; i += nt) {
        const int t = (int)(i / DM), n = (int)(i % DM);
        p.out[i] = x1[i] + dot_bf16(y + (size_t)t * NSA_OUT, w + (size_t)n * NSA_OUT, NSA_OUT);
    }
}
DEVFN void p7_final(const Params& p, long gt, long nt) {
    for (long r = gt; r < T_; r += nt) {
        float* xr = p.out + (size_t)r * DM; float ss = 0.f;
        for (int k = 0; k < DM; ++k) ss += xr[k] * xr[k];
        const float rs = 1.0f / sqrtf(ss / DM + EPS);
        for (int k = 0; k < DM; ++k) xr[k] = xr[k] * rs * p.final_norm[k];
    }
}

#ifndef HOST_EMU
static_assert(DM == 1024 && NB == 8, "device build is for the real shapes");
#define LAS __attribute__((address_space(3)))
#define GAS __attribute__((address_space(1)))
typedef unsigned v4u __attribute__((ext_vector_type(4)));
typedef float f32x4 __attribute__((ext_vector_type(4)));
typedef short bf16x8 __attribute__((ext_vector_type(8)));
#define LDS_WAIT() asm volatile("s_waitcnt lgkmcnt(0)" ::: "memory")
#define VM_WAIT() asm volatile("s_waitcnt vmcnt(0)" ::: "memory")
__device__ __forceinline__ unsigned pk2(float lo, float hi) { return (unsigned)f2bf(lo) | ((unsigned)f2bf(hi) << 16); }

__device__ __forceinline__ int fresh_tid();
namespace pg8 {
constexpr int BM = 256, BK = 64, HALF = 128, HTB = HALF * BK * 2  , STAGE_BYTES = 8 * HTB, NXCD = 8, WGM = 8;
__host__ __device__ __forceinline__ int lds_byte(int r, int c) { const int st = (r >> 4) * 2 + (c >> 5), rr = r & 15, cc = c & 31, ob = rr * 64 + cc * 2; return st * 1024 + (ob ^ (((ob >> 9) & 1) << 5)); }
__host__ __device__ __forceinline__ void stage_rc(int b, int& R, int& C) { const int st = b / 1024, sb = b % 1024, swz = sb ^ (((sb >> 9) & 1) << 5); R = (st >> 1) * 16 + swz / 64; C = (st & 1) * 32 + (swz % 64) / 2; }
__host__ __device__ __forceinline__ int perm32(int rho) { const int n = rho >> 4, i = rho & 15; return 8 * (i >> 2) + 4 * n + (i & 3); }
struct Unit { int pm, pn; };
struct Gemm { const bf16_t* A; const bf16_t* Bt; int M, N, K; };
struct StaticOrder {
    int nM, nN, nwg, G, c;
    __host__ __device__ void init(int M, int N, int G_, int c_) { nM = M / BM; nN = N / BM; nwg = nM * nN; G = G_; c = c_; }
    __host__ __device__ bool next(int i, Unit& u) const {
        const long L = (long)i * G + c; if (L >= nwg) return false;
        int wgid = (int)L; { const int q = nwg / NXCD, r = nwg % NXCD, xcd = wgid % NXCD, off = wgid / NXCD; wgid = (xcd < r ? xcd * (q + 1) : r * (q + 1) + (xcd - r) * q) + off; }
        const int nig = WGM * nN, gid = wgid / nig, fm = gid * WGM, gsz = (nM - fm) < WGM ? (nM - fm) : WGM;
        u.pm = fm + ((wgid % nig) % gsz); u.pn = (wgid % nig) / gsz; return true;
    }
    __device__ __forceinline__ void a_ready(const Unit&) const {}
    __device__ __forceinline__ void done(const Unit&) const {}
};
typedef __bf16 bf16x2_t __attribute__((ext_vector_type(2)));
__device__ __forceinline__ unsigned cvt_pk_bf16(float lo, float hi) { const bf16x2_t v = {(__bf16)lo, (__bf16)hi}; return __builtin_bit_cast(unsigned, v); }

struct EpiRoute {
    static constexpr bool PERM = true, AFTER_DRAIN = false;
    unsigned char* ws; bf16_t* xaza; int layer;
    __device__ __forceinline__ void operator()(const f32x4 (&acc)[2][2][4][2], const Unit& u, int wr, int wc, int fr, int fq) const {
        bf16_t* base; int ldc, colt; const int pn = u.pn;
        if (layer == 0) {
            if (pn < 8) { base = xaza; ldc = 2048; colt = pn * 256; }
            else if (pn < 14) { base = (bf16_t*)(ws + OFF_Q); ldc = 1536; colt = (pn - 8) * 256; }
            else if (pn < 20) { base = (bf16_t*)(ws + OFF_K); ldc = 1536; colt = (pn - 14) * 256; }
            else if (pn < 26) { base = (bf16_t*)(ws + OFF_V); ldc = 1536; colt = (pn - 20) * 256; }
            else if (pn < 28) { base = (bf16_t*)(ws + OFF_ZB); ldc = 512; colt = (pn - 26) * 256; }
            else if (pn < 29) { base = (bf16_t*)(ws + OFF_QM); ldc = 256; colt = 0; }
            else { base = (bf16_t*)(ws + OFF_ZM); ldc = 256; colt = 0; }
        } else {
            if (pn < 4) { base = (bf16_t*)(ws + OFF_Q1); ldc = 1024; colt = pn * 256; }
            else if (pn < 7) { base = (bf16_t*)(ws + OFF_KV1); ldc = 768; colt = (pn - 4) * 256; }
            else if (pn < 11) { base = (bf16_t*)(ws + OFF_Z1); ldc = 1024; colt = (pn - 7) * 256; }
            else if (pn < 12) { base = (bf16_t*)(ws + OFF_QM1); ldc = 256; colt = 0; }
            else if (pn < 13) { base = (bf16_t*)(ws + OFF_ZM1); ldc = 256; colt = 0; }
            else { base = (bf16_t*)(ws + OFF_GATE); ldc = 256; colt = 0; }
        }
        const int row0 = u.pm * BM + wr * 64 + fr, col0 = colt + wc * 32 + 8 * fq;
#pragma unroll
        for (int ai = 0; ai < 2; ++ai)
#pragma unroll
            for (int m = 0; m < 4; ++m) { bf16_t* rowp = base + (size_t)(row0 + ai * HALF + m * 16) * ldc + col0;
#pragma unroll
                for (int bj = 0; bj < 2; ++bj) { const f32x4 v0 = acc[ai][bj][m][0], v1 = acc[ai][bj][m][1];
                    v4u w; w.x = cvt_pk_bf16(v0[0], v0[1]); w.y = cvt_pk_bf16(v0[2], v0[3]); w.z = cvt_pk_bf16(v1[0], v1[1]); w.w = cvt_pk_bf16(v1[2], v1[3]);
                    *(v4u*)(rowp + bj * HALF) = w; } }
    }
};
struct EpiResid {
    static constexpr bool PERM = false, AFTER_DRAIN = false;
    const float* base; float* out; int ldc;
    __device__ __forceinline__ void operator()(const f32x4 (&acc)[2][2][4][2], const Unit& u, int wr, int wc, int fr, int fq) const {
        const int col0 = u.pn * BM + wc * 32 + 4 * fq;
#pragma unroll
        for (int ai = 0; ai < 2; ++ai)
#pragma unroll
            for (int m = 0; m < 4; ++m) { const size_t off = (size_t)(u.pm * BM + ai * HALF + wr * 64 + m * 16 + fr) * ldc + col0;
#pragma unroll
                for (int bj = 0; bj < 2; ++bj)
#pragma unroll
                    for (int n = 0; n < 2; ++n) { const f32x4 bs = *(const f32x4*)(base + off + bj * HALF + n * 16); *(f32x4*)(out + off + bj * HALF + n * 16) = bs + acc[ai][bj][m][n]; } }
    }
};

template <class Epi, class Sched, bool ALIGN_EPI = false, bool SP2 = false>
__device__ __forceinline__ void gemm_phase(LAS unsigned char* lds, const Gemm g, const Sched& S, const Epi& E) {
    const int tid = fresh_tid(), wid = __builtin_amdgcn_readfirstlane(tid >> 6), lane = tid & 63, wr = wid >> 2, wc = wid & 3, fr = lane & 15, fq = lane >> 4;
    const int K = g.K, nt = K / BK;
    unsigned voffA[2], voffB[2];
#pragma unroll
    for (int i = 0; i < 2; ++i) { int R, C; stage_rc(tid * 16 + i * 8192, R, C); const int Rb = Epi::PERM ? ((R & ~31) + perm32(R & 31)) : R;
        voffA[i] = (unsigned)(R * K + C) * 2u; voffB[i] = (unsigned)(Rb * K + C) * 2u; }
    const size_t kstep = (size_t)(BK * 2);
    const size_t hstep = (size_t)HALF * K * 2;
    const size_t tstep = 2 * hstep;
    const unsigned ldsw = (unsigned)wid * 1024u;
    const int aoff = lds_byte(wr * 64 + fr, fq * 8), boff = lds_byte(wc * 32 + fr, fq * 8);
#define PG8_SA(b, h) (((b) * 2 + (h)) * HTB)
#define PG8_SB(b, h) ((4 + (b) * 2 + (h)) * HTB)
#define PG8_STAGE(bufoff, gbase, voff) do { _Pragma("unroll") for (int _i = 0; _i < 2; ++_i) \
        __builtin_amdgcn_global_load_lds((const unsigned*)((const char*)(gbase) + (voff)[_i]), (LAS unsigned*)(lds + (bufoff) + ldsw + _i * 8192), 16, 0, 0); } while (0)
#define PG8_LDA(dst, b, h) do { _Pragma("unroll") for (int m = 0; m < 4; ++m) _Pragma("unroll") for (int k = 0; k < 2; ++k) dst[m][k] = *(const LAS bf16x8*)(lds + PG8_SA(b, h) + aoff + m * 2048 + k * 1024); } while (0)
#define PG8_LDB(dst, b, h) do { _Pragma("unroll") for (int n = 0; n < 2; ++n) _Pragma("unroll") for (int k = 0; k < 2; ++k) dst[n][k] = *(const LAS bf16x8*)(lds + PG8_SB(b, h) + boff + n * 2048 + k * 1024); } while (0)
#define PG8_MMA(ai, bj, At, Bt) do { __builtin_amdgcn_s_setprio(1); _Pragma("unroll") for (int m = 0; m < 4; ++m) _Pragma("unroll") for (int n = 0; n < 2; ++n) _Pragma("unroll") for (int k = 0; k < 2; ++k) \
        acc[ai][bj][m][n] = __builtin_amdgcn_mfma_f32_16x16x32_bf16(Bt[n][k], At[m][k], acc[ai][bj][m][n], 0, 0, 0); __builtin_amdgcn_s_setprio(0); } while (0)
#define PG8_WAIT_V(n) asm volatile("s_waitcnt vmcnt(" #n ")" ::: "memory")
#define PG8_WAIT_L(n) asm volatile("s_waitcnt lgkmcnt(" #n ")" ::: "memory")
#define PG8_BAR __builtin_amdgcn_s_barrier()
#define PG8_SCHED __builtin_amdgcn_sched_barrier(0)
    Unit cur, nxt; int ui = 0;
    if (!S.next(0, cur)) return;
    f32x4 acc[2][2][4][2];
#pragma unroll
    for (int a = 0; a < 2; ++a)
#pragma unroll
        for (int b = 0; b < 2; ++b)
#pragma unroll
            for (int m = 0; m < 4; ++m)
#pragma unroll
                for (int n = 0; n < 2; ++n) acc[a][b][m][n] = (f32x4){0.f, 0.f, 0.f, 0.f};
    bf16x8 At[4][2], B0[2][2], B1[2][2];
    const char* cA = (const char*)g.A + (size_t)cur.pm * tstep; const char* cB = (const char*)g.Bt + (size_t)cur.pn * tstep;
    S.a_ready(cur);
    if constexpr (SP2) {
        PG8_STAGE(PG8_SB(0, 0), cB, voffB); PG8_STAGE(PG8_SB(0, 1), cB + hstep, voffB); PG8_STAGE(PG8_SA(0, 0), cA, voffA); PG8_STAGE(PG8_SA(0, 1), cA + hstep, voffA);
        if (wr == 1) PG8_BAR;
        PG8_WAIT_V(2); PG8_BAR;
        PG8_STAGE(PG8_SB(1, 0), cB + kstep, voffB); PG8_STAGE(PG8_SA(1, 0), cA + kstep, voffA); PG8_STAGE(PG8_SB(1, 1), cB + hstep + kstep, voffB);
        PG8_WAIT_V(6); PG8_BAR;
    } else {
        PG8_STAGE(PG8_SB(0, 0), cB, voffB); PG8_STAGE(PG8_SA(0, 0), cA, voffA); PG8_STAGE(PG8_SB(0, 1), cB + hstep, voffB); PG8_STAGE(PG8_SA(0, 1), cA + hstep, voffA);
        if (wr == 1) PG8_BAR;
        PG8_WAIT_V(4); PG8_BAR;
        PG8_STAGE(PG8_SB(1, 0), cB + kstep, voffB); PG8_STAGE(PG8_SA(1, 0), cA + kstep, voffA); PG8_STAGE(PG8_SB(1, 1), cB + hstep + kstep, voffB);
        PG8_WAIT_V(6); PG8_BAR;
    }
    for (;;) {
        const bool has_next = S.next(ui + 1, nxt);
        const char* nA = has_next ? (const char*)g.A + (size_t)nxt.pm * tstep : cA; const char* nB = has_next ? (const char*)g.Bt + (size_t)nxt.pn * tstep : cB;
        for (int t = 0; t < nt; t += 2) {
            const bool last = (t == nt - 2);
            const char* a1 = cA + (size_t)(t + 1) * kstep;
            const char* a2 = last ? nA : cA + (size_t)(t + 2) * kstep; const char* b2 = last ? nB : cB + (size_t)(t + 2) * kstep;
            const char* a3 = a2 + kstep; const char* b3 = b2 + kstep;
            if (last && has_next) S.a_ready(nxt);
            if constexpr (SP2) {
            PG8_LDB(B0, 0, 0); PG8_LDB(B1, 0, 1); PG8_SCHED; PG8_LDA(At, 0, 0); PG8_STAGE(PG8_SA(1, 1), a1 + hstep, voffA);
            PG8_WAIT_V(8); PG8_WAIT_L(0); PG8_BAR; PG8_MMA(0, 0, At, B0); PG8_MMA(0, 1, At, B1); PG8_BAR; PG8_SCHED;
            PG8_LDA(At, 0, 1); PG8_STAGE(PG8_SB(0, 0), b2, voffB); PG8_STAGE(PG8_SB(0, 1), b2 + hstep, voffB); PG8_STAGE(PG8_SA(0, 0), a2, voffA);
            PG8_WAIT_V(8); PG8_WAIT_L(0); PG8_BAR; PG8_MMA(1, 0, At, B0); PG8_MMA(1, 1, At, B1); PG8_BAR; PG8_SCHED;
            PG8_LDB(B0, 1, 0); PG8_LDB(B1, 1, 1); PG8_SCHED; PG8_LDA(At, 1, 0); PG8_STAGE(PG8_SA(0, 1), a2 + hstep, voffA);
            PG8_WAIT_V(8); PG8_WAIT_L(0); PG8_BAR; PG8_MMA(0, 0, At, B0); PG8_MMA(0, 1, At, B1); PG8_BAR; PG8_SCHED;
            PG8_LDA(At, 1, 1); PG8_STAGE(PG8_SB(1, 0), b3, voffB); PG8_STAGE(PG8_SB(1, 1), b3 + hstep, voffB); PG8_STAGE(PG8_SA(1, 0), a3, voffA);
            PG8_WAIT_V(8); PG8_WAIT_L(0); PG8_BAR; PG8_MMA(1, 0, At, B0); PG8_MMA(1, 1, At, B1); PG8_BAR; PG8_SCHED;
            } else {
            PG8_LDB(B0, 0, 0); PG8_SCHED; PG8_LDA(At, 0, 0); PG8_STAGE(PG8_SA(1, 1), a1 + hstep, voffA);
            PG8_WAIT_L(8); PG8_BAR; PG8_WAIT_L(0); PG8_MMA(0, 0, At, B0); PG8_BAR; PG8_SCHED;
            PG8_LDB(B1, 0, 1); PG8_STAGE(PG8_SB(0, 0), b2, voffB);
            PG8_BAR; PG8_WAIT_L(0); PG8_MMA(0, 1, At, B1); PG8_BAR;
            PG8_LDA(At, 0, 1); PG8_STAGE(PG8_SA(0, 0), a2, voffA);
            PG8_BAR; PG8_WAIT_L(0); PG8_MMA(1, 0, At, B0); PG8_BAR; PG8_SCHED;
            PG8_STAGE(PG8_SB(0, 1), b2 + hstep, voffB);
            PG8_WAIT_V(6); PG8_BAR; PG8_MMA(1, 1, At, B1); PG8_BAR;
            PG8_LDB(B0, 1, 0); PG8_SCHED; PG8_LDA(At, 1, 0); PG8_STAGE(PG8_SA(0, 1), a2 + hstep, voffA);
            PG8_WAIT_L(8); PG8_BAR; PG8_WAIT_L(0); PG8_MMA(0, 0, At, B0); PG8_BAR; PG8_SCHED;
            PG8_LDB(B1, 1, 1); PG8_STAGE(PG8_SB(1, 0), b3, voffB);
            PG8_BAR; PG8_WAIT_L(0); PG8_MMA(0, 1, At, B1); PG8_BAR;
            PG8_LDA(At, 1, 1); PG8_STAGE(PG8_SA(1, 0), a3, voffA);
            PG8_BAR; PG8_WAIT_L(0); PG8_MMA(1, 0, At, B0); PG8_BAR; PG8_SCHED;
            PG8_STAGE(PG8_SB(1, 1), b3 + hstep, voffB);
            PG8_WAIT_V(6); PG8_BAR; PG8_MMA(1, 1, At, B1); PG8_BAR;
            }
        }
        if constexpr (ALIGN_EPI) { if (wr == 0) PG8_BAR; }
        if constexpr (!Epi::AFTER_DRAIN) { E(acc, cur, wr, wc, fr, fq); S.done(cur); }
        if (!has_next) break;
#pragma unroll
        for (int a = 0; a < 2; ++a)
#pragma unroll
            for (int b = 0; b < 2; ++b)
#pragma unroll
                for (int m = 0; m < 4; ++m)
#pragma unroll
                    for (int n = 0; n < 2; ++n) acc[a][b][m][n] = (f32x4){0.f, 0.f, 0.f, 0.f};
        cur = nxt; cA = nA; cB = nB; ++ui;
        if constexpr (ALIGN_EPI) { if (wr == 1) PG8_BAR; }
    }
    PG8_WAIT_V(0);
    if constexpr (!ALIGN_EPI) { if (wr == 0) PG8_BAR; }
    PG8_BAR;
#undef PG8_SA
#undef PG8_SB
#undef PG8_STAGE
#undef PG8_LDA
#undef PG8_LDB
#undef PG8_MMA
#undef PG8_WAIT_V
#undef PG8_WAIT_L
#undef PG8_BAR
#undef PG8_SCHED
}
}

constexpr int NWAVES = 8, LDS_BYTES = 147456;
__device__ __forceinline__ float wave_sum(float v) {
#pragma unroll
    for (int o = 1; o < 64; o <<= 1) v += __shfl_xor(v, o);
    return v;
}
template <bool PERM>
__device__ __forceinline__ void p0_transpose_item(const float* W, int K, int N, int NP, bf16_t* WT, LAS float* scr, int item, int lane) {
    const int nblk = NP / 32, kb = item / nblk, nb = item % nblk, k0 = 64 * kb, n0 = 32 * nb;
    int ncol = n0 + (lane & 31); if (PERM) ncol = nsa_col_orig(ncol);
#pragma unroll 8
    for (int i = 0; i < 32; ++i) { const int kk = 2 * i + (lane >> 5); scr[kk * 33 + (lane & 31)] = ncol >= 0 ? W[(size_t)(k0 + kk) * N + ncol] : 0.f; }
    LDS_WAIT(); asm volatile("" ::: "memory");
    const int c = lane & 7;
#pragma unroll
    for (int j = 0; j < 4; ++j) { const int n = (lane >> 3) + 8 * j; const LAS float* s = scr + (8 * c) * 33 + n;
        v4u o; o.x = pk2(s[0 * 33], s[1 * 33]); o.y = pk2(s[2 * 33], s[3 * 33]); o.z = pk2(s[4 * 33], s[5 * 33]); o.w = pk2(s[6 * 33], s[7 * 33]);
        *(v4u*)(WT + (size_t)(n0 + n) * K + k0 + 8 * c) = o; }
    LDS_WAIT(); asm volatile("" ::: "memory");
}
__device__ __forceinline__ void rms_row_to_bf16(const float* xrow, const float* g, bf16_t* orow, int lane) {
    const f32x4* xr = (const f32x4*)xrow + lane; const f32x4* gr = (const f32x4*)g + lane;
    f32x4 v[4]; float s = 0.f;
#pragma unroll
    for (int j = 0; j < 4; ++j) { v[j] = xr[64 * j]; s += (v[j].x * v[j].x + v[j].y * v[j].y) + (v[j].z * v[j].z + v[j].w * v[j].w); }
    const float rs = 1.f / sqrtf(wave_sum(s) * (1.f / 1024.f) + EPS);
    unsigned long long* o8 = (unsigned long long*)orow + lane;
#pragma unroll
    for (int j = 0; j < 4; ++j) { const f32x4 gg = gr[64 * j];
        o8[64 * j] = (unsigned long long)pk2(v[j].x * rs * gg.x, v[j].y * rs * gg.y) | ((unsigned long long)pk2(v[j].z * rs * gg.z, v[j].w * rs * gg.w) << 32); }
}
__device__ __forceinline__ void rms_row_inplace(float* xrow, const float* g, int lane) {
    f32x4* xr = (f32x4*)xrow + lane; const f32x4* gr = (const f32x4*)g + lane;
    f32x4 v[4]; float s = 0.f;
#pragma unroll
    for (int j = 0; j < 4; ++j) { v[j] = xr[64 * j]; s += (v[j].x * v[j].x + v[j].y * v[j].y) + (v[j].z * v[j].z + v[j].w * v[j].w); }
    const float rs = 1.f / sqrtf(wave_sum(s) * (1.f / 1024.f) + EPS);
#pragma unroll
    for (int j = 0; j < 4; ++j) xr[64 * j] = v[j] * rs * gr[64 * j];
}

typedef float f32x16 __attribute__((ext_vector_type(16)));
typedef short s16x4 __attribute__((ext_vector_type(4)));
typedef short v4i16_t __attribute__((ext_vector_type(4)));
typedef unsigned v2u __attribute__((ext_vector_type(2)));
#define MFMA32(a, b, c) __builtin_amdgcn_mfma_f32_32x32x16_bf16(a, b, c, 0, 0, 0)
constexpr float LOG2E = 1.4426950408889634f, LN2 = 0.6931471805599453f;
__device__ __forceinline__ int crow(int r, int hi) { return (r & 3) + 8 * (r >> 2) + 4 * hi; }
__device__ __forceinline__ s16x4 vtr(const LAS unsigned char* p) { return __builtin_bit_cast(s16x4, __builtin_amdgcn_ds_read_tr16_b64_v4i16((LAS v4i16_t*)p)); }
__device__ __forceinline__ float xmax32(float v) { auto rr = __builtin_amdgcn_permlane32_swap(__float_as_uint(v), __float_as_uint(v), false, false); return fmaxf(__uint_as_float(rr[0]), __uint_as_float(rr[1])); }
__device__ __forceinline__ float xsum32(float v) { auto rr = __builtin_amdgcn_permlane32_swap(__float_as_uint(v), __float_as_uint(v), false, false); return __uint_as_float(rr[0]) + __uint_as_float(rr[1]); }
__device__ __forceinline__ float ex2(float x) { return __builtin_amdgcn_exp2f(x); }
__device__ __forceinline__ bf16x8 pack8(const f32x16& v, int r0) {
    v4u w; w.x = pg8::cvt_pk_bf16(v[r0], v[r0 + 1]); w.y = pg8::cvt_pk_bf16(v[r0 + 2], v[r0 + 3]); w.z = pg8::cvt_pk_bf16(v[r0 + 4], v[r0 + 5]); w.w = pg8::cvt_pk_bf16(v[r0 + 6], v[r0 + 7]);
    return __builtin_bit_cast(bf16x8, w);
}
__device__ __forceinline__ bf16x8 vfrag(const LAS unsigned char* p) { const s16x4 a = vtr(p), b = vtr(p + 512); return (bf16x8){a[0], a[1], a[2], a[3], b[0], b[1], b[2], b[3]}; }

struct KVRegs { v4u k, v; };
__device__ __forceinline__ KVRegs kv_load(const bf16_t* Kg, const bf16_t* Vg, int ld, int tid) {
    const int key = (tid & 7) + 8 * (tid >> 6), ch = (tid >> 3) & 7;
    KVRegs r; r.k = *(const v4u*)(Kg + (size_t)key * ld + ch * 8); r.v = *(const v4u*)(Vg + (size_t)key * ld + ch * 8); return r;
}
__device__ __forceinline__ void kv_store(LAS unsigned char* buf, const KVRegs& r, int tid) {
    const int key = (tid & 7) + 8 * (tid >> 6), ch = (tid >> 3) & 7;
    *(LAS v4u*)(buf + ch * 1024 + key * 16) = r.k;
    *(LAS v4u*)(buf + 8192 + (ch >> 2) * 4096 + key * 64 + (ch & 3) * 16) = r.v;
}
struct Sm64 { f32x16 o[2]; float m, l; };
__device__ __forceinline__ void sm64_init(Sm64& st) {
#pragma unroll
    for (int r = 0; r < 16; ++r) { st.o[0][r] = 0.f; st.o[1][r] = 0.f; }
    st.m = -1e30f; st.l = 0.f;
}
__device__ __forceinline__ void qk64(f32x16& s0, f32x16& s1, const bf16x8 (&qf)[4], const LAS unsigned char* buf, int r32, int hi) {
    const LAS unsigned char* kp = buf + hi * 1024 + r32 * 16;
#pragma unroll
    for (int r = 0; r < 16; ++r) { s0[r] = 0.f; s1[r] = 0.f; }
#pragma unroll
    for (int d0 = 0; d0 < 4; ++d0) { const bf16x8 k0 = *(const LAS bf16x8*)(kp + d0 * 2048), k1 = *(const LAS bf16x8*)(kp + d0 * 2048 + 512);
        s0 = MFMA32(k0, qf[d0], s0); s1 = MFMA32(k1, qf[d0], s1); }
}
__device__ __forceinline__ void pv64(f32x16 (&o)[2], const f32x16& p0, const f32x16& p1, const LAS unsigned char* buf, int lane, int hi) {
    const bf16x8 pf0 = pack8(p0, 0), pf1 = pack8(p0, 8), pf2 = pack8(p1, 0), pf3 = pack8(p1, 8);
    const LAS unsigned char* vp = buf + 8192 + ((lane >> 4) & 1) * 32 + (lane & 3) * 8 + (4 * hi + ((lane & 15) >> 2)) * 64;
#pragma unroll
    for (int dt = 0; dt < 2; ++dt) {
        o[dt] = MFMA32(vfrag(vp + dt * 4096), pf0, o[dt]); o[dt] = MFMA32(vfrag(vp + dt * 4096 + 1024), pf1, o[dt]);
        o[dt] = MFMA32(vfrag(vp + dt * 4096 + 2048), pf2, o[dt]); o[dt] = MFMA32(vfrag(vp + dt * 4096 + 3072), pf3, o[dt]);
    }
}
template <class F>
__device__ __forceinline__ void tile64(Sm64& st, const bf16x8 (&qf)[4], const LAS unsigned char* buf, int lane, float c2, F f) {
    const int r32 = lane & 31, hi = lane >> 5;
    f32x16 s0, s1; qk64(s0, s1, qf, buf, r32, hi);
    float mx = -INFINITY;
#pragma unroll
    for (int r = 0; r < 16; ++r) { const int k0 = crow(r, hi); s0[r] = fmaf(s0[r], c2, f(k0)); s1[r] = fmaf(s1[r], c2, f(k0 + 32)); mx = fmaxf(mx, fmaxf(s0[r], s1[r])); }
    mx = xmax32(mx);
    const float mn = fmaxf(st.m, mx), al = ex2(st.m - mn);
    float sum = 0.f;
#pragma unroll
    for (int r = 0; r < 16; ++r) { s0[r] = ex2(s0[r] - mn); s1[r] = ex2(s1[r] - mn); sum += s0[r] + s1[r]; }
    sum = xsum32(sum);
    st.l = st.l * al + sum; st.m = mn;
#pragma unroll
    for (int r = 0; r < 16; ++r) { st.o[0][r] *= al; st.o[1][r] *= al; }
    pv64(st.o, s0, s1, buf, lane, hi);
}

__device__ __forceinline__ void nsa_unit(const Params& p, LAS unsigned char* lds, int unit) {
    const int tid = fresh_tid(), lane = tid & 63, r32 = lane & 31, hi = lane >> 5, w = __builtin_amdgcn_readfirstlane(tid >> 6);
    const int q32 = unit & 63, g = (unit >> 6) & 1, b = unit >> 7;
    const int q0 = q32 * 32, cur = q0 >> 6, hidx = g * 8 + w, s = q0 + r32;
    const size_t trow = (size_t)b * SEQ + s;
    const bf16_t* Q1 = (const bf16_t*)(p.ws + OFF_Q1); const bf16_t* KV = (const bf16_t*)(p.ws + OFF_KV1); const bf16_t* gate = (const bf16_t*)(p.ws + OFF_GATE);
    const bf16_t* ckv = (const bf16_t*)(p.ws + OFF_CMPKV); const bf16_t* Z1 = (const bf16_t*)(p.ws + OFF_Z1); bf16_t* Y1 = (bf16_t*)(p.ws + OFF_Y1);
    const float slope2 = exp2f(-0.5f * (float)(hidx + 1)) * LOG2E, c2 = 0.125f * LOG2E;
    LAS unsigned char* buf0 = lds; LAS unsigned char* buf1 = lds + 16384;
    LAS float* impw = (LAS float*)(lds + 32768) + w * 1024; LAS float* impt = (LAS float*)(lds + 65536); LAS unsigned* msk = (LAS unsigned*)(lds + 65536 + 4224);
    bf16x8 qf[4];
#pragma unroll
    for (int d0 = 0; d0 < 4; ++d0) qf[d0] = *(const bf16x8*)(Q1 + trow * 1024 + hidx * 64 + d0 * 16 + hi * 8);
    const float g0 = sigmoidf_(bf2f(gate[trow * 256 + hidx * 3 + 0])), g1 = sigmoidf_(bf2f(gate[trow * 256 + hidx * 3 + 1])), g2 = sigmoidf_(bf2f(gate[trow * 256 + hidx * 3 + 2]));
    f32x16 ot[2];
    {
        const bf16_t* kc = ckv + (((size_t)0 * NB + b) * 2 + g) * 128 * 64; const bf16_t* vc = ckv + (((size_t)1 * NB + b) * 2 + g) * 128 * 64;
        { const KVRegs r0 = kv_load(kc, vc, 64, tid), r1 = kv_load(kc + 64 * 64, vc + 64 * 64, 64, tid); kv_store(buf0, r0, tid); kv_store(buf1, r1, tid); }
        __syncthreads();
        f32x16 sc[4]; qk64(sc[0], sc[1], qf, buf0, r32, hi); qk64(sc[2], sc[3], qf, buf1, r32, hi);
        float mx = -INFINITY;
#pragma unroll
        for (int T = 0; T < 4; ++T)
#pragma unroll
            for (int r = 0; r < 16; ++r) { const int n = 32 * T + crow(r, hi), dist = s - (16 * n + 31);
                const float v = dist >= 0 ? fmaf(sc[T][r], c2, -slope2 * (float)dist) : -INFINITY; sc[T][r] = v; mx = fmaxf(mx, v); }
        mx = fmaxf(xmax32(mx), -1e30f);
        float sum = 0.f;
#pragma unroll
        for (int T = 0; T < 4; ++T)
#pragma unroll
            for (int r = 0; r < 16; ++r) { sc[T][r] = ex2(sc[T][r] - mx); sum += sc[T][r]; }
        sum = xsum32(sum);
        const float inv = sum > 0.f ? 1.0f / sum : 0.f;
        float prev_y = 0.f;
#pragma unroll
        for (int T = 0; T < 4; ++T)
#pragma unroll
            for (int c = 0; c < 4; ++c) { const float x3 = sc[T][4 * c + 3], y = __shfl_xor(x3, 32);
                const float sum4 = (sc[T][4 * c] + sc[T][4 * c + 1]) + (sc[T][4 * c + 2] + x3);
                impw[r32 * 32 + 8 * T + 2 * c + hi] = (sum4 + (hi ? y : prev_y)) * inv; prev_y = y; }
        f32x16 oc[2];
#pragma unroll
        for (int r = 0; r < 16; ++r) { oc[0][r] = 0.f; oc[1][r] = 0.f; }
        pv64(oc, sc[0], sc[1], buf0, lane, hi); pv64(oc, sc[2], sc[3], buf1, lane, hi);
        const float f0 = g0 * inv;
#pragma unroll
        for (int r = 0; r < 16; ++r) { ot[0][r] = oc[0][r] * f0; ot[1][r] = oc[1][r] * f0; }
    }
    __syncthreads();
    for (int idx = tid; idx < 1024; idx += 512) { float a = 0.f;
#pragma unroll
        for (int ww = 0; ww < 8; ++ww) a += ((LAS float*)(lds + 32768))[ww * 1024 + idx];
        impt[(idx >> 5) * 33 + (idx & 31)] = a; }
    __syncthreads();
    {
        const int nf = cur == 0 ? 1 : (cur == 1 ? 2 : 3), need = 8 - nf;
#pragma unroll
        for (int pi = 0; pi < 2; ++pi) {
            const int q = pi * 16 + 2 * w + hi, j = r32; bool sel;
            if (j == 0 || j == cur || j == cur - 1) sel = true;
            else if (j <= cur - 2) { const float v = impt[q * 33 + j]; int rank = 0;
                for (int j2 = 1; j2 <= cur - 2; ++j2) { const float v2 = impt[q * 33 + j2]; rank += (j2 != j && (v2 > v || (v2 == v && j2 < j))) ? 1 : 0; }
                sel = rank < need; }
            else sel = false;
            const unsigned long long bal = __ballot(sel);
            if (lane == 0) msk[pi * 16 + 2 * w] = (unsigned)bal;
            if (lane == 32) msk[pi * 16 + 2 * w + 1] = (unsigned)(bal >> 32);
        }
    }
    __syncthreads();
    const unsigned mymask = msk[r32];
    unsigned uni = mymask;
#pragma unroll
    for (int o = 1; o < 32; o <<= 1) uni |= (unsigned)__shfl_xor((int)uni, o);
    uni = (unsigned)__builtin_amdgcn_readfirstlane((int)uni);
    const int nslc = __builtin_popcount(uni), wlo = (q0 - 511 > 0 ? q0 - 511 : 0) >> 6, nwin = cur - wlo + 1, ntile = nslc + nwin;
    const bf16_t* kvb = KV + (size_t)b * SEQ * 768 + g * 64;
    unsigned rem_l = uni, rem_c = uni;
    auto tile_j = [&](int i, unsigned& rem) { int j; if (i < nslc) { j = __builtin_ctz(rem); rem &= rem - 1; } else j = wlo + (i - nslc); return j; };
    { const int j = tile_j(0, rem_l); const int col = 0 < nslc ? 256 : 512; const KVRegs r = kv_load(kvb + (size_t)64 * j * 768 + col, kvb + (size_t)64 * j * 768 + col + 128, 768, tid); kv_store(buf0, r, tid); }
    __syncthreads();
    Sm64 st; sm64_init(st);
    for (int i = 0; i < ntile; ++i) {
        KVRegs rn;
        if (i + 1 < ntile) { const int j = tile_j(i + 1, rem_l); const int col = (i + 1) < nslc ? 256 : 512; rn = kv_load(kvb + (size_t)64 * j * 768 + col, kvb + (size_t)64 * j * 768 + col + 128, 768, tid); }
        const int j = tile_j(i, rem_c); const LAS unsigned char* buf = (i & 1) ? buf1 : buf0;
        if (i < nslc) { const bool has = (mymask >> j) & 1u;
            tile64(st, qf, buf, lane, c2, [&](int kin) { const int kpos = 64 * j + kin; return (has && kpos <= s) ? slope2 * (float)(kpos - s) : -INFINITY; });
            if (i == nslc - 1) { const float f1 = g1 / st.l;
#pragma unroll
                for (int r = 0; r < 16; ++r) { ot[0][r] += st.o[0][r] * f1; ot[1][r] += st.o[1][r] * f1; }
                sm64_init(st); }
        } else {
            tile64(st, qf, buf, lane, c2, [&](int kin) { const int kpos = 64 * j + kin; return (kpos <= s && kpos >= s - 511) ? slope2 * (float)(kpos - s) : -INFINITY; });
        }
        if (i + 1 < ntile) kv_store((i & 1) ? buf0 : buf1, rn, tid);
        __syncthreads();
    }
    { const float f2 = g2 / st.l;
#pragma unroll
      for (int r = 0; r < 16; ++r) { ot[0][r] += st.o[0][r] * f2; ot[1][r] += st.o[1][r] * f2; } }
#pragma unroll
    for (int dt = 0; dt < 2; ++dt)
#pragma unroll
        for (int c = 0; c < 4; ++c) { const int d = 32 * dt + 8 * c + 4 * hi;
            const v2u zz = *(const v2u*)(Z1 + trow * 1024 + hidx * 64 + d);
            const float y0 = ot[dt][4 * c] * siluf_(lo16(zz.x)), y1 = ot[dt][4 * c + 1] * siluf_(hi16(zz.x)), y2 = ot[dt][4 * c + 2] * siluf_(lo16(zz.y)), y3 = ot[dt][4 * c + 3] * siluf_(hi16(zz.y));
            v2u o2; o2.x = pg8::cvt_pk_bf16(y0, y1); o2.y = pg8::cvt_pk_bf16(y2, y3);
            *(v2u*)(Y1 + trow * 1280 + hidx * 64 + d) = o2; }
}

__device__ __forceinline__ void mem_unit(const bf16_t* mkv, const bf16_t* QMb, const bf16_t* ZMb, bf16_t* Y, int ldy, LAS unsigned char* lds, int unit) {
    const int tid = fresh_tid(), lane = tid & 63, r32 = lane & 31, hi = lane >> 5, w = __builtin_amdgcn_readfirstlane(tid >> 6);
    const int qc = unit & 7, h = (unit >> 3) & 3, b = unit >> 5;
    const size_t trow = (size_t)b * SEQ + qc * 256 + w * 32 + r32;
    const bf16_t* kb = mkv + (size_t)b * NMEM * 512 + h * 64;
#pragma unroll
    for (int t = 0; t < 4; ++t) { const KVRegs r = kv_load(kb + (size_t)t * 64 * 512, kb + (size_t)t * 64 * 512 + 256, 512, tid); kv_store(lds + t * 16384, r, tid); }
    bf16x8 qf[4];
#pragma unroll
    for (int d0 = 0; d0 < 4; ++d0) qf[d0] = *(const bf16x8*)(QMb + trow * 256 + h * 64 + d0 * 16 + hi * 8);
    __syncthreads();
    Sm64 st; sm64_init(st);
#pragma unroll 1
    for (int t = 0; t < 4; ++t) tile64(st, qf, lds + t * 16384, lane, 0.125f * LOG2E, [](int) { return 0.f; });
    const float inv = 1.0f / st.l;
#pragma unroll
    for (int dt = 0; dt < 2; ++dt)
#pragma unroll
        for (int c = 0; c < 4; ++c) { const int d = 32 * dt + 8 * c + 4 * hi;
            const v2u zz = *(const v2u*)(ZMb + trow * 256 + h * 64 + d);
            const float y0 = st.o[dt][4 * c] * inv * siluf_(lo16(zz.x)), y1 = st.o[dt][4 * c + 1] * inv * siluf_(hi16(zz.x)), y2 = st.o[dt][4 * c + 2] * inv * siluf_(lo16(zz.y)), y3 = st.o[dt][4 * c + 3] * inv * siluf_(hi16(zz.y));
            v2u o2; o2.x = pg8::cvt_pk_bf16(y0, y1); o2.y = pg8::cvt_pk_bf16(y2, y3);
            *(v2u*)(Y + trow * ldy + h * 64 + d) = o2; }
    __syncthreads();
}

__device__ __forceinline__ void dil_task(const Params& p, LAS unsigned char* vl  , int task, int lane) {
    const int r32 = lane & 31, hi = lane >> 5;
    const int grp = task >> 11, idx = task & 2047, dil = grp == 0 ? 1 : (grp == 1 ? 4 : 16), lg = grp * 2, nq = 64 >> lg;
    const int qi = idx & (nq - 1), rest = idx >> (6 - lg), h = rest & 3, brho = rest >> 2, b = brho >> lg, rho = brho & (dil - 1);
    const int hh = grp * 4 + h, i0 = 32 * qi, isub = i0 + r32;
    bf16_t* Q = (bf16_t*)(p.ws + OFF_Q); const bf16_t* K = (const bf16_t*)(p.ws + OFF_K); const bf16_t* V = (const bf16_t*)(p.ws + OFF_V); float* LSE = (float*)(p.ws + OFF_LSE);
    const size_t base = (size_t)b * SEQ + rho;
    const size_t trow = base + (size_t)isub * dil;
    const float slope2 = exp2f(-8.0f * (float)(hh + 1) / 12.0f) * (float)dil * LOG2E, c2 = 0.08838834764831845f * LOG2E;
    bf16x8 qf[8];
#pragma unroll
    for (int d0 = 0; d0 < 8; ++d0) qf[d0] = *(const bf16x8*)(Q + trow * 1536 + hh * 128 + d0 * 16 + hi * 8);
    f32x16 o[4]; float m = -1e30f, l = 0.f;
#pragma unroll
    for (int dt = 0; dt < 4; ++dt)
#pragma unroll
        for (int r = 0; r < 16; ++r) o[dt][r] = 0.f;
    const LAS unsigned char* vp = vl + ((lane >> 4) & 1) * 32 + (lane & 3) * 8 + (4 * hi + ((lane & 15) >> 2)) * 64;
    for (int jt = (qi - 4 > 0 ? qi - 4 : 0); jt <= qi; ++jt) {
        asm volatile("s_waitcnt lgkmcnt(0)" ::: "memory");
#pragma unroll
        for (int it = 0; it < 8; ++it) { const int e = it * 64 + lane, key = e >> 4, ch = e & 15;
            const v4u v = *(const v4u*)(V + (base + (size_t)(32 * jt + key) * dil) * 1536 + hh * 128 + ch * 8);
            *(LAS v4u*)(vl + (ch >> 2) * 2048 + key * 64 + (ch & 3) * 16) = v; }
        f32x16 sc;
#pragma unroll
        for (int r = 0; r < 16; ++r) sc[r] = 0.f;
        const bf16_t* kr = K + (base + (size_t)(32 * jt + r32) * dil) * 1536 + hh * 128 + hi * 8;
#pragma unroll
        for (int d0 = 0; d0 < 8; ++d0) { const bf16x8 kf = *(const bf16x8*)(kr + d0 * 16); sc = MFMA32(kf, qf[d0], sc); }
        float mx = -INFINITY;
#pragma unroll
        for (int r = 0; r < 16; ++r) { const int dist = isub - (32 * jt + crow(r, hi));
            const float v = (dist >= 0 && dist <= 128) ? fmaf(sc[r], c2, -slope2 * (float)dist) : -INFINITY; sc[r] = v; mx = fmaxf(mx, v); }
        mx = xmax32(mx);
        const float mn = fmaxf(m, mx), al = ex2(m - mn);
        float sum = 0.f;
#pragma unroll
        for (int r = 0; r < 16; ++r) { sc[r] = ex2(sc[r] - mn); sum += sc[r]; }
        sum = xsum32(sum); l = l * al + sum; m = mn;
#pragma unroll
        for (int dt = 0; dt < 4; ++dt)
#pragma unroll
            for (int r = 0; r < 16; ++r) o[dt][r] *= al;
        const bf16x8 pf0 = pack8(sc, 0), pf1 = pack8(sc, 8);
        asm volatile("s_waitcnt lgkmcnt(0)" ::: "memory");
#pragma unroll
        for (int dt = 0; dt < 4; ++dt) { o[dt] = MFMA32(vfrag(vp + dt * 2048), pf0, o[dt]); o[dt] = MFMA32(vfrag(vp + dt * 2048 + 1024), pf1, o[dt]); }
    }
    const float inv = 1.0f / l;
#pragma unroll
    for (int dt = 0; dt < 4; ++dt)
#pragma unroll
        for (int c = 0; c < 4; ++c) { const int d = 32 * dt + 8 * c + 4 * hi;
            v2u o2; o2.x = pg8::cvt_pk_bf16(o[dt][4 * c] * inv, o[dt][4 * c + 1] * inv); o2.y = pg8::cvt_pk_bf16(o[dt][4 * c + 2] * inv, o[dt][4 * c + 3] * inv);
            *(v2u*)(Q + trow * 1536 + hh * 128 + d) = o2; }
    if (hi == 0) LSE[((size_t)grp * T_ + trow) * 4 + h] = (m + __builtin_amdgcn_logf(l)) * LN2;
}

#define GSYNC() grid.sync()
__device__ __forceinline__ int fresh_tid() { int t = threadIdx.x; asm volatile("" : "+v"(t)); return t; }
#define PH_IDS() const int tid = fresh_tid(), lane = tid & 63, wave = __builtin_amdgcn_readfirstlane(tid >> 6); const long gt = (long)blockIdx.x * 512 + tid, nt = (long)G * 512; \
    const int gw = blockIdx.x * NWAVES + wave, NGW = G * NWAVES; (void)lane; (void)gt; (void)nt; (void)gw; (void)NGW
__global__ void __launch_bounds__(NWAVES * 64, 2) mega(Params p) {
    extern __shared__ __attribute__((aligned(16))) unsigned char lds_raw[];
    LAS unsigned char* lds = (LAS unsigned char*)lds_raw;
    cg::grid_group grid = cg::this_grid();
    const int G = gridDim.x;

    {
        PH_IDS();
        LAS float* scr = (LAS float*)(lds + wave * 16384);
        constexpr int I0 = (DM / 64) * (HAWK_IN / 32), I1 = (HAWK_OUT / 64) * (DM / 32), I2 = (DM / 64) * (NSA_INP / 32), I3 = (NSA_OUT / 64) * (DM / 32), I4 = (2048 / 64) * (256 / 32);
        for (int it = gw; it < I0 + I1 + I2 + I3 + 2 * I4; it += NGW) {
            int r = it;
            if (r < I0) { p0_transpose_item<false>(p.hawk_w_in, DM, HAWK_IN, HAWK_IN, (bf16_t*)(p.ws + OFF_W0IN), scr, r, lane); continue; } r -= I0;
            if (r < I1) { p0_transpose_item<false>(p.hawk_w_out, HAWK_OUT, DM, DM, (bf16_t*)(p.ws + OFF_W0OUT), scr, r, lane); continue; } r -= I1;
            if (r < I2) { p0_transpose_item<true>(p.nsa_w_in, DM, NSA_IN, NSA_INP, (bf16_t*)(p.ws + OFF_W1IN), scr, r, lane); continue; } r -= I2;
            if (r < I3) { p0_transpose_item<false>(p.nsa_w_out, NSA_OUT, DM, DM, (bf16_t*)(p.ws + OFF_W1OUT), scr, r, lane); continue; } r -= I3;
            if (r < I4) { p0_transpose_item<false>(p.phik_w1, 2048, 256, 256, (bf16_t*)(p.ws + OFF_PHIW1), scr, r, lane); continue; } r -= I4;
            p0_transpose_item<false>(p.phiv_w1, 2048, 256, 256, (bf16_t*)(p.ws + OFF_PHIW1) + 256 * 2048, scr, r, lane);
        }
        for (int m = gw; m < T_; m += NGW) rms_row_to_bf16(p.x + (size_t)m * DM, p.hawk_norm, (bf16_t*)(p.ws + OFF_XN) + (size_t)m * DM, lane);
        p0_memkv(p, gt, nt);
    }
    GSYNC();
    { pg8::Gemm g{(const bf16_t*)(p.ws + OFF_XN), (const bf16_t*)(p.ws + OFF_W0IN), T_, HAWK_IN, DM}; pg8::StaticOrder S; S.init(T_, HAWK_IN, G, (int)blockIdx.x);
      pg8::EpiRoute E{p.ws, (bf16_t*)p.out, 0};
      pg8::gemm_phase<pg8::EpiRoute, pg8::StaticOrder, true, true>(lds, g, S, E); }
    GSYNC();
    {
        PH_IDS();
        p2_lru(p, gt, nt);
        for (int task = gw; task < 6144; task += NGW) dil_task(p, lds + wave * 8192, task, lane);
        __syncthreads();
        for (int u = blockIdx.x; u < 256; u += G) mem_unit((const bf16_t*)(p.ws + OFF_MEMKV), (const bf16_t*)(p.ws + OFF_QM), (const bf16_t*)(p.ws + OFF_ZM), (bf16_t*)(p.ws + OFF_Y0) + 1536, 1792, lds, u);
    }
    GSYNC();
    { PH_IDS(); p2_combine(p, gt, nt); }
    GSYNC();
    { pg8::Gemm g{(const bf16_t*)(p.ws + OFF_Y0), (const bf16_t*)(p.ws + OFF_W0OUT), T_, DM, HAWK_OUT}; pg8::StaticOrder S; S.init(T_, DM, G, (int)blockIdx.x);
      pg8::EpiResid E{p.x, (float*)(p.ws + OFF_X1), DM};
      pg8::gemm_phase<pg8::EpiResid, pg8::StaticOrder, true, true>(lds, g, S, E); }
    GSYNC();
    { PH_IDS(); for (int m = gw; m < T_; m += NGW) rms_row_to_bf16((const float*)(p.ws + OFF_X1) + (size_t)m * DM, p.nsa_norm, (bf16_t*)(p.ws + OFF_XN) + (size_t)m * DM, lane); }
    GSYNC();
    { pg8::Gemm g{(const bf16_t*)(p.ws + OFF_XN), (const bf16_t*)(p.ws + OFF_W1IN), T_, NSA_INP, DM}; pg8::StaticOrder S; S.init(T_, NSA_INP, G, (int)blockIdx.x);
      pg8::EpiRoute E{p.ws, (bf16_t*)p.out, 1};
      pg8::gemm_phase<pg8::EpiRoute, pg8::StaticOrder, true, true>(lds, g, S, E); }
    GSYNC();
    {
        PH_IDS();
        p5_cmp1(p, gt, nt);
        for (int u = blockIdx.x; u < 256; u += G) mem_unit((const bf16_t*)(p.ws + OFF_MEMKV) + (size_t)NB * NMEM * 512, (const bf16_t*)(p.ws + OFF_QM1), (const bf16_t*)(p.ws + OFF_ZM1), (bf16_t*)(p.ws + OFF_Y1) + 1024, 1280, lds, u);
    }
    GSYNC();
    { PH_IDS(); p5_cmp2(p, gt, nt); }
    GSYNC();
    for (int u = blockIdx.x; u < 1024; u += G) nsa_unit(p, lds, u);
    GSYNC();
    { pg8::Gemm g{(const bf16_t*)(p.ws + OFF_Y1), (const bf16_t*)(p.ws + OFF_W1OUT), T_, DM, NSA_OUT}; pg8::StaticOrder S; S.init(T_, DM, G, (int)blockIdx.x);
      pg8::EpiResid E{(const float*)(p.ws + OFF_X1), p.out, DM};
      pg8::gemm_phase<pg8::EpiResid, pg8::StaticOrder, true, true>(lds, g, S, E); }
    GSYNC();
    { PH_IDS(); for (int m = gw; m < T_; m += NGW) rms_row_inplace(p.out + (size_t)m * DM, p.final_norm, lane); }
}

extern "C" void kernel_launch(void* const* d_in, const int* in_sizes, int n_in, void* d_out, int out_size, void* d_ws, size_t ws_size, hipStream_t stream) {
    static int grid_blocks = 0;
    if (!grid_blocks) {
        int dev = 0, cus = 0, per_cu = 0;
        (void)hipGetDevice(&dev);
        (void)hipDeviceGetAttribute(&cus, hipDeviceAttributeMultiprocessorCount, dev);
        if (hipFuncSetAttribute((const void*)mega, hipFuncAttributeMaxDynamicSharedMemorySize, LDS_BYTES) != hipSuccess) fprintf(stderr, "hipFuncSetAttribute failed\n");
        (void)hipOccupancyMaxActiveBlocksPerMultiprocessor(&per_cu, (const void*)mega, NWAVES * 64, LDS_BYTES);
        if (per_cu < 1) fprintf(stderr, "occupancy query reports %d blocks per CU\n", per_cu);
        grid_blocks = cus;
        if (ws_size < WS_END) fprintf(stderr, "workspace too small: %zu < %zu\n", ws_size, (size_t)WS_END);
    }
    Params p{};
    const float** f = (const float**)&p;
    for (int i = 0; i < 26; ++i) f[i] = (const float*)d_in[i];
    p.out = (float*)d_out; p.ws = (unsigned char*)d_ws;
    void* args[] = {&p};
    hipError_t e = hipLaunchCooperativeKernel((void*)mega, dim3(grid_blocks), dim3(NWAVES * 64), args, LDS_BYTES, stream);
    if (e != hipSuccess) fprintf(stderr, "cooperative launch failed: %s (grid %d)\n", hipGetErrorString(e), grid_blocks);
}
#endif
```

```cpp
#ifndef HOST_EMU
#include <hip/hip_runtime.h>
#include <hip/hip_cooperative_groups.h>
namespace cg = cooperative_groups;
#define DEVFN __device__ __forceinline__
#define DEVNI __device__ __forceinline__
#else
#include <cmath>
#include <cstdint>
#include <cstring>
#define DEVFN static inline
#define DEVNI static
#endif
#include <cstdio>
#include <cstdint>

#ifndef BATCH_
#define BATCH_ 8
#endif
#ifndef DM_
#define DM_ 1024
#endif

typedef unsigned short bf16_t;
constexpr int SEQ = 2048, NB = BATCH_, T_ = NB * SEQ, DM = DM_, NMEM = 256;
constexpr int HAWK_IN = 7680, HAWK_OUT = 1792, NSA_IN = 3376, NSA_INP = 3584, NSA_OUT = 1280;
constexpr float EPS = 1e-6f;

DEVFN float bf2f(bf16_t h) { union { unsigned u; float f; } c; c.u = (unsigned)h << 16; return c.f; }
DEVFN bf16_t f2bf(float f) { union { unsigned u; float f; } c; c.f = f; unsigned u = c.u; u += 0x7fffu + ((u >> 16) & 1u); return (bf16_t)(u >> 16); }
DEVFN float sigmoidf_(float x) { return 1.0f / (1.0f + expf(-x)); }
DEVFN float siluf_(float x) { return x / (1.0f + expf(-x)); }

constexpr size_t al256(size_t x) { return (x + 255) & ~(size_t)255; }
constexpr size_t OFF_CTRL = 0;
constexpr size_t OFF_W0OUT = 65536;
constexpr size_t OFF_W1IN = OFF_W0OUT + al256((size_t)DM * HAWK_OUT * 2);
constexpr size_t OFF_W1OUT = OFF_W1IN + al256((size_t)NSA_INP * DM * 2);
constexpr size_t OFF_PHIW1 = OFF_W1OUT + al256((size_t)DM * NSA_OUT * 2);
constexpr size_t OFF_MEMKV = OFF_PHIW1 + al256((size_t)2 * 256 * 2048 * 2);
constexpr size_t OFF_LSE = OFF_MEMKV + al256((size_t)2 * NB * NMEM * 512 * 2);
constexpr size_t OFF_PEB = OFF_LSE + al256((size_t)3 * T_ * 4 * 4);
constexpr size_t OFF_WMKV = OFF_PEB + 2048;
constexpr size_t OFF_RA = OFF_WMKV + al256((size_t)2 * 512 * DM * 2);
constexpr size_t RA_BYTES = (size_t)T_ * 1792 * 2;
constexpr size_t OFF_XN = OFF_RA;
constexpr size_t OFF_W0IN = OFF_RA + (size_t)T_ * 1024 * 2;
constexpr size_t OFF_Y0 = OFF_RA;
constexpr size_t OFF_Y1 = OFF_RA;
constexpr size_t OFF_CMPH = OFF_RA + (size_t)T_ * 1280 * 2;
constexpr size_t OFF_CMPKV = OFF_CMPH + al256((size_t)2 * NB * 2 * 128 * 256 * 4);
constexpr size_t OFF_SEL = OFF_CMPKV + al256((size_t)2 * NB * 2 * 128 * 64 * 4);
constexpr size_t OFF_IMP = OFF_SEL + al256((size_t)NB * 2 * SEQ * 4);
static_assert(OFF_W0IN + (size_t)HAWK_IN * DM * 2 <= OFF_RA + RA_BYTES, "region A: XN0 | W0IN");
static_assert(OFF_IMP + (size_t)NB * 2 * SEQ * 32 * 4 <= OFF_RA + RA_BYTES, "region A: layer-1 temporaries");
constexpr size_t OFF_Q = OFF_RA + RA_BYTES;
constexpr size_t OFF_K = OFF_Q + (size_t)T_ * 1536 * 2;
constexpr size_t OFF_V = OFF_K + (size_t)T_ * 1536 * 2;
constexpr size_t OFF_ZB = OFF_V + (size_t)T_ * 1536 * 2;
constexpr size_t OFF_QM = OFF_ZB + (size_t)T_ * 512 * 2;
constexpr size_t OFF_ZM = OFF_QM + (size_t)T_ * 256 * 2;
constexpr size_t WS_END = OFF_ZM + (size_t)T_ * 256 * 2;
constexpr size_t OFF_X1 = OFF_K;
constexpr size_t OFF_Z1 = OFF_K + (size_t)T_ * 1024 * 4;
constexpr size_t OFF_Q1 = OFF_Q;
constexpr size_t OFF_QM1 = OFF_Q + (size_t)T_ * 1024 * 2;
constexpr size_t OFF_ZM1 = OFF_QM1 + (size_t)T_ * 256 * 2;
constexpr size_t OFF_KV1 = OFF_ZB;
constexpr size_t OFF_GATE = OFF_ZM;
static_assert(OFF_Z1 + (size_t)T_ * 1024 * 2 <= OFF_ZB, "Z1 overlay");
static_assert(BATCH_ != 8 || DM_ != 1024 || WS_END <= (size_t)256 * 1024 * 1024, "workspace too big");

struct Params {
    const float *x, *mem, *hawk_norm, *hawk_w_in, *conv_w, *conv_b, *ga_w, *ga_b, *gx_w, *gx_b, *lam, *hawk_mem_norm, *hawk_w_mem_kv, *hawk_w_out;
    const float *nsa_norm, *nsa_w_in, *pe_k, *pe_v, *phik_w1, *phik_w2, *phiv_w1, *phiv_w2, *nsa_mem_norm, *nsa_w_mem_kv, *nsa_w_out, *final_norm;
    float* out; unsigned char* ws;
};

DEVFN int nsa_col_orig(int n) {
    if (n < 1792) return n;
    if (n < 2816) return n - 1792 + 1840;
    if (n < 3072) return n - 2816 + 2864;
    if (n < 3328) return n - 3072 + 3120;
    if (n < 3376) return n - 3328 + 1792;
    return -1;
}

DEVFN void p0_convert(const Params& p, long gt, long nt) {
    bf16_t* w0in = (bf16_t*)(p.ws + OFF_W0IN); bf16_t* w0out = (bf16_t*)(p.ws + OFF_W0OUT);
    bf16_t* w1in = (bf16_t*)(p.ws + OFF_W1IN); bf16_t* w1out = (bf16_t*)(p.ws + OFF_W1OUT); bf16_t* phiw1 = (bf16_t*)(p.ws + OFF_PHIW1);
    for (long i = gt; i < (long)DM * HAWK_IN; i += nt) { const int k = (int)(i / HAWK_IN), n = (int)(i % HAWK_IN); w0in[(size_t)n * DM + k] = f2bf(p.hawk_w_in[i]); }
    for (long i = gt; i < (long)HAWK_OUT * DM; i += nt) { const int k = (int)(i / DM), n = (int)(i % DM); w0out[(size_t)n * HAWK_OUT + k] = f2bf(p.hawk_w_out[i]); }
    for (long i = gt; i < (long)DM * NSA_INP; i += nt) { const int k = (int)(i / NSA_INP), n = (int)(i % NSA_INP); const int no = nsa_col_orig(n);
        w1in[(size_t)n * DM + k] = no >= 0 ? f2bf(p.nsa_w_in[(size_t)k * NSA_IN + no]) : (bf16_t)0; }
    for (long i = gt; i < (long)NSA_OUT * DM; i += nt) { const int k = (int)(i / DM), n = (int)(i % DM); w1out[(size_t)n * NSA_OUT + k] = f2bf(p.nsa_w_out[i]); }
    for (long i = gt; i < (long)2 * 2048 * 256; i += nt) { const int kv = (int)(i / (2048 * 256)), r = (int)(i % (2048 * 256)), k = r / 256, n = r % 256;
        phiw1[(size_t)kv * 256 * 2048 + (size_t)n * 2048 + k] = f2bf((kv ? p.phiv_w1 : p.phik_w1)[r]); }
}
DEVFN void rows_rmsnorm(const float* x, const float* g, bf16_t* xn, long gt, long nt) {
    for (long r = gt; r < T_; r += nt) {
        const float* xr = x + (size_t)r * DM; float ss = 0.f;
        for (int k = 0; k < DM; ++k) ss += xr[k] * xr[k];
        const float rs = 1.0f / sqrtf(ss / DM + EPS);
        for (int k = 0; k < DM; ++k) xn[(size_t)r * DM + k] = f2bf(xr[k] * rs * g[k]);
    }
}
DEVFN void p0_memkv(const Params& p, long gt, long nt) {
    bf16_t* mkv = (bf16_t*)(p.ws + OFF_MEMKV);
    for (long i = gt; i < (long)2 * NB * NMEM * 512; i += nt) {
        const int l = (int)(i / ((long)NB * NMEM * 512)), r = (int)((i / 512) % (NB * NMEM)), c = (int)(i % 512);
        const float* mr = p.mem + (size_t)r * DM; const float* g = l ? p.nsa_mem_norm : p.hawk_mem_norm; const float* w = l ? p.nsa_w_mem_kv : p.hawk_w_mem_kv;
        float ss = 0.f, acc = 0.f;
        for (int k = 0; k < DM; ++k) { const float v = mr[k]; ss += v * v; acc += v * g[k] * w[(size_t)k * 512 + c]; }
        mkv[i] = f2bf(acc / sqrtf(ss / DM + EPS));
    }
}

struct __attribute__((aligned(16))) U4 { unsigned x, y, z, w; };
DEVFN float lo16(unsigned u) { union { unsigned u; float f; } c; c.u = u << 16; return c.f; }
DEVFN float hi16(unsigned u) { union { unsigned u; float f; } c; c.u = u & 0xffff0000u; return c.f; }
DEVFN float dot_bf16(const bf16_t* a, const bf16_t* b, int n) {
    float s0 = 0.f, s1 = 0.f, s2 = 0.f, s3 = 0.f;
    for (int k = 0; k < n; k += 8) { const U4 va = *(const U4*)(a + k), vb = *(const U4*)(b + k);
        s0 += lo16(va.x) * lo16(vb.x) + hi16(va.x) * hi16(vb.x); s1 += lo16(va.y) * lo16(vb.y) + hi16(va.y) * hi16(vb.y);
        s2 += lo16(va.z) * lo16(vb.z) + hi16(va.z) * hi16(vb.z); s3 += lo16(va.w) * lo16(vb.w) + hi16(va.w) * hi16(vb.w); }
    return (s0 + s1) + (s2 + s3);
}

DEVFN void p1_gemm(const Params& p, long gt, long nt) {
    const bf16_t* xn = (const bf16_t*)(p.ws + OFF_XN); const bf16_t* w = (const bf16_t*)(p.ws + OFF_W0IN);
    bf16_t* xaza = (bf16_t*)p.out;
    for (long i = gt; i < (long)T_ * HAWK_IN; i += nt) {
        const int t = (int)(i / HAWK_IN), n = (int)(i % HAWK_IN);
        const bf16_t v = f2bf(dot_bf16(xn + (size_t)t * DM, w + (size_t)n * DM, DM));
        if (n < 2048) xaza[(size_t)t * 2048 + n] = v;
        else if (n < 3584) ((bf16_t*)(p.ws + OFF_Q))[(size_t)t * 1536 + n - 2048] = v;
        else if (n < 5120) ((bf16_t*)(p.ws + OFF_K))[(size_t)t * 1536 + n - 3584] = v;
        else if (n < 6656) ((bf16_t*)(p.ws + OFF_V))[(size_t)t * 1536 + n - 5120] = v;
        else if (n < 7168) ((bf16_t*)(p.ws + OFF_ZB))[(size_t)t * 512 + n - 6656] = v;
        else if (n < 7424) ((bf16_t*)(p.ws + OFF_QM))[(size_t)t * 256 + n - 7168] = v;
        else ((bf16_t*)(p.ws + OFF_ZM))[(size_t)t * 256 + n - 7424] = v;
    }
}

DEVFN void p2_lru(const Params& p, long gt, long nt) {
    const bf16_t* xaza = (const bf16_t*)p.out; bf16_t* Y0 = (bf16_t*)(p.ws + OFF_Y0);
    for (long i = gt; i < (long)NB * 1024; i += nt) {
        const int b = (int)(i / 1024), c = (int)(i % 1024), blk = c >> 6, j = c & 63;
        const float sp = log1pf(expf(-p.lam[c]));
        const float* gaw = p.ga_w + (size_t)blk * 4096; const float* gxw = p.gx_w + (size_t)blk * 4096;
        float h = 0.f;
        for (int t = 0; t < SEQ; ++t) {
            float ra = p.ga_b[c], ri = p.gx_b[c], xcj = 0.f;
            for (int ii = 0; ii < 64; ++ii) {
                const int cc = blk * 64 + ii; float xc = p.conv_b[cc];
                for (int k = 0; k < 4; ++k) { const int tt = t - 3 + k; if (tt >= 0) xc += p.conv_w[k * 1024 + cc] * bf2f(xaza[((size_t)b * SEQ + tt) * 2048 + cc]); }
                ra += xc * gaw[ii * 64 + j]; ri += xc * gxw[ii * 64 + j];
                if (ii == j) xcj = xc;
            }
            const float r = sigmoidf_(ra), ig = sigmoidf_(ri);
            const float log_a = -8.0f * r * sp, a = expf(log_a);
            const float mult = t == 0 ? 1.0f : sqrtf(-expm1f(2.0f * log_a));
            h = a * h + xcj * ig * mult;
            const size_t tt0 = (size_t)b * SEQ + t;
            Y0[tt0 * 1792 + c] = f2bf(h * siluf_(bf2f(xaza[tt0 * 2048 + 1024 + c])));
        }
    }
}
DEVNI void p2_dilated(const Params& p, long gt, long nt) {
    bf16_t* Q = (bf16_t*)(p.ws + OFF_Q); const bf16_t* K = (const bf16_t*)(p.ws + OFF_K); const bf16_t* V = (const bf16_t*)(p.ws + OFF_V);
    float* LSE = (float*)(p.ws + OFF_LSE);
    for (long i = gt; i < (long)T_ * 12; i += nt) {
        const int t = (int)(i / 12), hh = (int)(i % 12), g = hh >> 2, h = hh & 3, s = t % SEQ;
        const int dil = g == 0 ? 1 : (g == 1 ? 4 : 16);
        const float slope = exp2f(-8.0f * (float)(hh + 1) / 12.0f), scale = 0.08838834764831845f;
        bf16_t* qp = Q + (size_t)t * 1536 + hh * 128;
        float o[128], m = -1e30f, l = 0.f;
#pragma unroll
        for (int d = 0; d < 128; ++d) o[d] = 0.f;
        for (int jj = 0; jj <= 128; ++jj) {
            const int sk = s - jj * dil; if (sk < 0) break;
            const bf16_t* kp = K + (size_t)(t - jj * dil) * 1536 + hh * 128; const bf16_t* vp = V + (size_t)(t - jj * dil) * 1536 + hh * 128;
            float sc = 0.f;
#pragma nounroll
            for (int d = 0; d < 128; ++d) sc += bf2f(qp[d]) * bf2f(kp[d]);
            sc = sc * scale - slope * (float)(jj * dil);
            const float mn = fmaxf(m, sc), al = expf(m - mn), pe = expf(sc - mn);
            l = l * al + pe; m = mn;
#pragma unroll
            for (int d = 0; d < 128; ++d) o[d] = o[d] * al + pe * bf2f(vp[d]);
        }
        const float inv = 1.0f / l;
#pragma unroll
        for (int d = 0; d < 128; ++d) qp[d] = f2bf(o[d] * inv);
        LSE[((size_t)g * T_ + t) * 4 + h] = m + logf(l);
    }
}
DEVFN void p2_combine(const Params& p, long gt, long nt) {
    const bf16_t* Q = (const bf16_t*)(p.ws + OFF_Q); const bf16_t* ZB = (const bf16_t*)(p.ws + OFF_ZB); const float* LSE = (const float*)(p.ws + OFF_LSE); bf16_t* Y0 = (bf16_t*)(p.ws + OFF_Y0);
    for (long i = gt; i < (long)T_ * 512; i += nt) {
        const int t = (int)(i / 512), c = (int)(i % 512), h = c >> 7;
        const float l0 = LSE[((size_t)0 * T_ + t) * 4 + h], l1 = LSE[((size_t)1 * T_ + t) * 4 + h], l2 = LSE[((size_t)2 * T_ + t) * 4 + h];
        const float mx = fmaxf(l0, fmaxf(l1, l2)), e0 = expf(l0 - mx), e1 = expf(l1 - mx), e2 = expf(l2 - mx), inv = 1.0f / (e0 + e1 + e2);
        const float o = (e0 * bf2f(Q[(size_t)t * 1536 + c]) + e1 * bf2f(Q[(size_t)t * 1536 + 512 + c]) + e2 * bf2f(Q[(size_t)t * 1536 + 1024 + c])) * inv;
        Y0[(size_t)t * 1792 + 1024 + c] = f2bf(o * siluf_(bf2f(ZB[i])));
    }
}
DEVNI void mem_attn(const bf16_t* mkv, const bf16_t* QMb, const bf16_t* ZMb, bf16_t* Y, int ldy, long gt, long nt) {
    for (long i = gt; i < (long)T_ * 4; i += nt) {
        const int t = (int)(i / 4), h = (int)(i % 4), b = t / SEQ;
        const bf16_t* qp = QMb + (size_t)t * 256 + h * 64;
        float o[64], m = -1e30f, l = 0.f;
#pragma unroll
        for (int d = 0; d < 64; ++d) o[d] = 0.f;
        for (int j = 0; j < NMEM; ++j) {
            const bf16_t* kp = mkv + ((size_t)b * NMEM + j) * 512 + h * 64; const bf16_t* vp = kp + 256;
            float sc = 0.f;
#pragma nounroll
            for (int d = 0; d < 64; ++d) sc += bf2f(qp[d]) * bf2f(kp[d]);
            sc *= 0.125f;
            const float mn = fmaxf(m, sc), al = expf(m - mn), pe = expf(sc - mn);
            l = l * al + pe; m = mn;
#pragma unroll
            for (int d = 0; d < 64; ++d) o[d] = o[d] * al + pe * bf2f(vp[d]);
        }
        const float inv = 1.0f / l;
#pragma unroll
        for (int d = 0; d < 64; ++d) Y[(size_t)t * ldy + h * 64 + d] = f2bf(o[d] * inv * siluf_(bf2f(ZMb[(size_t)t * 256 + h * 64 + d])));
    }
}

DEVFN void p3_gemm(const Params& p, long gt, long nt) {
    const bf16_t* y = (const bf16_t*)(p.ws + OFF_Y0); const bf16_t* w = (const bf16_t*)(p.ws + OFF_W0OUT); float* x1 = (float*)(p.ws + OFF_X1);
    for (long i = gt; i < (long)T_ * DM; i += nt) {
        const int t = (int)(i / DM), n = (int)(i % DM);
        x1[i] = p.x[i] + dot_bf16(y + (size_t)t * HAWK_OUT, w + (size_t)n * HAWK_OUT, HAWK_OUT);
    }
}
DEVFN void p4_gemm(const Params& p, long gt, long nt) {
    const bf16_t* xn = (const bf16_t*)(p.ws + OFF_XN); const bf16_t* w = (const bf16_t*)(p.ws + OFF_W1IN);
    for (long i = gt; i < (long)T_ * NSA_IN; i += nt) {
        const int t = (int)(i / NSA_IN), n = (int)(i % NSA_IN);
        const float a = dot_bf16(xn + (size_t)t * DM, w + (size_t)n * DM, DM); const bf16_t v = f2bf(a);
        if (n < 1024) ((bf16_t*)(p.ws + OFF_Q1))[(size_t)t * 1024 + n] = v;
        else if (n < 1792) ((bf16_t*)(p.ws + OFF_KV1))[(size_t)t * 768 + n - 1024] = v;
        else if (n < 2816) ((bf16_t*)(p.ws + OFF_Z1))[(size_t)t * 1024 + n - 1792] = v;
        else if (n < 3072) ((bf16_t*)(p.ws + OFF_QM1))[(size_t)t * 256 + n - 2816] = v;
        else if (n < 3328) ((bf16_t*)(p.ws + OFF_ZM1))[(size_t)t * 256 + n - 3072] = v;
        else ((bf16_t*)(p.ws + OFF_GATE))[(size_t)t * 256 + n - 3328] = v;
    }
}
DEVFN void p5_cmp1(const Params& p, long gt, long nt) {
    const bf16_t* KV = (const bf16_t*)(p.ws + OFF_KV1); const bf16_t* w1 = (const bf16_t*)(p.ws + OFF_PHIW1); float* hid = (float*)(p.ws + OFF_CMPH);
    for (long i = gt; i < (long)2 * NB * 2 * 127 * 256; i += nt) {
        const int j = (int)(i % 256); long r = i / 256; const int n = (int)(r % 127); r /= 127; const int g = (int)(r % 2); r /= 2; const int b = (int)(r % NB), kv = (int)(r / NB);
        const float* pe = kv ? p.pe_v : p.pe_k; const bf16_t* wj = w1 + ((size_t)kv * 256 + j) * 2048;
        float acc = 0.f;
        for (int ii = 0; ii < 32; ++ii) { const bf16_t* tp = KV + ((size_t)b * SEQ + 16 * n + ii) * 768 + kv * 128 + g * 64;
            for (int d = 0; d < 64; ++d) acc += (bf2f(tp[d]) + pe[ii * 64 + d]) * bf2f(wj[ii * 64 + d]); }
        hid[((((size_t)kv * NB + b) * 2 + g) * 128 + n) * 256 + j] = siluf_(acc);
    }
}
DEVFN void p5_cmp2(const Params& p, long gt, long nt) {
    const float* hid = (const float*)(p.ws + OFF_CMPH); bf16_t* ckv = (bf16_t*)(p.ws + OFF_CMPKV);
    for (long i = gt; i < (long)2 * NB * 2 * 128 * 64; i += nt) {
        const int d = (int)(i % 64); long r = i / 64; const int n = (int)(r % 128); r /= 128; const int g = (int)(r % 2); r /= 2; const int b = (int)(r % NB), kv = (int)(r / NB);
        const float* w2 = kv ? p.phiv_w2 : p.phik_w2; const size_t row = (((size_t)kv * NB + b) * 2 + g) * 128 + n;
        float acc = 0.f;
        if (n < 127) for (int j = 0; j < 256; ++j) acc += hid[row * 256 + j] * w2[j * 64 + d];
        ckv[row * 64 + d] = f2bf(acc);
    }
}
DEVNI void p5_cmp_attn(const Params& p, long gt, long nt) {
    const bf16_t* Q1 = (const bf16_t*)(p.ws + OFF_Q1); const bf16_t* ckv = (const bf16_t*)(p.ws + OFF_CMPKV); const bf16_t* gate = (const bf16_t*)(p.ws + OFF_GATE);
    unsigned* SEL = (unsigned*)(p.ws + OFF_SEL); float* ocmp = p.out; float* IMP = (float*)(p.ws + OFF_IMP);
    for (long i = gt; i < (long)NB * 2 * SEQ; i += nt) {
        const int s = (int)(i % SEQ), g = (int)((i / SEQ) % 2), b = (int)(i / (2 * SEQ)); const int t = b * SEQ + s;
        const bf16_t* kc = ckv + (((size_t)0 * NB + b) * 2 + g) * 128 * 64; const bf16_t* vc = ckv + (((size_t)1 * NB + b) * 2 + g) * 128 * 64;
        const int nvis = s >= 31 ? (s - 31) / 16 + 1 : 0;
        float* imp = IMP + (size_t)i * 32;
        for (int r = 0; r < 8; ++r) {
            const int hidx = g * 8 + r; const float slope = exp2f(-0.5f * (float)(hidx + 1));
            const bf16_t* qp = Q1 + (size_t)t * 1024 + hidx * 64;
            float m = -1e30f;
            for (int n = 0; n < nvis; ++n) { float sc = 0.f;
_Pragma("nounroll") for (int d = 0; d < 64; ++d) sc += bf2f(qp[d]) * bf2f(kc[n * 64 + d]);
                sc = sc * 0.125f - slope * (float)(s - (16 * n + 31)); m = fmaxf(m, sc); }
            float l = 0.f;
            for (int n = 0; n < nvis; ++n) { float sc = 0.f;
_Pragma("nounroll") for (int d = 0; d < 64; ++d) sc += bf2f(qp[d]) * bf2f(kc[n * 64 + d]);
                sc = sc * 0.125f - slope * (float)(s - (16 * n + 31)); l += expf(sc - m); }
            const float inv = nvis > 0 ? 1.0f / l : 0.f;
            float o[64];
#pragma unroll
            for (int d = 0; d < 64; ++d) o[d] = 0.f;
            float carry = 0.f;
            for (int j = 0; j < 32; ++j) {
                float acc = carry; carry = 0.f;
                for (int q4 = 0; q4 < 4; ++q4) { const int n = 4 * j + q4;
                    if (n < nvis) { float sc = 0.f;
_Pragma("nounroll") for (int d = 0; d < 64; ++d) sc += bf2f(qp[d]) * bf2f(kc[n * 64 + d]);
                        sc = sc * 0.125f - slope * (float)(s - (16 * n + 31)); const float pr = expf(sc - m) * inv;
                        acc += pr; if (q4 == 3) carry = pr;
#pragma unroll
                        for (int d = 0; d < 64; ++d) o[d] += pr * bf2f(vc[n * 64 + d]); } }
                imp[j] = (r == 0 ? 0.f : imp[j]) + acc;
            }
            const float g0 = sigmoidf_(bf2f(gate[(size_t)t * 256 + hidx * 3 + 0]));
#pragma unroll
            for (int d = 0; d < 64; ++d) ocmp[(size_t)t * 1024 + hidx * 64 + d] = g0 * o[d];
        }
        const int cur = s >> 6; unsigned mask = 1u | (1u << cur) | (cur > 0 ? (1u << (cur - 1)) : 0u);
        const int nf = cur == 0 ? 1 : (cur == 1 ? 2 : 3), need = 8 - nf;
        for (int j = 1; j < 30; ++j) {
            if (j <= cur - 2) { int rank = 0;
                for (int j2 = 1; j2 < 30; ++j2) if (j2 <= cur - 2 && j2 != j) rank += (imp[j2] > imp[j] || (imp[j2] == imp[j] && j2 < j)) ? 1 : 0;
                if (rank < need) mask |= 1u << j; }
        }
        SEL[i] = mask;
    }
}
DEVNI void p5_slc_win(const Params& p, long gt, long nt) {
    const bf16_t* Q1 = (const bf16_t*)(p.ws + OFF_Q1); const bf16_t* KV = (const bf16_t*)(p.ws + OFF_KV1); const bf16_t* gate = (const bf16_t*)(p.ws + OFF_GATE);
    const unsigned* SEL = (const unsigned*)(p.ws + OFF_SEL); const float* ocmp = p.out; const bf16_t* Z1 = (const bf16_t*)(p.ws + OFF_Z1); bf16_t* Y1 = (bf16_t*)(p.ws + OFF_Y1);
    for (long i = gt; i < (long)T_ * 16; i += nt) {
        const int t = (int)(i / 16), hidx = (int)(i % 16), g = hidx >> 3, b = t / SEQ, s = t % SEQ;
        const float slope = exp2f(-0.5f * (float)(hidx + 1));
        const bf16_t* qp = Q1 + (size_t)t * 1024 + hidx * 64;
        const unsigned mask = SEL[((size_t)b * 2 + g) * SEQ + s];
        float res[64];
        {
            float o[64], m = -1e30f, l = 0.f;
#pragma unroll
            for (int d = 0; d < 64; ++d) o[d] = 0.f;
            for (int j = 0; j < 32; ++j) { if (!((mask >> j) & 1u)) continue;
                for (int kk = 0; kk < 64; ++kk) { const int kpos = j * 64 + kk; if (kpos > s) break;
                    const bf16_t* kp = KV + ((size_t)b * SEQ + kpos) * 768 + 2 * 128 + g * 64; const bf16_t* vp = kp + 128;
                    float sc = 0.f;
#pragma nounroll
                    for (int d = 0; d < 64; ++d) sc += bf2f(qp[d]) * bf2f(kp[d]);
                    sc = sc * 0.125f - slope * (float)(s - kpos);
                    const float mn = fmaxf(m, sc), al = expf(m - mn), pe = expf(sc - mn); l = l * al + pe; m = mn;
#pragma unroll
                    for (int d = 0; d < 64; ++d) o[d] = o[d] * al + pe * bf2f(vp[d]); } }
            const float g1 = sigmoidf_(bf2f(gate[(size_t)t * 256 + hidx * 3 + 1])) / l;
#pragma unroll
            for (int d = 0; d < 64; ++d) res[d] = ocmp[(size_t)t * 1024 + hidx * 64 + d] + g1 * o[d];
        }
        {
            float o[64], m = -1e30f, l = 0.f;
#pragma unroll
            for (int d = 0; d < 64; ++d) o[d] = 0.f;
            for (int kpos = (s - 511 > 0 ? s - 511 : 0); kpos <= s; ++kpos) {
                const bf16_t* kp = KV + ((size_t)b * SEQ + kpos) * 768 + 4 * 128 + g * 64; const bf16_t* vp = kp + 128;
                float sc = 0.f;
#pragma nounroll
                for (int d = 0; d < 64; ++d) sc += bf2f(qp[d]) * bf2f(kp[d]);
                sc = sc * 0.125f - slope * (float)(s - kpos);
                const float mn = fmaxf(m, sc), al = expf(m - mn), pe = expf(sc - mn); l = l * al + pe; m = mn;
#pragma unroll
                for (int d = 0; d < 64; ++d) o[d] = o[d] * al + pe * bf2f(vp[d]); }
            const float g2 = sigmoidf_(bf2f(gate[(size_t)t * 256 + hidx * 3 + 2])) / l;
#pragma unroll
            for (int d = 0; d < 64; ++d) res[d] += g2 * o[d];
        }
#pragma unroll
        for (int d = 0; d < 64; ++d) Y1[(size_t)t * 1280 + hidx * 64 + d] = f2bf(res[d] * siluf_(bf2f(Z1[(size_t)t * 1024 + hidx * 64 + d])));
    }
}
DEVFN void p6_gemm(const Params& p, long gt, long nt) {
    const bf16_t* y = (const bf16_t*)(p.ws + OFF_Y1); const bf16_t* w = (const bf16_t*)(p.ws + OFF_W1OUT); const float* x1 = (const float*)(p.ws + OFF_X1);
    for (long i = gt; i < (long)T_ * DM; i += nt) {
        const int t = (int)(i / DM), n = (int)(i % DM);
        p.out[i] = x1[i] + dot_bf16(y + (size_t)t * NSA_OUT, w + (size_t)n * NSA_OUT, NSA_OUT);
    }
}
DEVFN void p7_final(const Params& p, long gt, long nt) {
    for (long r = gt; r < T_; r += nt) {
        float* xr = p.out + (size_t)r * DM; float ss = 0.f;
        for (int k = 0; k < DM; ++k) ss += xr[k] * xr[k];
        const float rs = 1.0f / sqrtf(ss / DM + EPS);
        for (int k = 0; k < DM; ++k) xr[k] = xr[k] * rs * p.final_norm[k];
    }
}

#ifndef HOST_EMU
static_assert(DM == 1024 && NB == 8, "device build is for the real shapes");
#define LAS __attribute__((address_space(3)))
#define GAS __attribute__((address_space(1)))
typedef unsigned v4u __attribute__((ext_vector_type(4)));
typedef float f32x4 __attribute__((ext_vector_type(4)));
typedef short bf16x8 __attribute__((ext_vector_type(8)));
#define LDS_WAIT() asm volatile("s_waitcnt lgkmcnt(0)" ::: "memory")
#define VM_WAIT() asm volatile("s_waitcnt vmcnt(0)" ::: "memory")
__device__ __forceinline__ unsigned pk2(float lo, float hi) { return (unsigned)f2bf(lo) | ((unsigned)f2bf(hi) << 16); }

__device__ __forceinline__ int fresh_tid();
namespace pg8 {
constexpr int BM = 256, BK = 64, HALF = 128, HTB = HALF * BK * 2  , STAGE_BYTES = 8 * HTB, NXCD = 8, WGM = 8;
__host__ __device__ __forceinline__ int lds_byte(int r, int c) { const int st = (r >> 4) * 2 + (c >> 5), rr = r & 15, cc = c & 31, ob = rr * 64 + cc * 2; return st * 1024 + (ob ^ (((ob >> 9) & 1) << 5)); }
__host__ __device__ __forceinline__ void stage_rc(int b, int& R, int& C) { const int st = b / 1024, sb = b % 1024, swz = sb ^ (((sb >> 9) & 1) << 5); R = (st >> 1) * 16 + swz / 64; C = (st & 1) * 32 + (swz % 64) / 2; }
__host__ __device__ __forceinline__ int perm32(int rho) { const int n = rho >> 4, i = rho & 15; return 8 * (i >> 2) + 4 * n + (i & 3); }
struct Unit { int pm, pn; };
struct Gemm { const bf16_t* A; const bf16_t* Bt; int M, N, K; };
struct StaticOrder {
    int nM, nN, nwg, G, c;
    __host__ __device__ void init(int M, int N, int G_, int c_) { nM = M / BM; nN = N / BM; nwg = nM * nN; G = G_; c = c_; }
    __host__ __device__ bool next(int i, Unit& u) const {
        const long L = (long)i * G + c; if (L >= nwg) return false;
        int wgid = (int)L; { const int q = nwg / NXCD, r = nwg % NXCD, xcd = wgid % NXCD, off = wgid / NXCD; wgid = (xcd < r ? xcd * (q + 1) : r * (q + 1) + (xcd - r) * q) + off; }
        const int nig = WGM * nN, gid = wgid / nig, fm = gid * WGM, gsz = (nM - fm) < WGM ? (nM - fm) : WGM;
        u.pm = fm + ((wgid % nig) % gsz); u.pn = (wgid % nig) / gsz; return true;
    }
    __device__ __forceinline__ void a_ready(const Unit&) const {}
    __device__ __forceinline__ void done(const Unit&) const {}
};
typedef __bf16 bf16x2_t __attribute__((ext_vector_type(2)));
__device__ __forceinline__ unsigned cvt_pk_bf16(float lo, float hi) { const bf16x2_t v = {(__bf16)lo, (__bf16)hi}; return __builtin_bit_cast(unsigned, v); }

struct EpiRoute {
    static constexpr bool PERM = true, AFTER_DRAIN = false;
    unsigned char* ws; bf16_t* xaza; int layer;
    __device__ __forceinline__ void operator()(const f32x4 (&acc)[2][2][4][2], const Unit& u, int wr, int wc, int fr, int fq) const {
        bf16_t* base; int ldc, colt; const int pn = u.pn;
        if (layer == 0) {
            if (pn < 8) { base = xaza; ldc = 2048; colt = pn * 256; }
            else if (pn < 14) { base = (bf16_t*)(ws + OFF_Q); ldc = 1536; colt = (pn - 8) * 256; }
            else if (pn < 20) { base = (bf16_t*)(ws + OFF_K); ldc = 1536; colt = (pn - 14) * 256; }
            else if (pn < 26) { base = (bf16_t*)(ws + OFF_V); ldc = 1536; colt = (pn - 20) * 256; }
            else if (pn < 28) { base = (bf16_t*)(ws + OFF_ZB); ldc = 512; colt = (pn - 26) * 256; }
            else if (pn < 29) { base = (bf16_t*)(ws + OFF_QM); ldc = 256; colt = 0; }
            else { base = (bf16_t*)(ws + OFF_ZM); ldc = 256; colt = 0; }
        } else {
            if (pn < 4) { base = (bf16_t*)(ws + OFF_Q1); ldc = 1024; colt = pn * 256; }
            else if (pn < 7) { base = (bf16_t*)(ws + OFF_KV1); ldc = 768; colt = (pn - 4) * 256; }
            else if (pn < 11) { base = (bf16_t*)(ws + OFF_Z1); ldc = 1024; colt = (pn - 7) * 256; }
            else if (pn < 12) { base = (bf16_t*)(ws + OFF_QM1); ldc = 256; colt = 0; }
            else if (pn < 13) { base = (bf16_t*)(ws + OFF_ZM1); ldc = 256; colt = 0; }
            else { base = (bf16_t*)(ws + OFF_GATE); ldc = 256; colt = 0; }
        }
        const int row0 = u.pm * BM + wr * 64 + fr, col0 = colt + wc * 32 + 8 * fq;
#pragma unroll
        for (int ai = 0; ai < 2; ++ai)
#pragma unroll
            for (int m = 0; m < 4; ++m) { bf16_t* rowp = base + (size_t)(row0 + ai * HALF + m * 16) * ldc + col0;
#pragma unroll
                for (int bj = 0; bj < 2; ++bj) { const f32x4 v0 = acc[ai][bj][m][0], v1 = acc[ai][bj][m][1];
                    v4u w; w.x = cvt_pk_bf16(v0[0], v0[1]); w.y = cvt_pk_bf16(v0[2], v0[3]); w.z = cvt_pk_bf16(v1[0], v1[1]); w.w = cvt_pk_bf16(v1[2], v1[3]);
                    *(v4u*)(rowp + bj * HALF) = w; } }
    }
};
struct EpiResid {
    static constexpr bool PERM = false, AFTER_DRAIN = false;
    const float* base; float* out; int ldc;
    __device__ __forceinline__ void operator()(const f32x4 (&acc)[2][2][4][2], const Unit& u, int wr, int wc, int fr, int fq) const {
        const int col0 = u.pn * BM + wc * 32 + 4 * fq;
#pragma unroll
        for (int ai = 0; ai < 2; ++ai)
#pragma unroll
            for (int m = 0; m < 4; ++m) { const size_t off = (size_t)(u.pm * BM + ai * HALF + wr * 64 + m * 16 + fr) * ldc + col0;
#pragma unroll
                for (int bj = 0; bj < 2; ++bj)
#pragma unroll
                    for (int n = 0; n < 2; ++n) { const f32x4 bs = *(const f32x4*)(base + off + bj * HALF + n * 16); *(f32x4*)(out + off + bj * HALF + n * 16) = bs + acc[ai][bj][m][n]; } }
    }
};

template <class Epi, class Sched, bool ALIGN_EPI = false, bool SP2 = false>
__device__ __forceinline__ void gemm_phase(LAS unsigned char* lds, const Gemm g, const Sched& S, const Epi& E) {
    const int tid = fresh_tid(), wid = __builtin_amdgcn_readfirstlane(tid >> 6), lane = tid & 63, wr = wid >> 2, wc = wid & 3, fr = lane & 15, fq = lane >> 4;
    const int K = g.K, nt = K / BK;
    unsigned voffA[2], voffB[2];
#pragma unroll
    for (int i = 0; i < 2; ++i) { int R, C; stage_rc(tid * 16 + i * 8192, R, C); const int Rb = Epi::PERM ? ((R & ~31) + perm32(R & 31)) : R;
        voffA[i] = (unsigned)(R * K + C) * 2u; voffB[i] = (unsigned)(Rb * K + C) * 2u; }
    const size_t kstep = (size_t)(BK * 2);
    const size_t hstep = (size_t)HALF * K * 2;
    const size_t tstep = 2 * hstep;
    const unsigned ldsw = (unsigned)wid * 1024u;
    const int aoff = lds_byte(wr * 64 + fr, fq * 8), boff = lds_byte(wc * 32 + fr, fq * 8);
#define PG8_SA(b, h) (((b) * 2 + (h)) * HTB)
#define PG8_SB(b, h) ((4 + (b) * 2 + (h)) * HTB)
#define PG8_STAGE(bufoff, gbase, voff) do { _Pragma("unroll") for (int _i = 0; _i < 2; ++_i) \
        __builtin_amdgcn_global_load_lds((const unsigned*)((const char*)(gbase) + (voff)[_i]), (LAS unsigned*)(lds + (bufoff) + ldsw + _i * 8192), 16, 0, 0); } while (0)
#define PG8_LDA(dst, b, h) do { _Pragma("unroll") for (int m = 0; m < 4; ++m) _Pragma("unroll") for (int k = 0; k < 2; ++k) dst[m][k] = *(const LAS bf16x8*)(lds + PG8_SA(b, h) + aoff + m * 2048 + k * 1024); } while (0)
#define PG8_LDB(dst, b, h) do { _Pragma("unroll") for (int n = 0; n < 2; ++n) _Pragma("unroll") for (int k = 0; k < 2; ++k) dst[n][k] = *(const LAS bf16x8*)(lds + PG8_SB(b, h) + boff + n * 2048 + k * 1024); } while (0)
#define PG8_MMA(ai, bj, At, Bt) do { __builtin_amdgcn_s_setprio(1); _Pragma("unroll") for (int m = 0; m < 4; ++m) _Pragma("unroll") for (int n = 0; n < 2; ++n) _Pragma("unroll") for (int k = 0; k < 2; ++k) \
        acc[ai][bj][m][n] = __builtin_amdgcn_mfma_f32_16x16x32_bf16(Bt[n][k], At[m][k], acc[ai][bj][m][n], 0, 0, 0); __builtin_amdgcn_s_setprio(0); } while (0)
#define PG8_WAIT_V(n) asm volatile("s_waitcnt vmcnt(" #n ")" ::: "memory")
#define PG8_WAIT_L(n) asm volatile("s_waitcnt lgkmcnt(" #n ")" ::: "memory")
#define PG8_BAR __builtin_amdgcn_s_barrier()
#define PG8_SCHED __builtin_amdgcn_sched_barrier(0)
    Unit cur, nxt; int ui = 0;
    if (!S.next(0, cur)) return;
    f32x4 acc[2][2][4][2];
#pragma unroll
    for (int a = 0; a < 2; ++a)
#pragma unroll
        for (int b = 0; b < 2; ++b)
#pragma unroll
            for (int m = 0; m < 4; ++m)
#pragma unroll
                for (int n = 0; n < 2; ++n) acc[a][b][m][n] = (f32x4){0.f, 0.f, 0.f, 0.f};
    bf16x8 At[4][2], B0[2][2], B1[2][2];
    const char* cA = (const char*)g.A + (size_t)cur.pm * tstep; const char* cB = (const char*)g.Bt + (size_t)cur.pn * tstep;
    S.a_ready(cur);
    if constexpr (SP2) {
        PG8_STAGE(PG8_SB(0, 0), cB, voffB); PG8_STAGE(PG8_SB(0, 1), cB + hstep, voffB); PG8_STAGE(PG8_SA(0, 0), cA, voffA); PG8_STAGE(PG8_SA(0, 1), cA + hstep, voffA);
        if (wr == 1) PG8_BAR;
        PG8_WAIT_V(2); PG8_BAR;
        PG8_STAGE(PG8_SB(1, 0), cB + kstep, voffB); PG8_STAGE(PG8_SA(1, 0), cA + kstep, voffA); PG8_STAGE(PG8_SB(1, 1), cB + hstep + kstep, voffB);
        PG8_WAIT_V(6); PG8_BAR;
    } else {
        PG8_STAGE(PG8_SB(0, 0), cB, voffB); PG8_STAGE(PG8_SA(0, 0), cA, voffA); PG8_STAGE(PG8_SB(0, 1), cB + hstep, voffB); PG8_STAGE(PG8_SA(0, 1), cA + hstep, voffA);
        if (wr == 1) PG8_BAR;
        PG8_WAIT_V(4); PG8_BAR;
        PG8_STAGE(PG8_SB(1, 0), cB + kstep, voffB); PG8_STAGE(PG8_SA(1, 0), cA + kstep, voffA); PG8_STAGE(PG8_SB(1, 1), cB + hstep + kstep, voffB);
        PG8_WAIT_V(6); PG8_BAR;
    }
    for (;;) {
        const bool has_next = S.next(ui + 1, nxt);
        const char* nA = has_next ? (const char*)g.A + (size_t)nxt.pm * tstep : cA; const char* nB = has_next ? (const char*)g.Bt + (size_t)nxt.pn * tstep : cB;
        for (int t = 0; t < nt; t += 2) {
            const bool last = (t == nt - 2);
            const char* a1 = cA + (size_t)(t + 1) * kstep;
            const char* a2 = last ? nA : cA + (size_t)(t + 2) * kstep; const char* b2 = last ? nB : cB + (size_t)(t + 2) * kstep;
            const char* a3 = a2 + kstep; const char* b3 = b2 + kstep;
            if (last && has_next) S.a_ready(nxt);
            if constexpr (SP2) {
            PG8_LDB(B0, 0, 0); PG8_LDB(B1, 0, 1); PG8_SCHED; PG8_LDA(At, 0, 0); PG8_STAGE(PG8_SA(1, 1), a1 + hstep, voffA);
            PG8_WAIT_V(8); PG8_WAIT_L(0); PG8_BAR; PG8_MMA(0, 0, At, B0); PG8_MMA(0, 1, At, B1); PG8_BAR; PG8_SCHED;
            PG8_LDA(At, 0, 1); PG8_STAGE(PG8_SB(0, 0), b2, voffB); PG8_STAGE(PG8_SB(0, 1), b2 + hstep, voffB); PG8_STAGE(PG8_SA(0, 0), a2, voffA);
            PG8_WAIT_V(8); PG8_WAIT_L(0); PG8_BAR; PG8_MMA(1, 0, At, B0); PG8_MMA(1, 1, At, B1); PG8_BAR; PG8_SCHED;
            PG8_LDB(B0, 1, 0); PG8_LDB(B1, 1, 1); PG8_SCHED; PG8_LDA(At, 1, 0); PG8_STAGE(PG8_SA(0, 1), a2 + hstep, voffA);
            PG8_WAIT_V(8); PG8_WAIT_L(0); PG8_BAR; PG8_MMA(0, 0, At, B0); PG8_MMA(0, 1, At, B1); PG8_BAR; PG8_SCHED;
            PG8_LDA(At, 1, 1); PG8_STAGE(PG8_SB(1, 0), b3, voffB); PG8_STAGE(PG8_SB(1, 1), b3 + hstep, voffB); PG8_STAGE(PG8_SA(1, 0), a3, voffA);
            PG8_WAIT_V(8); PG8_WAIT_L(0); PG8_BAR; PG8_MMA(1, 0, At, B0); PG8_MMA(1, 1, At, B1); PG8_BAR; PG8_SCHED;
            } else {
            PG8_LDB(B0, 0, 0); PG8_SCHED; PG8_LDA(At, 0, 0); PG8_STAGE(PG8_SA(1, 1), a1 + hstep, voffA);
            PG8_WAIT_L(8); PG8_BAR; PG8_WAIT_L(0); PG8_MMA(0, 0, At, B0); PG8_BAR; PG8_SCHED;
            PG8_LDB(B1, 0, 1); PG8_STAGE(PG8_SB(0, 0), b2, voffB);
            PG8_BAR; PG8_WAIT_L(0); PG8_MMA(0, 1, At, B1); PG8_BAR;
            PG8_LDA(At, 0, 1); PG8_STAGE(PG8_SA(0, 0), a2, voffA);
            PG8_BAR; PG8_WAIT_L(0); PG8_MMA(1, 0, At, B0); PG8_BAR; PG8_SCHED;
            PG8_STAGE(PG8_SB(0, 1), b2 + hstep, voffB);
            PG8_WAIT_V(6); PG8_BAR; PG8_MMA(1, 1, At, B1); PG8_BAR;
            PG8_LDB(B0, 1, 0); PG8_SCHED; PG8_LDA(At, 1, 0); PG8_STAGE(PG8_SA(0, 1), a2 + hstep, voffA);
            PG8_WAIT_L(8); PG8_BAR; PG8_WAIT_L(0); PG8_MMA(0, 0, At, B0); PG8_BAR; PG8_SCHED;
            PG8_LDB(B1, 1, 1); PG8_STAGE(PG8_SB(1, 0), b3, voffB);
            PG8_BAR; PG8_WAIT_L(0); PG8_MMA(0, 1, At, B1); PG8_BAR;
            PG8_LDA(At, 1, 1); PG8_STAGE(PG8_SA(1, 0), a3, voffA);
            PG8_BAR; PG8_WAIT_L(0); PG8_MMA(1, 0, At, B0); PG8_BAR; PG8_SCHED;
            PG8_STAGE(PG8_SB(1, 1), b3 + hstep, voffB);
            PG8_WAIT_V(6); PG8_BAR; PG8_MMA(1, 1, At, B1); PG8_BAR;
            }
        }
        if constexpr (ALIGN_EPI) { if (wr == 0) PG8_BAR; }
        if constexpr (!Epi::AFTER_DRAIN) { E(acc, cur, wr, wc, fr, fq); S.done(cur); }
        if (!has_next) break;
#pragma unroll
        for (int a = 0; a < 2; ++a)
#pragma unroll
            for (int b = 0; b < 2; ++b)
#pragma unroll
                for (int m = 0; m < 4; ++m)
#pragma unroll
                    for (int n = 0; n < 2; ++n) acc[a][b][m][n] = (f32x4){0.f, 0.f, 0.f, 0.f};
        cur = nxt; cA = nA; cB = nB; ++ui;
        if constexpr (ALIGN_EPI) { if (wr == 1) PG8_BAR; }
    }
    PG8_WAIT_V(0);
    if constexpr (!ALIGN_EPI) { if (wr == 0) PG8_BAR; }
    PG8_BAR;
#undef PG8_SA
#undef PG8_SB
#undef PG8_STAGE
#undef PG8_LDA
#undef PG8_LDB
#undef PG8_MMA
#undef PG8_WAIT_V
#undef PG8_WAIT_L
#undef PG8_BAR
#undef PG8_SCHED
}
}

constexpr int NWAVES = 8, LDS_BYTES = 147456;
__device__ __forceinline__ float wave_sum(float v) {
#pragma unroll
    for (int o = 1; o < 64; o <<= 1) v += __shfl_xor(v, o);
    return v;
}
template <bool PERM>
__device__ __forceinline__ void p0_transpose_item(const float* W, int K, int N, int NP, bf16_t* WT, LAS float* scr, int item, int lane, const float* ksc = nullptr) {
    const int nblk = NP / 32, kb = item / nblk, nb = item % nblk, k0 = 64 * kb, n0 = 32 * nb;
    int ncol = n0 + (lane & 31); if (PERM) ncol = nsa_col_orig(ncol);
#pragma unroll 8
    for (int i = 0; i < 32; ++i) { const int kk = 2 * i + (lane >> 5); scr[kk * 33 + (lane & 31)] = ncol >= 0 ? W[(size_t)(k0 + kk) * N + ncol] * (ksc ? ksc[k0 + kk] : 1.0f) : 0.f; }
    LDS_WAIT(); asm volatile("" ::: "memory");
    const int c = lane & 7;
#pragma unroll
    for (int j = 0; j < 4; ++j) { const int n = (lane >> 3) + 8 * j; const LAS float* s = scr + (8 * c) * 33 + n;
        v4u o; o.x = pk2(s[0 * 33], s[1 * 33]); o.y = pk2(s[2 * 33], s[3 * 33]); o.z = pk2(s[4 * 33], s[5 * 33]); o.w = pk2(s[6 * 33], s[7 * 33]);
        *(v4u*)(WT + (size_t)(n0 + n) * K + k0 + 8 * c) = o; }
    LDS_WAIT(); asm volatile("" ::: "memory");
}
__device__ __forceinline__ void rms_row_to_bf16(const float* xrow, const float* g, bf16_t* orow, int lane) {
    const f32x4* xr = (const f32x4*)xrow + lane; const f32x4* gr = (const f32x4*)g + lane;
    f32x4 v[4]; float s = 0.f;
#pragma unroll
    for (int j = 0; j < 4; ++j) { v[j] = xr[64 * j]; s += (v[j].x * v[j].x + v[j].y * v[j].y) + (v[j].z * v[j].z + v[j].w * v[j].w); }
    const float rs = 1.f / sqrtf(wave_sum(s) * (1.f / 1024.f) + EPS);
    unsigned long long* o8 = (unsigned long long*)orow + lane;
#pragma unroll
    for (int j = 0; j < 4; ++j) { const f32x4 gg = gr[64 * j];
        o8[64 * j] = (unsigned long long)pk2(v[j].x * rs * gg.x, v[j].y * rs * gg.y) | ((unsigned long long)pk2(v[j].z * rs * gg.z, v[j].w * rs * gg.w) << 32); }
}
__device__ __forceinline__ void rms_row_inplace(float* xrow, const float* g, int lane) {
    f32x4* xr = (f32x4*)xrow + lane; const f32x4* gr = (const f32x4*)g + lane;
    f32x4 v[4]; float s = 0.f;
#pragma unroll
    for (int j = 0; j < 4; ++j) { v[j] = xr[64 * j]; s += (v[j].x * v[j].x + v[j].y * v[j].y) + (v[j].z * v[j].z + v[j].w * v[j].w); }
    const float rs = 1.f / sqrtf(wave_sum(s) * (1.f / 1024.f) + EPS);
#pragma unroll
    for (int j = 0; j < 4; ++j) xr[64 * j] = v[j] * rs * gr[64 * j];
}

typedef float f32x16 __attribute__((ext_vector_type(16)));
typedef short s16x4 __attribute__((ext_vector_type(4)));
typedef short v4i16_t __attribute__((ext_vector_type(4)));
typedef unsigned v2u __attribute__((ext_vector_type(2)));
#define MFMA32(a, b, c) __builtin_amdgcn_mfma_f32_32x32x16_bf16(a, b, c, 0, 0, 0)
constexpr float LOG2E = 1.4426950408889634f, LN2 = 0.6931471805599453f;
__device__ __forceinline__ int crow(int r, int hi) { return (r & 3) + 8 * (r >> 2) + 4 * hi; }
__device__ __forceinline__ s16x4 vtr(const LAS unsigned char* p) { return __builtin_bit_cast(s16x4, __builtin_amdgcn_ds_read_tr16_b64_v4i16((LAS v4i16_t*)p)); }
__device__ __forceinline__ float xmax32(float v) { auto rr = __builtin_amdgcn_permlane32_swap(__float_as_uint(v), __float_as_uint(v), false, false); return fmaxf(__uint_as_float(rr[0]), __uint_as_float(rr[1])); }
__device__ __forceinline__ float xsum32(float v) { auto rr = __builtin_amdgcn_permlane32_swap(__float_as_uint(v), __float_as_uint(v), false, false); return __uint_as_float(rr[0]) + __uint_as_float(rr[1]); }
__device__ __forceinline__ float ex2(float x) { return __builtin_amdgcn_exp2f(x); }
__device__ __forceinline__ bf16x8 pack8(const f32x16& v, int r0) {
    v4u w; w.x = pg8::cvt_pk_bf16(v[r0], v[r0 + 1]); w.y = pg8::cvt_pk_bf16(v[r0 + 2], v[r0 + 3]); w.z = pg8::cvt_pk_bf16(v[r0 + 4], v[r0 + 5]); w.w = pg8::cvt_pk_bf16(v[r0 + 6], v[r0 + 7]);
    return __builtin_bit_cast(bf16x8, w);
}
__device__ __forceinline__ bf16x8 vfrag(const LAS unsigned char* p) { const s16x4 a = vtr(p), b = vtr(p + 512); return (bf16x8){a[0], a[1], a[2], a[3], b[0], b[1], b[2], b[3]}; }

struct KVRegs { v4u k, v; };
__device__ __forceinline__ KVRegs kv_load(const bf16_t* Kg, const bf16_t* Vg, int ld, int tid) {
    const int key = (tid & 7) + 8 * (tid >> 6), ch = (tid >> 3) & 7;
    KVRegs r; r.k = *(const v4u*)(Kg + (size_t)key * ld + ch * 8); r.v = *(const v4u*)(Vg + (size_t)key * ld + ch * 8); return r;
}
__device__ __forceinline__ void kv_store(LAS unsigned char* buf, const KVRegs& r, int tid) {
    const int key = (tid & 7) + 8 * (tid >> 6), ch = (tid >> 3) & 7;
    *(LAS v4u*)(buf + ch * 1024 + key * 16) = r.k;
    *(LAS v4u*)(buf + 8192 + (ch >> 2) * 4096 + key * 64 + (ch & 3) * 16) = r.v;
}
struct Sm64 { f32x16 o[2]; float m, l; };
__device__ __forceinline__ void sm64_init(Sm64& st) {
#pragma unroll
    for (int r = 0; r < 16; ++r) { st.o[0][r] = 0.f; st.o[1][r] = 0.f; }
    st.m = -1e30f; st.l = 0.f;
}
__device__ __forceinline__ void qk64(f32x16& s0, f32x16& s1, const bf16x8 (&qf)[4], const LAS unsigned char* buf, int r32, int hi) {
    const LAS unsigned char* kp = buf + hi * 1024 + r32 * 16;
#pragma unroll
    for (int r = 0; r < 16; ++r) { s0[r] = 0.f; s1[r] = 0.f; }
#pragma unroll
    for (int d0 = 0; d0 < 4; ++d0) { const bf16x8 k0 = *(const LAS bf16x8*)(kp + d0 * 2048), k1 = *(const LAS bf16x8*)(kp + d0 * 2048 + 512);
        s0 = MFMA32(k0, qf[d0], s0); s1 = MFMA32(k1, qf[d0], s1); }
}
__device__ __forceinline__ void pv64(f32x16 (&o)[2], const f32x16& p0, const f32x16& p1, const LAS unsigned char* buf, int lane, int hi) {
    const bf16x8 pf0 = pack8(p0, 0), pf1 = pack8(p0, 8), pf2 = pack8(p1, 0), pf3 = pack8(p1, 8);
    const LAS unsigned char* vp = buf + 8192 + ((lane >> 4) & 1) * 32 + (lane & 3) * 8 + (4 * hi + ((lane & 15) >> 2)) * 64;
#pragma unroll
    for (int dt = 0; dt < 2; ++dt) {
        o[dt] = MFMA32(vfrag(vp + dt * 4096), pf0, o[dt]); o[dt] = MFMA32(vfrag(vp + dt * 4096 + 1024), pf1, o[dt]);
        o[dt] = MFMA32(vfrag(vp + dt * 4096 + 2048), pf2, o[dt]); o[dt] = MFMA32(vfrag(vp + dt * 4096 + 3072), pf3, o[dt]);
    }
}
template <class F>
__device__ __forceinline__ void tile64(Sm64& st, const bf16x8 (&qf)[4], const LAS unsigned char* buf, int lane, float c2, F f) {
    const int r32 = lane & 31, hi = lane >> 5;
    f32x16 s0, s1; qk64(s0, s1, qf, buf, r32, hi);
    float mx = -INFINITY;
#pragma unroll
    for (int r = 0; r < 16; ++r) { const int k0 = crow(r, hi); s0[r] = fmaf(s0[r], c2, f(k0)); s1[r] = fmaf(s1[r], c2, f(k0 + 32)); mx = fmaxf(mx, fmaxf(s0[r], s1[r])); }
    mx = xmax32(mx);
    const float mn = fmaxf(st.m, mx), al = ex2(st.m - mn);
    float sum = 0.f;
#pragma unroll
    for (int r = 0; r < 16; ++r) { s0[r] = ex2(s0[r] - mn); s1[r] = ex2(s1[r] - mn); sum += s0[r] + s1[r]; }
    sum = xsum32(sum);
    st.l = st.l * al + sum; st.m = mn;
#pragma unroll
    for (int r = 0; r < 16; ++r) { st.o[0][r] *= al; st.o[1][r] *= al; }
    pv64(st.o, s0, s1, buf, lane, hi);
}

__device__ __forceinline__ void nsa_unit(const Params& p, LAS unsigned char* lds, int unit) {
    const int tid = fresh_tid(), lane = tid & 63, r32 = lane & 31, hi = lane >> 5, w = __builtin_amdgcn_readfirstlane(tid >> 6);
    const int q32 = unit & 63, g = (unit >> 6) & 1, b = unit >> 7;
    const int q0 = q32 * 32, cur = q0 >> 6, hidx = g * 8 + w, s = q0 + r32;
    const size_t trow = (size_t)b * SEQ + s;
    const bf16_t* Q1 = (const bf16_t*)(p.ws + OFF_Q1); const bf16_t* KV = (const bf16_t*)(p.ws + OFF_KV1); const bf16_t* gate = (const bf16_t*)(p.ws + OFF_GATE);
    const bf16_t* ckv = (const bf16_t*)(p.ws + OFF_CMPKV); const bf16_t* Z1 = (const bf16_t*)(p.ws + OFF_Z1); bf16_t* Y1 = (bf16_t*)(p.ws + OFF_Y1);
    const float slope2 = exp2f(-0.5f * (float)(hidx + 1)) * LOG2E, c2 = 0.125f * LOG2E;
    LAS unsigned char* buf0 = lds; LAS unsigned char* buf1 = lds + 16384;
    LAS float* impw = (LAS float*)(lds + 32768) + w * 1024; LAS float* impt = (LAS float*)(lds + 65536); LAS unsigned* msk = (LAS unsigned*)(lds + 65536 + 4224);
    bf16x8 qf[4];
#pragma unroll
    for (int d0 = 0; d0 < 4; ++d0) qf[d0] = *(const bf16x8*)(Q1 + trow * 1024 + hidx * 64 + d0 * 16 + hi * 8);
    const float g0 = sigmoidf_(bf2f(gate[trow * 256 + hidx * 3 + 0])), g1 = sigmoidf_(bf2f(gate[trow * 256 + hidx * 3 + 1])), g2 = sigmoidf_(bf2f(gate[trow * 256 + hidx * 3 + 2]));
    f32x16 ot[2];
    {
        const bf16_t* kc = ckv + (((size_t)0 * NB + b) * 2 + g) * 128 * 64; const bf16_t* vc = ckv + (((size_t)1 * NB + b) * 2 + g) * 128 * 64;
        { const KVRegs r0 = kv_load(kc, vc, 64, tid), r1 = kv_load(kc + 64 * 64, vc + 64 * 64, 64, tid); kv_store(buf0, r0, tid); kv_store(buf1, r1, tid); }
        __syncthreads();
        f32x16 sc[4]; qk64(sc[0], sc[1], qf, buf0, r32, hi); qk64(sc[2], sc[3], qf, buf1, r32, hi);
        float mx = -INFINITY;
#pragma unroll
        for (int T = 0; T < 4; ++T)
#pragma unroll
            for (int r = 0; r < 16; ++r) { const int n = 32 * T + crow(r, hi), dist = s - (16 * n + 31);
                const float v = dist >= 0 ? fmaf(sc[T][r], c2, -slope2 * (float)dist) : -INFINITY; sc[T][r] = v; mx = fmaxf(mx, v); }
        mx = fmaxf(xmax32(mx), -1e30f);
        float sum = 0.f;
#pragma unroll
        for (int T = 0; T < 4; ++T)
#pragma unroll
            for (int r = 0; r < 16; ++r) { sc[T][r] = ex2(sc[T][r] - mx); sum += sc[T][r]; }
        sum = xsum32(sum);
        const float inv = sum > 0.f ? 1.0f / sum : 0.f;
        float prev_y = 0.f;
#pragma unroll
        for (int T = 0; T < 4; ++T)
#pragma unroll
            for (int c = 0; c < 4; ++c) { const float x3 = sc[T][4 * c + 3], y = __shfl_xor(x3, 32);
                const float sum4 = (sc[T][4 * c] + sc[T][4 * c + 1]) + (sc[T][4 * c + 2] + x3);
                impw[r32 * 32 + 8 * T + 2 * c + hi] = (sum4 + (hi ? y : prev_y)) * inv; prev_y = y; }
        f32x16 oc[2];
#pragma unroll
        for (int r = 0; r < 16; ++r) { oc[0][r] = 0.f; oc[1][r] = 0.f; }
        pv64(oc, sc[0], sc[1], buf0, lane, hi); pv64(oc, sc[2], sc[3], buf1, lane, hi);
        const float f0 = g0 * inv;
#pragma unroll
        for (int r = 0; r < 16; ++r) { ot[0][r] = oc[0][r] * f0; ot[1][r] = oc[1][r] * f0; }
    }
    __syncthreads();
    for (int idx = tid; idx < 1024; idx += 512) { float a = 0.f;
#pragma unroll
        for (int ww = 0; ww < 8; ++ww) a += ((LAS float*)(lds + 32768))[ww * 1024 + idx];
        impt[(idx >> 5) * 33 + (idx & 31)] = a; }
    __syncthreads();
    {
        const int nf = cur == 0 ? 1 : (cur == 1 ? 2 : 3), need = 8 - nf;
#pragma unroll
        for (int pi = 0; pi < 2; ++pi) {
            const int q = pi * 16 + 2 * w + hi, j = r32; bool sel;
            if (j == 0 || j == cur || j == cur - 1) sel = true;
            else if (j <= cur - 2) { const float v = impt[q * 33 + j]; int rank = 0;
                for (int j2 = 1; j2 <= cur - 2; ++j2) { const float v2 = impt[q * 33 + j2]; rank += (j2 != j && (v2 > v || (v2 == v && j2 < j))) ? 1 : 0; }
                sel = rank < need; }
            else sel = false;
            const unsigned long long bal = __ballot(sel);
            if (lane == 0) msk[pi * 16 + 2 * w] = (unsigned)bal;
            if (lane == 32) msk[pi * 16 + 2 * w + 1] = (unsigned)(bal >> 32);
        }
    }
    __syncthreads();
    const unsigned mymask = msk[r32];
    unsigned uni = mymask;
#pragma unroll
    for (int o = 1; o < 32; o <<= 1) uni |= (unsigned)__shfl_xor((int)uni, o);
    uni = (unsigned)__builtin_amdgcn_readfirstlane((int)uni);
    const int nslc = __builtin_popcount(uni), wlo = (q0 - 511 > 0 ? q0 - 511 : 0) >> 6, nwin = cur - wlo + 1, ntile = nslc + nwin;
    const bf16_t* kvb = KV + (size_t)b * SEQ * 768 + g * 64;
    unsigned rem_l = uni, rem_c = uni;
    auto tile_j = [&](int i, unsigned& rem) { int j; if (i < nslc) { j = __builtin_ctz(rem); rem &= rem - 1; } else j = wlo + (i - nslc); return j; };
    { const int j = tile_j(0, rem_l); const int col = 0 < nslc ? 256 : 512; const KVRegs r = kv_load(kvb + (size_t)64 * j * 768 + col, kvb + (size_t)64 * j * 768 + col + 128, 768, tid); kv_store(buf0, r, tid); }
    __syncthreads();
    Sm64 st; sm64_init(st);
    for (int i = 0; i < ntile; ++i) {
        KVRegs rn;
        if (i + 1 < ntile) { const int j = tile_j(i + 1, rem_l); const int col = (i + 1) < nslc ? 256 : 512; rn = kv_load(kvb + (size_t)64 * j * 768 + col, kvb + (size_t)64 * j * 768 + col + 128, 768, tid); }
        const int j = tile_j(i, rem_c); const LAS unsigned char* buf = (i & 1) ? buf1 : buf0;
        if (i < nslc) { const bool has = (mymask >> j) & 1u;
            tile64(st, qf, buf, lane, c2, [&](int kin) { const int kpos = 64 * j + kin; return (has && kpos <= s) ? slope2 * (float)(kpos - s) : -INFINITY; });
            if (i == nslc - 1) { const float f1 = g1 / st.l;
#pragma unroll
                for (int r = 0; r < 16; ++r) { ot[0][r] += st.o[0][r] * f1; ot[1][r] += st.o[1][r] * f1; }
                sm64_init(st); }
        } else {
            tile64(st, qf, buf, lane, c2, [&](int kin) { const int kpos = 64 * j + kin; return (kpos <= s && kpos >= s - 511) ? slope2 * (float)(kpos - s) : -INFINITY; });
        }
        if (i + 1 < ntile) kv_store((i & 1) ? buf0 : buf1, rn, tid);
        __syncthreads();
    }
    { const float f2 = g2 / st.l;
#pragma unroll
      for (int r = 0; r < 16; ++r) { ot[0][r] += st.o[0][r] * f2; ot[1][r] += st.o[1][r] * f2; } }
#pragma unroll
    for (int dt = 0; dt < 2; ++dt)
#pragma unroll
        for (int c = 0; c < 4; ++c) { const int d = 32 * dt + 8 * c + 4 * hi;
            const v2u zz = *(const v2u*)(Z1 + trow * 1024 + hidx * 64 + d);
            const float y0 = ot[dt][4 * c] * siluf_(lo16(zz.x)), y1 = ot[dt][4 * c + 1] * siluf_(hi16(zz.x)), y2 = ot[dt][4 * c + 2] * siluf_(lo16(zz.y)), y3 = ot[dt][4 * c + 3] * siluf_(hi16(zz.y));
            v2u o2; o2.x = pg8::cvt_pk_bf16(y0, y1); o2.y = pg8::cvt_pk_bf16(y2, y3);
            *(v2u*)(Y1 + trow * 1280 + hidx * 64 + d) = o2; }
}

__device__ __forceinline__ void mem_unit(const bf16_t* mkv, const bf16_t* QMb, const bf16_t* ZMb, bf16_t* Y, int ldy, LAS unsigned char* lds, int unit) {
    const int tid = fresh_tid(), lane = tid & 63, r32 = lane & 31, hi = lane >> 5, w = __builtin_amdgcn_readfirstlane(tid >> 6);
    const int qc = unit & 7, h = (unit >> 3) & 3, b = unit >> 5;
    const size_t trow = (size_t)b * SEQ + qc * 256 + w * 32 + r32;
    const bf16_t* kb = mkv + (size_t)b * NMEM * 512 + h * 64;
#pragma unroll
    for (int t = 0; t < 4; ++t) { const KVRegs r = kv_load(kb + (size_t)t * 64 * 512, kb + (size_t)t * 64 * 512 + 256, 512, tid); kv_store(lds + t * 16384, r, tid); }
    bf16x8 qf[4];
#pragma unroll
    for (int d0 = 0; d0 < 4; ++d0) qf[d0] = *(const bf16x8*)(QMb + trow * 256 + h * 64 + d0 * 16 + hi * 8);
    __syncthreads();
    Sm64 st; sm64_init(st);
#pragma unroll 1
    for (int t = 0; t < 4; ++t) tile64(st, qf, lds + t * 16384, lane, 0.125f * LOG2E, [](int) { return 0.f; });
    const float inv = 1.0f / st.l;
#pragma unroll
    for (int dt = 0; dt < 2; ++dt)
#pragma unroll
        for (int c = 0; c < 4; ++c) { const int d = 32 * dt + 8 * c + 4 * hi;
            const v2u zz = *(const v2u*)(ZMb + trow * 256 + h * 64 + d);
            const float y0 = st.o[dt][4 * c] * inv * siluf_(lo16(zz.x)), y1 = st.o[dt][4 * c + 1] * inv * siluf_(hi16(zz.x)), y2 = st.o[dt][4 * c + 2] * inv * siluf_(lo16(zz.y)), y3 = st.o[dt][4 * c + 3] * inv * siluf_(hi16(zz.y));
            v2u o2; o2.x = pg8::cvt_pk_bf16(y0, y1); o2.y = pg8::cvt_pk_bf16(y2, y3);
            *(v2u*)(Y + trow * ldy + h * 64 + d) = o2; }
    __syncthreads();
}

__device__ __forceinline__ void dil_task(const Params& p, LAS unsigned char* vl  , int task, int lane) {
    const int r32 = lane & 31, hi = lane >> 5;
    const int grp = task >> 11, idx = task & 2047, dil = grp == 0 ? 1 : (grp == 1 ? 4 : 16), lg = grp * 2, nq = 64 >> lg;
    const int qi = idx & (nq - 1), rest = idx >> (6 - lg), h = rest & 3, brho = rest >> 2, b = brho >> lg, rho = brho & (dil - 1);
    const int hh = grp * 4 + h, i0 = 32 * qi, isub = i0 + r32;
    bf16_t* Q = (bf16_t*)(p.ws + OFF_Q); const bf16_t* K = (const bf16_t*)(p.ws + OFF_K); const bf16_t* V = (const bf16_t*)(p.ws + OFF_V); float* LSE = (float*)(p.ws + OFF_LSE);
    const size_t base = (size_t)b * SEQ + rho;
    const size_t trow = base + (size_t)isub * dil;
    const float slope2 = exp2f(-8.0f * (float)(hh + 1) / 12.0f) * (float)dil * LOG2E, c2 = 0.08838834764831845f * LOG2E;
    bf16x8 qf[8];
#pragma unroll
    for (int d0 = 0; d0 < 8; ++d0) qf[d0] = *(const bf16x8*)(Q + trow * 1536 + hh * 128 + d0 * 16 + hi * 8);
    f32x16 o[4]; float m = -1e30f, l = 0.f;
#pragma unroll
    for (int dt = 0; dt < 4; ++dt)
#pragma unroll
        for (int r = 0; r < 16; ++r) o[dt][r] = 0.f;
    const LAS unsigned char* vp = vl + ((lane >> 4) & 1) * 32 + (lane & 3) * 8 + (4 * hi + ((lane & 15) >> 2)) * 64;
    for (int jt = (qi - 4 > 0 ? qi - 4 : 0); jt <= qi; ++jt) {
        asm volatile("s_waitcnt lgkmcnt(0)" ::: "memory");
#pragma unroll
        for (int it = 0; it < 8; ++it) { const int e = it * 64 + lane, key = e >> 4, ch = e & 15;
            const v4u v = *(const v4u*)(V + (base + (size_t)(32 * jt + key) * dil) * 1536 + hh * 128 + ch * 8);
            *(LAS v4u*)(vl + (ch >> 2) * 2048 + key * 64 + (ch & 3) * 16) = v; }
        f32x16 sc;
#pragma unroll
        for (int r = 0; r < 16; ++r) sc[r] = 0.f;
        const bf16_t* kr = K + (base + (size_t)(32 * jt + r32) * dil) * 1536 + hh * 128 + hi * 8;
#pragma unroll
        for (int d0 = 0; d0 < 8; ++d0) { const bf16x8 kf = *(const bf16x8*)(kr + d0 * 16); sc = MFMA32(kf, qf[d0], sc); }
        float mx = -INFINITY;
#pragma unroll
        for (int r = 0; r < 16; ++r) { const int dist = isub - (32 * jt + crow(r, hi));
            const float v = (dist >= 0 && dist <= 128) ? fmaf(sc[r], c2, -slope2 * (float)dist) : -INFINITY; sc[r] = v; mx = fmaxf(mx, v); }
        mx = xmax32(mx);
        const float mn = fmaxf(m, mx), al = ex2(m - mn);
        float sum = 0.f;
#pragma unroll
        for (int r = 0; r < 16; ++r) { sc[r] = ex2(sc[r] - mn); sum += sc[r]; }
        sum = xsum32(sum); l = l * al + sum; m = mn;
#pragma unroll
        for (int dt = 0; dt < 4; ++dt)
#pragma unroll
            for (int r = 0; r < 16; ++r) o[dt][r] *= al;
        const bf16x8 pf0 = pack8(sc, 0), pf1 = pack8(sc, 8);
        asm volatile("s_waitcnt lgkmcnt(0)" ::: "memory");
#pragma unroll
        for (int dt = 0; dt < 4; ++dt) { o[dt] = MFMA32(vfrag(vp + dt * 2048), pf0, o[dt]); o[dt] = MFMA32(vfrag(vp + dt * 2048 + 1024), pf1, o[dt]); }
    }
    const float inv = 1.0f / l;
#pragma unroll
    for (int dt = 0; dt < 4; ++dt)
#pragma unroll
        for (int c = 0; c < 4; ++c) { const int d = 32 * dt + 8 * c + 4 * hi;
            v2u o2; o2.x = pg8::cvt_pk_bf16(o[dt][4 * c] * inv, o[dt][4 * c + 1] * inv); o2.y = pg8::cvt_pk_bf16(o[dt][4 * c + 2] * inv, o[dt][4 * c + 3] * inv);
            *(v2u*)(Q + trow * 1536 + hh * 128 + d) = o2; }
    if (hi == 0) LSE[((size_t)grp * T_ + trow) * 4 + h] = (m + __builtin_amdgcn_logf(l)) * LN2;
}

__device__ __forceinline__ float sigm_(float x) { return __builtin_amdgcn_rcpf(1.0f + ex2(-x * LOG2E)); }
__device__ __forceinline__ void lru_unit(const Params& p, LAS unsigned char* lds, int unit) {
    const int tid = fresh_tid(), lane = tid & 63, r32 = lane & 31, hi = lane >> 5, w = __builtin_amdgcn_readfirstlane(tid >> 6);
    const int hh = unit & 1, blk = (unit >> 1) & 15, b = unit >> 5;
    const int cj = blk * 64 + hh * 32 + r32;
    const bf16_t* xaza = (const bf16_t*)p.out; bf16_t* Y0 = (bf16_t*)(p.ws + OFF_Y0);
    LAS float* cw = (LAS float*)lds; LAS float* tot = (LAS float*)(lds + 2048); LAS float* xcs = (LAS float*)(lds + 8192 + w * 8704);
    if (tid < 256) cw[tid] = p.conv_w[(tid >> 6) * 1024 + blk * 64 + (tid & 63)]; else if (tid < 320) cw[tid] = p.conv_b[blk * 64 + tid - 256];
    bf16x8 wa[4], wx[4];
#pragma unroll
    for (int ks = 0; ks < 4; ++ks) { float fa[8], fx[8];
#pragma unroll
        for (int jj = 0; jj < 8; ++jj) { const size_t wi = (size_t)blk * 4096 + (size_t)(16 * ks + 8 * hi + jj) * 64 + hh * 32 + r32; fa[jj] = p.ga_w[wi]; fx[jj] = p.gx_w[wi]; }
        v4u a4, x4; a4.x = pg8::cvt_pk_bf16(fa[0], fa[1]); a4.y = pg8::cvt_pk_bf16(fa[2], fa[3]); a4.z = pg8::cvt_pk_bf16(fa[4], fa[5]); a4.w = pg8::cvt_pk_bf16(fa[6], fa[7]);
        x4.x = pg8::cvt_pk_bf16(fx[0], fx[1]); x4.y = pg8::cvt_pk_bf16(fx[2], fx[3]); x4.z = pg8::cvt_pk_bf16(fx[4], fx[5]); x4.w = pg8::cvt_pk_bf16(fx[6], fx[7]);
        wa[ks] = __builtin_bit_cast(bf16x8, a4); wx[ks] = __builtin_bit_cast(bf16x8, x4); }
    const float ba = p.ga_b[cj], bx = p.gx_b[cj], sp8 = -8.0f * log1pf(expf(-p.lam[cj]));
    __syncthreads();
    float hchunk = 0.f;
#pragma unroll 1
    for (int c = 0; c < 8; ++c) {
        const int t0 = c * 256 + w * 32;
        const size_t rowb = (size_t)b * SEQ + t0;
        float zv[16];
#pragma unroll
        for (int r = 0; r < 16; ++r) zv[r] = bf2f(xaza[(rowb + crow(r, hi)) * 2048 + 1024 + cj]);
        bf16x8 af[4];
        asm volatile("s_waitcnt lgkmcnt(0)" ::: "memory");
#pragma unroll
        for (int ks = 0; ks < 4; ++ks) { const int i0 = 16 * ks + 8 * hi; float acc[8];
            { const f32x4 b0 = *(const LAS f32x4*)(cw + 256 + i0), b1 = *(const LAS f32x4*)(cw + 256 + i0 + 4); acc[0] = b0[0]; acc[1] = b0[1]; acc[2] = b0[2]; acc[3] = b0[3]; acc[4] = b1[0]; acc[5] = b1[1]; acc[6] = b1[2]; acc[7] = b1[3]; }
#pragma unroll
            for (int k = 0; k < 4; ++k) { const int tt = t0 + r32 - 3 + k;
                v4u v = (v4u){0u, 0u, 0u, 0u}; if (tt >= 0) v = *(const v4u*)(xaza + ((size_t)b * SEQ + tt) * 2048 + blk * 64 + i0);
                const f32x4 w0 = *(const LAS f32x4*)(cw + k * 64 + i0), w1 = *(const LAS f32x4*)(cw + k * 64 + i0 + 4);
                acc[0] += w0[0] * lo16(v.x); acc[1] += w0[1] * hi16(v.x); acc[2] += w0[2] * lo16(v.y); acc[3] += w0[3] * hi16(v.y);
                acc[4] += w1[0] * lo16(v.z); acc[5] += w1[1] * hi16(v.z); acc[6] += w1[2] * lo16(v.w); acc[7] += w1[3] * hi16(v.w); }
            *(LAS f32x4*)(xcs + r32 * 68 + i0) = (f32x4){acc[0], acc[1], acc[2], acc[3]}; *(LAS f32x4*)(xcs + r32 * 68 + i0 + 4) = (f32x4){acc[4], acc[5], acc[6], acc[7]};
            v4u pk; pk.x = pg8::cvt_pk_bf16(acc[0], acc[1]); pk.y = pg8::cvt_pk_bf16(acc[2], acc[3]); pk.z = pg8::cvt_pk_bf16(acc[4], acc[5]); pk.w = pg8::cvt_pk_bf16(acc[6], acc[7]);
            af[ks] = __builtin_bit_cast(bf16x8, pk); }
        f32x16 ra, rx;
#pragma unroll
        for (int r = 0; r < 16; ++r) { ra[r] = 0.f; rx[r] = 0.f; }
#pragma unroll
        for (int ks = 0; ks < 4; ++ks) { ra = MFMA32(af[ks], wa[ks], ra); rx = MFMA32(af[ks], wx[ks], rx); }
        asm volatile("s_waitcnt lgkmcnt(0)" ::: "memory");
        float a[16], u[16];
#pragma unroll
        for (int r = 0; r < 16; ++r) { const int tl = crow(r, hi); const float xc = xcs[tl * 68 + hh * 32 + r32];
            const float rg = sigm_(ra[r] + ba), ig = sigm_(rx[r] + bx), la = sp8 * rg;
            a[r] = ex2(la * LOG2E);
            const float x2 = 2.0f * la, om = x2 > -0.1f ? -x2 * (1.0f + 0.5f * x2 * (1.0f + 0.33333333f * x2 * (1.0f + 0.25f * x2))) : 1.0f - a[r] * a[r];
            const float mult = (t0 + tl == 0) ? 1.0f : __builtin_sqrtf(om);
            u[r] = xc * ig * mult; }
        float EA[8], EU[8];
#pragma unroll
        for (int cg = 0; cg < 4; ++cg) { const int r0 = 4 * cg;
            const float GA = (a[r0] * a[r0 + 1]) * (a[r0 + 2] * a[r0 + 3]), GU = ((u[r0] * a[r0 + 1] + u[r0 + 1]) * a[r0 + 2] + u[r0 + 2]) * a[r0 + 3] + u[r0 + 3];
            const float PA = __shfl_xor(GA, 32), PU = __shfl_xor(GU, 32);
            EA[2 * cg] = hi ? PA : GA; EU[2 * cg] = hi ? PU : GU; EA[2 * cg + 1] = hi ? GA : PA; EU[2 * cg + 1] = hi ? GU : PU; }
        float TA = 1.f, TU = 0.f;
#pragma unroll
        for (int g = 0; g < 8; ++g) { TU = EA[g] * TU + EU[g]; TA *= EA[g]; }
        LAS float* tt2 = tot + (c & 1) * 512;
        if (hi == 0) { tt2[(w * 32 + r32) * 2] = TA; tt2[(w * 32 + r32) * 2 + 1] = TU; }
        __syncthreads();
        float h = hchunk, hin = 0.f;
#pragma unroll
        for (int ww = 0; ww < 8; ++ww) { if (ww == w) hin = h; h = tt2[(ww * 32 + r32) * 2] * h + tt2[(ww * 32 + r32) * 2 + 1]; }
        hchunk = h;
        float hown[4], hg = hin;
#pragma unroll
        for (int g = 0; g < 8; ++g) { if ((g & 1) == hi) hown[g >> 1] = hg; hg = EA[g] * hg + EU[g]; }
#pragma unroll
        for (int cg = 0; cg < 4; ++cg) { float hc = hown[cg];
#pragma unroll
            for (int q = 0; q < 4; ++q) { const int r = 4 * cg + q; hc = a[r] * hc + u[r];
                Y0[(rowb + crow(r, hi)) * 1792 + cj] = f2bf(hc * zv[r] * sigm_(zv[r])); } }
    }
    __syncthreads();
}

__device__ __forceinline__ void cmp1_task(const Params& p, int task, int lane) {
    const int r32 = lane & 31, hi = lane >> 5;
    const int ct = task & 7, rt = (task >> 3) & 3, g = (task >> 5) & 1, b = (task >> 6) & 7, kv = task >> 9;
    const bf16_t* KV = (const bf16_t*)(p.ws + OFF_KV1); const bf16_t* w1 = (const bf16_t*)(p.ws + OFF_PHIW1) + (size_t)kv * 256 * 2048; float* hid = (float*)(p.ws + OFF_CMPH);
    const float* peb = (const float*)(p.ws + OFF_PEB) + kv * 256;
    const int n = rt * 32 + r32;
    const bf16_t* ar = KV + ((size_t)b * SEQ + 16 * n) * 768 + kv * 128 + g * 64 + hi * 8;
    const bf16_t* br = w1 + (size_t)(ct * 32 + r32) * 2048 + hi * 8;
    f32x16 acc;
#pragma unroll
    for (int r = 0; r < 16; ++r) acc[r] = 0.f;
#pragma unroll 4
    for (int i = 0; i < 32; ++i) {
#pragma unroll
        for (int q = 0; q < 4; ++q) { const bf16x8 af = *(const bf16x8*)(ar + (size_t)i * 768 + 16 * q), bf = *(const bf16x8*)(br + i * 64 + 16 * q); acc = MFMA32(af, bf, acc); }
    }
    const float pb = peb[ct * 32 + r32];
    const size_t rowbase = (((size_t)kv * NB + b) * 2 + g) * 128 + rt * 32;
#pragma unroll
    for (int r = 0; r < 16; ++r) { const float v = acc[r] + pb; hid[(rowbase + crow(r, hi)) * 256 + ct * 32 + r32] = v * sigm_(v); }
}

__device__ __forceinline__ void memkv_task(const Params& p, int task, int lane) {
    const int r32 = lane & 31, hi = lane >> 5;
    const int ct = task & 15, rt = (task >> 4) & 63, l = task >> 10;
    const float* ar = p.mem + (size_t)(rt * 32 + r32) * DM + hi * 8;
    const bf16_t* br = (const bf16_t*)(p.ws + OFF_WMKV) + ((size_t)l * 512 + ct * 32 + r32) * DM + hi * 8;
    bf16_t* mkv = (bf16_t*)(p.ws + OFF_MEMKV) + (size_t)l * NB * NMEM * 512;
    f32x16 acc; float ss = 0.f;
#pragma unroll
    for (int r = 0; r < 16; ++r) acc[r] = 0.f;
#pragma unroll 4
    for (int ks = 0; ks < DM / 16; ++ks) { const f32x4 x0 = *(const f32x4*)(ar + 16 * ks), x1 = *(const f32x4*)(ar + 16 * ks + 4);
        ss += (x0[0] * x0[0] + x0[1] * x0[1]) + (x0[2] * x0[2] + x0[3] * x0[3]) + (x1[0] * x1[0] + x1[1] * x1[1]) + (x1[2] * x1[2] + x1[3] * x1[3]);
        v4u pk; pk.x = pg8::cvt_pk_bf16(x0[0], x0[1]); pk.y = pg8::cvt_pk_bf16(x0[2], x0[3]); pk.z = pg8::cvt_pk_bf16(x1[0], x1[1]); pk.w = pg8::cvt_pk_bf16(x1[2], x1[3]);
        acc = MFMA32(__builtin_bit_cast(bf16x8, pk), *(const bf16x8*)(br + 16 * ks), acc); }
    ss = xsum32(ss);
    const float rs = 1.0f / sqrtf(ss * (1.0f / DM) + EPS);
#pragma unroll
    for (int r = 0; r < 16; ++r) { const float rr = __shfl(rs, crow(r, hi)); mkv[(size_t)(rt * 32 + crow(r, hi)) * 512 + ct * 32 + r32] = f2bf(acc[r] * rr); }
}

#define GSYNC() grid.sync()
__device__ __forceinline__ int fresh_tid() { int t = threadIdx.x; asm volatile("" : "+v"(t)); return t; }
#define PH_IDS() const int tid = fresh_tid(), lane = tid & 63, wave = __builtin_amdgcn_readfirstlane(tid >> 6); const long gt = (long)blockIdx.x * 512 + tid, nt = (long)G * 512; \
    const int gw = blockIdx.x * NWAVES + wave, NGW = G * NWAVES; (void)lane; (void)gt; (void)nt; (void)gw; (void)NGW
__global__ void __launch_bounds__(NWAVES * 64, 2) mega(Params p) {
    extern __shared__ __attribute__((aligned(16))) unsigned char lds_raw[];
    LAS unsigned char* lds = (LAS unsigned char*)lds_raw;
    cg::grid_group grid = cg::this_grid();
    const int G = gridDim.x;

    {
        PH_IDS();
        LAS float* scr = (LAS float*)(lds + wave * 16384);
        constexpr int I0 = (DM / 64) * (HAWK_IN / 32), I1 = (HAWK_OUT / 64) * (DM / 32), I2 = (DM / 64) * (NSA_INP / 32), I3 = (NSA_OUT / 64) * (DM / 32), I4 = (2048 / 64) * (256 / 32), I5 = (DM / 64) * (512 / 32);
        for (int it = gw; it < I0 + I1 + I2 + I3 + 2 * I4 + 2 * I5; it += NGW) {
            int r = it;
            if (r < I0) { p0_transpose_item<false>(p.hawk_w_in, DM, HAWK_IN, HAWK_IN, (bf16_t*)(p.ws + OFF_W0IN), scr, r, lane); continue; } r -= I0;
            if (r < I1) { p0_transpose_item<false>(p.hawk_w_out, HAWK_OUT, DM, DM, (bf16_t*)(p.ws + OFF_W0OUT), scr, r, lane); continue; } r -= I1;
            if (r < I2) { p0_transpose_item<true>(p.nsa_w_in, DM, NSA_IN, NSA_INP, (bf16_t*)(p.ws + OFF_W1IN), scr, r, lane); continue; } r -= I2;
            if (r < I3) { p0_transpose_item<false>(p.nsa_w_out, NSA_OUT, DM, DM, (bf16_t*)(p.ws + OFF_W1OUT), scr, r, lane); continue; } r -= I3;
            if (r < I4) { p0_transpose_item<false>(p.phik_w1, 2048, 256, 256, (bf16_t*)(p.ws + OFF_PHIW1), scr, r, lane); continue; } r -= I4;
            if (r < I4) { p0_transpose_item<false>(p.phiv_w1, 2048, 256, 256, (bf16_t*)(p.ws + OFF_PHIW1) + 256 * 2048, scr, r, lane); continue; } r -= I4;
            if (r < I5) { p0_transpose_item<false>(p.hawk_w_mem_kv, DM, 512, 512, (bf16_t*)(p.ws + OFF_WMKV), scr, r, lane, p.hawk_mem_norm); continue; } r -= I5;
            p0_transpose_item<false>(p.nsa_w_mem_kv, DM, 512, 512, (bf16_t*)(p.ws + OFF_WMKV) + 512 * DM, scr, r, lane, p.nsa_mem_norm);
        }
        for (int m = gw; m < T_; m += NGW) rms_row_to_bf16(p.x + (size_t)m * DM, p.hawk_norm, (bf16_t*)(p.ws + OFF_XN) + (size_t)m * DM, lane);
        if (gt < 512) { const int kv = (int)gt >> 8, j = (int)gt & 255; const float* pe = kv ? p.pe_v : p.pe_k; const float* w1 = kv ? p.phiv_w1 : p.phik_w1; float a = 0.f;
            for (int k = 0; k < 2048; ++k) a += pe[k] * w1[(size_t)k * 256 + j];
            ((float*)(p.ws + OFF_PEB))[gt] = a; }
    }
    GSYNC();
    { PH_IDS(); for (int task = gw; task < 2048; task += NGW) memkv_task(p, task, lane); }
    { pg8::Gemm g{(const bf16_t*)(p.ws + OFF_XN), (const bf16_t*)(p.ws + OFF_W0IN), T_, HAWK_IN, DM}; pg8::StaticOrder S; S.init(T_, HAWK_IN, G, (int)blockIdx.x);
      pg8::EpiRoute E{p.ws, (bf16_t*)p.out, 0};
      pg8::gemm_phase<pg8::EpiRoute, pg8::StaticOrder, true, true>(lds, g, S, E); }
    GSYNC();
    {
        PH_IDS();
        for (int u = blockIdx.x; u < 256; u += G) lru_unit(p, lds, u);
        for (int task = gw; task < 6144; task += NGW) dil_task(p, lds + wave * 8192, task, lane);
        __syncthreads();
        for (int u = blockIdx.x; u < 256; u += G) mem_unit((const bf16_t*)(p.ws + OFF_MEMKV), (const bf16_t*)(p.ws + OFF_QM), (const bf16_t*)(p.ws + OFF_ZM), (bf16_t*)(p.ws + OFF_Y0) + 1536, 1792, lds, u);
    }
    GSYNC();
    { PH_IDS(); p2_combine(p, gt, nt); }
    GSYNC();
    { pg8::Gemm g{(const bf16_t*)(p.ws + OFF_Y0), (const bf16_t*)(p.ws + OFF_W0OUT), T_, DM, HAWK_OUT}; pg8::StaticOrder S; S.init(T_, DM, G, (int)blockIdx.x);
      pg8::EpiResid E{p.x, (float*)(p.ws + OFF_X1), DM};
      pg8::gemm_phase<pg8::EpiResid, pg8::StaticOrder, true, true>(lds, g, S, E); }
    GSYNC();
    { PH_IDS(); for (int m = gw; m < T_; m += NGW) rms_row_to_bf16((const float*)(p.ws + OFF_X1) + (size_t)m * DM, p.nsa_norm, (bf16_t*)(p.ws + OFF_XN) + (size_t)m * DM, lane); }
    GSYNC();
    { pg8::Gemm g{(const bf16_t*)(p.ws + OFF_XN), (const bf16_t*)(p.ws + OFF_W1IN), T_, NSA_INP, DM}; pg8::StaticOrder S; S.init(T_, NSA_INP, G, (int)blockIdx.x);
      pg8::EpiRoute E{p.ws, (bf16_t*)p.out, 1};
      pg8::gemm_phase<pg8::EpiRoute, pg8::StaticOrder, true, true>(lds, g, S, E); }
    GSYNC();
    {
        PH_IDS();
        for (int task = gw; task < 1024; task += NGW) cmp1_task(p, task, lane);
        for (int u = blockIdx.x; u < 256; u += G) mem_unit((const bf16_t*)(p.ws + OFF_MEMKV) + (size_t)NB * NMEM * 512, (const bf16_t*)(p.ws + OFF_QM1), (const bf16_t*)(p.ws + OFF_ZM1), (bf16_t*)(p.ws + OFF_Y1) + 1024, 1280, lds, u);
    }
    GSYNC();
    { PH_IDS(); p5_cmp2(p, gt, nt); }
    GSYNC();
    for (int u = blockIdx.x; u < 1024; u += G) nsa_unit(p, lds, u);
    GSYNC();
    { pg8::Gemm g{(const bf16_t*)(p.ws + OFF_Y1), (const bf16_t*)(p.ws + OFF_W1OUT), T_, DM, NSA_OUT}; pg8::StaticOrder S; S.init(T_, DM, G, (int)blockIdx.x);
      pg8::EpiResid E{(const float*)(p.ws + OFF_X1), p.out, DM};
      pg8::gemm_phase<pg8::EpiResid, pg8::StaticOrder, true, true>(lds, g, S, E); }
    GSYNC();
    { PH_IDS(); for (int m = gw; m < T_; m += NGW) rms_row_inplace(p.out + (size_t)m * DM, p.final_norm, lane); }
}

extern "C" void kernel_launch(void* const* d_in, const int* in_sizes, int n_in, void* d_out, int out_size, void* d_ws, size_t ws_size, hipStream_t stream) {
    static int grid_blocks = 0;
    if (!grid_blocks) {
        int dev = 0, cus = 0, per_cu = 0;
        (void)hipGetDevice(&dev);
        (void)hipDeviceGetAttribute(&cus, hipDeviceAttributeMultiprocessorCount, dev);
        if (hipFuncSetAttribute((const void*)mega, hipFuncAttributeMaxDynamicSharedMemorySize, LDS_BYTES) != hipSuccess) fprintf(stderr, "hipFuncSetAttribute failed\n");
        (void)hipOccupancyMaxActiveBlocksPerMultiprocessor(&per_cu, (const void*)mega, NWAVES * 64, LDS_BYTES);
        if (per_cu < 1) fprintf(stderr, "occupancy query reports %d blocks per CU\n", per_cu);
        grid_blocks = cus;
        if (ws_size < WS_END) fprintf(stderr, "workspace too small: %zu < %zu\n", ws_size, (size_t)WS_END);
    }
    Params p{};
    const float** f = (const float**)&p;
    for (int i = 0; i < 26; ++i) f[i] = (const float*)d_in[i];
    p.out = (float*)d_out; p.ws = (unsigned char*)d_ws;
    void* args[] = {&p};
    hipError_t e = hipLaunchCooperativeKernel((void*)mega, dim3(grid_blocks), dim3(NWAVES * 64), args, LDS_BYTES, stream);
    if (e != hipSuccess) fprintf(stderr, "cooperative launch failed: %s (grid %d)\n", hipGetErrorString(e), grid_blocks);
}
#endif
```

```cpp
#ifndef HOST_EMU
#include <hip/hip_runtime.h>
#include <hip/hip_cooperative_groups.h>
namespace cg = cooperative_groups;
#define DEVFN __device__ __forceinline__
#define DEVNI __device__ __forceinline__
#else
#include <cmath>
#include <cstdint>
#include <cstring>
#define DEVFN static inline
#define DEVNI static
#endif
#include <cstdio>
#include <cstdint>

#ifndef BATCH_
#define BATCH_ 8
#endif
#ifndef DM_
#define DM_ 1024
#endif

typedef unsigned short bf16_t;
constexpr int SEQ = 2048, NB = BATCH_, T_ = NB * SEQ, DM = DM_, NMEM = 256;
constexpr int HAWK_IN = 7680, HAWK_OUT = 1792, NSA_IN = 3376, NSA_INP = 3584, NSA_OUT = 1280;
constexpr float EPS = 1e-6f;

DEVFN float bf2f(bf16_t h) { union { unsigned u; float f; } c; c.u = (unsigned)h << 16; return c.f; }
DEVFN bf16_t f2bf(float f) { union { unsigned u; float f; } c; c.f = f; unsigned u = c.u; u += 0x7fffu + ((u >> 16) & 1u); return (bf16_t)(u >> 16); }
DEVFN float sigmoidf_(float x) { return 1.0f / (1.0f + expf(-x)); }
DEVFN float siluf_(float x) { return x / (1.0f + expf(-x)); }

constexpr size_t al256(size_t x) { return (x + 255) & ~(size_t)255; }
constexpr size_t OFF_CTRL = 0;
constexpr size_t OFF_W0OUT = 65536;
constexpr size_t OFF_W1IN = OFF_W0OUT + al256((size_t)DM * HAWK_OUT * 2);
constexpr size_t OFF_W1OUT = OFF_W1IN + al256((size_t)NSA_INP * DM * 2);
constexpr size_t OFF_PHIW1 = OFF_W1OUT + al256((size_t)DM * NSA_OUT * 2);
constexpr size_t OFF_MEMKV = OFF_PHIW1 + al256((size_t)2 * 256 * 2048 * 2);
constexpr size_t OFF_LSE = OFF_MEMKV + al256((size_t)2 * NB * NMEM * 512 * 2);
constexpr size_t OFF_PEB = OFF_LSE + al256((size_t)3 * T_ * 4 * 4) + 65536;
constexpr size_t OFF_PHIW2 = OFF_LSE + al256((size_t)3 * T_ * 4 * 4);
constexpr size_t OFF_PEBS = OFF_PHIW2 + 65536 + 131072;
constexpr size_t OFF_WMKV = OFF_PEBS + 4096;
constexpr size_t OFF_RA = OFF_WMKV + al256((size_t)2 * 512 * DM * 2);
constexpr size_t RA_BYTES = (size_t)T_ * 1792 * 2;
constexpr size_t OFF_XN = OFF_RA;
constexpr size_t OFF_W0IN = OFF_RA + (size_t)T_ * 1024 * 2;
constexpr size_t OFF_MEMN = OFF_W0IN + (size_t)HAWK_IN * DM * 2;
static_assert(OFF_MEMN + (size_t)NB * NMEM * DM * 2 <= OFF_RA + RA_BYTES, "region A: MEMN");
constexpr size_t OFF_Y0 = OFF_RA;
constexpr size_t OFF_Y1 = OFF_RA;
constexpr size_t OFF_CMPH = OFF_RA + (size_t)T_ * 1280 * 2;
constexpr size_t OFF_CMPKV = OFF_CMPH + al256((size_t)2 * NB * 2 * 128 * 256 * 4);
constexpr size_t OFF_SEL = OFF_CMPKV + al256((size_t)2 * NB * 2 * 128 * 64 * 4);
constexpr size_t OFF_IMP = OFF_SEL + al256((size_t)NB * 2 * SEQ * 4);
static_assert(OFF_W0IN + (size_t)HAWK_IN * DM * 2 <= OFF_RA + RA_BYTES, "region A: XN0 | W0IN");
static_assert(OFF_IMP + (size_t)NB * 2 * SEQ * 32 * 4 <= OFF_RA + RA_BYTES, "region A: layer-1 temporaries");
constexpr size_t OFF_Q = OFF_RA + RA_BYTES;
constexpr size_t OFF_K = OFF_Q + (size_t)T_ * 1536 * 2;
constexpr size_t OFF_V = OFF_K + (size_t)T_ * 1536 * 2;
constexpr size_t OFF_ZB = OFF_V + (size_t)T_ * 1536 * 2;
constexpr size_t OFF_QM = OFF_ZB + (size_t)T_ * 512 * 2;
constexpr size_t OFF_ZM = OFF_QM + (size_t)T_ * 256 * 2;
constexpr size_t WS_END = OFF_ZM + (size_t)T_ * 256 * 2;
constexpr size_t OFF_X1 = OFF_K;
constexpr size_t OFF_Z1 = OFF_K + (size_t)T_ * 1024 * 4;
constexpr size_t OFF_Q1 = OFF_Q;
constexpr size_t OFF_QM1 = OFF_Q + (size_t)T_ * 1024 * 2;
constexpr size_t OFF_ZM1 = OFF_QM1 + (size_t)T_ * 256 * 2;
constexpr size_t OFF_KV1 = OFF_ZB;
constexpr size_t OFF_GATE = OFF_ZM;
static_assert(OFF_Z1 + (size_t)T_ * 1024 * 2 <= OFF_ZB, "Z1 overlay");
static_assert(BATCH_ != 8 || DM_ != 1024 || WS_END <= (size_t)256 * 1024 * 1024, "workspace too big");

struct Params {
    const float *x, *mem, *hawk_norm, *hawk_w_in, *conv_w, *conv_b, *ga_w, *ga_b, *gx_w, *gx_b, *lam, *hawk_mem_norm, *hawk_w_mem_kv, *hawk_w_out;
    const float *nsa_norm, *nsa_w_in, *pe_k, *pe_v, *phik_w1, *phik_w2, *phiv_w1, *phiv_w2, *nsa_mem_norm, *nsa_w_mem_kv, *nsa_w_out, *final_norm;
    float* out; unsigned char* ws;
};

DEVFN int nsa_col_orig(int n) {
    if (n < 1792) return n;
    if (n < 2816) return n - 1792 + 1840;
    if (n < 3072) return n - 2816 + 2864;
    if (n < 3328) return n - 3072 + 3120;
    if (n < 3376) return n - 3328 + 1792;
    return -1;
}

DEVFN void p0_convert(const Params& p, long gt, long nt) {
    bf16_t* w0in = (bf16_t*)(p.ws + OFF_W0IN); bf16_t* w0out = (bf16_t*)(p.ws + OFF_W0OUT);
    bf16_t* w1in = (bf16_t*)(p.ws + OFF_W1IN); bf16_t* w1out = (bf16_t*)(p.ws + OFF_W1OUT); bf16_t* phiw1 = (bf16_t*)(p.ws + OFF_PHIW1);
    for (long i = gt; i < (long)DM * HAWK_IN; i += nt) { const int k = (int)(i / HAWK_IN), n = (int)(i % HAWK_IN); w0in[(size_t)n * DM + k] = f2bf(p.hawk_w_in[i]); }
    for (long i = gt; i < (long)HAWK_OUT * DM; i += nt) { const int k = (int)(i / DM), n = (int)(i % DM); w0out[(size_t)n * HAWK_OUT + k] = f2bf(p.hawk_w_out[i]); }
    for (long i = gt; i < (long)DM * NSA_INP; i += nt) { const int k = (int)(i / NSA_INP), n = (int)(i % NSA_INP); const int no = nsa_col_orig(n);
        w1in[(size_t)n * DM + k] = no >= 0 ? f2bf(p.nsa_w_in[(size_t)k * NSA_IN + no]) : (bf16_t)0; }
    for (long i = gt; i < (long)NSA_OUT * DM; i += nt) { const int k = (int)(i / DM), n = (int)(i % DM); w1out[(size_t)n * NSA_OUT + k] = f2bf(p.nsa_w_out[i]); }
    for (long i = gt; i < (long)2 * 2048 * 256; i += nt) { const int kv = (int)(i / (2048 * 256)), r = (int)(i % (2048 * 256)), k = r / 256, n = r % 256;
        phiw1[(size_t)kv * 256 * 2048 + (size_t)n * 2048 + k] = f2bf((kv ? p.phiv_w1 : p.phik_w1)[r]); }
}
DEVFN void rows_rmsnorm(const float* x, const float* g, bf16_t* xn, long gt, long nt) {
    for (long r = gt; r < T_; r += nt) {
        const float* xr = x + (size_t)r * DM; float ss = 0.f;
        for (int k = 0; k < DM; ++k) ss += xr[k] * xr[k];
        const float rs = 1.0f / sqrtf(ss / DM + EPS);
        for (int k = 0; k < DM; ++k) xn[(size_t)r * DM + k] = f2bf(xr[k] * rs * g[k]);
    }
}
DEVFN void p0_memkv(const Params& p, long gt, long nt) {
    bf16_t* mkv = (bf16_t*)(p.ws + OFF_MEMKV);
    for (long i = gt; i < (long)2 * NB * NMEM * 512; i += nt) {
        const int l = (int)(i / ((long)NB * NMEM * 512)), r = (int)((i / 512) % (NB * NMEM)), c = (int)(i % 512);
        const float* mr = p.mem + (size_t)r * DM; const float* g = l ? p.nsa_mem_norm : p.hawk_mem_norm; const float* w = l ? p.nsa_w_mem_kv : p.hawk_w_mem_kv;
        float ss = 0.f, acc = 0.f;
        for (int k = 0; k < DM; ++k) { const float v = mr[k]; ss += v * v; acc += v * g[k] * w[(size_t)k * 512 + c]; }
        mkv[i] = f2bf(acc / sqrtf(ss / DM + EPS));
    }
}

struct __attribute__((aligned(16))) U4 { unsigned x, y, z, w; };
DEVFN float lo16(unsigned u) { union { unsigned u; float f; } c; c.u = u << 16; return c.f; }
DEVFN float hi16(unsigned u) { union { unsigned u; float f; } c; c.u = u & 0xffff0000u; return c.f; }
DEVFN float dot_bf16(const bf16_t* a, const bf16_t* b, int n) {
    float s0 = 0.f, s1 = 0.f, s2 = 0.f, s3 = 0.f;
    for (int k = 0; k < n; k += 8) { const U4 va = *(const U4*)(a + k), vb = *(const U4*)(b + k);
        s0 += lo16(va.x) * lo16(vb.x) + hi16(va.x) * hi16(vb.x); s1 += lo16(va.y) * lo16(vb.y) + hi16(va.y) * hi16(vb.y);
        s2 += lo16(va.z) * lo16(vb.z) + hi16(va.z) * hi16(vb.z); s3 += lo16(va.w) * lo16(vb.w) + hi16(va.w) * hi16(vb.w); }
    return (s0 + s1) + (s2 + s3);
}

DEVFN void p1_gemm(const Params& p, long gt, long nt) {
    const bf16_t* xn = (const bf16_t*)(p.ws + OFF_XN); const bf16_t* w = (const bf16_t*)(p.ws + OFF_W0IN);
    bf16_t* xaza = (bf16_t*)p.out;
    for (long i = gt; i < (long)T_ * HAWK_IN; i += nt) {
        const int t = (int)(i / HAWK_IN), n = (int)(i % HAWK_IN);
        const bf16_t v = f2bf(dot_bf16(xn + (size_t)t * DM, w + (size_t)n * DM, DM));
        if (n < 2048) xaza[(size_t)t * 2048 + n] = v;
        else if (n < 3584) ((bf16_t*)(p.ws + OFF_Q))[(size_t)t * 1536 + n - 2048] = v;
        else if (n < 5120) ((bf16_t*)(p.ws + OFF_K))[(size_t)t * 1536 + n - 3584] = v;
        else if (n < 6656) ((bf16_t*)(p.ws + OFF_V))[(size_t)t * 1536 + n - 5120] = v;
        else if (n < 7168) ((bf16_t*)(p.ws + OFF_ZB))[(size_t)t * 512 + n - 6656] = v;
        else if (n < 7424) ((bf16_t*)(p.ws + OFF_QM))[(size_t)t * 256 + n - 7168] = v;
        else ((bf16_t*)(p.ws + OFF_ZM))[(size_t)t * 256 + n - 7424] = v;
    }
}

DEVFN void p2_lru(const Params& p, long gt, long nt) {
    const bf16_t* xaza = (const bf16_t*)p.out; bf16_t* Y0 = (bf16_t*)(p.ws + OFF_Y0);
    for (long i = gt; i < (long)NB * 1024; i += nt) {
        const int b = (int)(i / 1024), c = (int)(i % 1024), blk = c >> 6, j = c & 63;
        const float sp = log1pf(expf(-p.lam[c]));
        const float* gaw = p.ga_w + (size_t)blk * 4096; const float* gxw = p.gx_w + (size_t)blk * 4096;
        float h = 0.f;
        for (int t = 0; t < SEQ; ++t) {
            float ra = p.ga_b[c], ri = p.gx_b[c], xcj = 0.f;
            for (int ii = 0; ii < 64; ++ii) {
                const int cc = blk * 64 + ii; float xc = p.conv_b[cc];
                for (int k = 0; k < 4; ++k) { const int tt = t - 3 + k; if (tt >= 0) xc += p.conv_w[k * 1024 + cc] * bf2f(xaza[((size_t)b * SEQ + tt) * 2048 + cc]); }
                ra += xc * gaw[ii * 64 + j]; ri += xc * gxw[ii * 64 + j];
                if (ii == j) xcj = xc;
            }
            const float r = sigmoidf_(ra), ig = sigmoidf_(ri);
            const float log_a = -8.0f * r * sp, a = expf(log_a);
            const float mult = t == 0 ? 1.0f : sqrtf(-expm1f(2.0f * log_a));
            h = a * h + xcj * ig * mult;
            const size_t tt0 = (size_t)b * SEQ + t;
            Y0[tt0 * 1792 + c] = f2bf(h * siluf_(bf2f(xaza[tt0 * 2048 + 1024 + c])));
        }
    }
}
DEVNI void p2_dilated(const Params& p, long gt, long nt) {
    bf16_t* Q = (bf16_t*)(p.ws + OFF_Q); const bf16_t* K = (const bf16_t*)(p.ws + OFF_K); const bf16_t* V = (const bf16_t*)(p.ws + OFF_V);
    float* LSE = (float*)(p.ws + OFF_LSE);
    for (long i = gt; i < (long)T_ * 12; i += nt) {
        const int t = (int)(i / 12), hh = (int)(i % 12), g = hh >> 2, h = hh & 3, s = t % SEQ;
        const int dil = g == 0 ? 1 : (g == 1 ? 4 : 16);
        const float slope = exp2f(-8.0f * (float)(hh + 1) / 12.0f), scale = 0.08838834764831845f;
        bf16_t* qp = Q + (size_t)t * 1536 + hh * 128;
        float o[128], m = -1e30f, l = 0.f;
#pragma unroll
        for (int d = 0; d < 128; ++d) o[d] = 0.f;
        for (int jj = 0; jj <= 128; ++jj) {
            const int sk = s - jj * dil; if (sk < 0) break;
            const bf16_t* kp = K + (size_t)(t - jj * dil) * 1536 + hh * 128; const bf16_t* vp = V + (size_t)(t - jj * dil) * 1536 + hh * 128;
            float sc = 0.f;
#pragma nounroll
            for (int d = 0; d < 128; ++d) sc += bf2f(qp[d]) * bf2f(kp[d]);
            sc = sc * scale - slope * (float)(jj * dil);
            const float mn = fmaxf(m, sc), al = expf(m - mn), pe = expf(sc - mn);
            l = l * al + pe; m = mn;
#pragma unroll
            for (int d = 0; d < 128; ++d) o[d] = o[d] * al + pe * bf2f(vp[d]);
        }
        const float inv = 1.0f / l;
#pragma unroll
        for (int d = 0; d < 128; ++d) qp[d] = f2bf(o[d] * inv);
        LSE[((size_t)g * T_ + t) * 4 + h] = m + logf(l);
    }
}
DEVFN void p2_combine(const Params& p, long gt, long nt) {
    const bf16_t* Q = (const bf16_t*)(p.ws + OFF_Q); const bf16_t* ZB = (const bf16_t*)(p.ws + OFF_ZB); const float* LSE = (const float*)(p.ws + OFF_LSE); bf16_t* Y0 = (bf16_t*)(p.ws + OFF_Y0);
    for (long i = gt; i < (long)T_ * 512; i += nt) {
        const int t = (int)(i / 512), c = (int)(i % 512), h = c >> 7;
        const float l0 = LSE[((size_t)0 * T_ + t) * 4 + h], l1 = LSE[((size_t)1 * T_ + t) * 4 + h], l2 = LSE[((size_t)2 * T_ + t) * 4 + h];
        const float mx = fmaxf(l0, fmaxf(l1, l2)), e0 = expf(l0 - mx), e1 = expf(l1 - mx), e2 = expf(l2 - mx), inv = 1.0f / (e0 + e1 + e2);
        const float o = (e0 * bf2f(Q[(size_t)t * 1536 + c]) + e1 * bf2f(Q[(size_t)t * 1536 + 512 + c]) + e2 * bf2f(Q[(size_t)t * 1536 + 1024 + c])) * inv;
        Y0[(size_t)t * 1792 + 1024 + c] = f2bf(o * siluf_(bf2f(ZB[i])));
    }
}
DEVNI void mem_attn(const bf16_t* mkv, const bf16_t* QMb, const bf16_t* ZMb, bf16_t* Y, int ldy, long gt, long nt) {
    for (long i = gt; i < (long)T_ * 4; i += nt) {
        const int t = (int)(i / 4), h = (int)(i % 4), b = t / SEQ;
        const bf16_t* qp = QMb + (size_t)t * 256 + h * 64;
        float o[64], m = -1e30f, l = 0.f;
#pragma unroll
        for (int d = 0; d < 64; ++d) o[d] = 0.f;
        for (int j = 0; j < NMEM; ++j) {
            const bf16_t* kp = mkv + ((size_t)b * NMEM + j) * 512 + h * 64; const bf16_t* vp = kp + 256;
            float sc = 0.f;
#pragma nounroll
            for (int d = 0; d < 64; ++d) sc += bf2f(qp[d]) * bf2f(kp[d]);
            sc *= 0.125f;
            const float mn = fmaxf(m, sc), al = expf(m - mn), pe = expf(sc - mn);
            l = l * al + pe; m = mn;
#pragma unroll
            for (int d = 0; d < 64; ++d) o[d] = o[d] * al + pe * bf2f(vp[d]);
        }
        const float inv = 1.0f / l;
#pragma unroll
        for (int d = 0; d < 64; ++d) Y[(size_t)t * ldy + h * 64 + d] = f2bf(o[d] * inv * siluf_(bf2f(ZMb[(size_t)t * 256 + h * 64 + d])));
    }
}

DEVFN void p3_gemm(const Params& p, long gt, long nt) {
    const bf16_t* y = (const bf16_t*)(p.ws + OFF_Y0); const bf16_t* w = (const bf16_t*)(p.ws + OFF_W0OUT); float* x1 = (float*)(p.ws + OFF_X1);
    for (long i = gt; i < (long)T_ * DM; i += nt) {
        const int t = (int)(i / DM), n = (int)(i % DM);
        x1[i] = p.x[i] + dot_bf16(y + (size_t)t * HAWK_OUT, w + (size_t)n * HAWK_OUT, HAWK_OUT);
    }
}
DEVFN void p4_gemm(const Params& p, long gt, long nt) {
    const bf16_t* xn = (const bf16_t*)(p.ws + OFF_XN); const bf16_t* w = (const bf16_t*)(p.ws + OFF_W1IN);
    for (long i = gt; i < (long)T_ * NSA_IN; i += nt) {
        const int t = (int)(i / NSA_IN), n = (int)(i % NSA_IN);
        const float a = dot_bf16(xn + (size_t)t * DM, w + (size_t)n * DM, DM); const bf16_t v = f2bf(a);
        if (n < 1024) ((bf16_t*)(p.ws + OFF_Q1))[(size_t)t * 1024 + n] = v;
        else if (n < 1792) ((bf16_t*)(p.ws + OFF_KV1))[(size_t)t * 768 + n - 1024] = v;
        else if (n < 2816) ((bf16_t*)(p.ws + OFF_Z1))[(size_t)t * 1024 + n - 1792] = v;
        else if (n < 3072) ((bf16_t*)(p.ws + OFF_QM1))[(size_t)t * 256 + n - 2816] = v;
        else if (n < 3328) ((bf16_t*)(p.ws + OFF_ZM1))[(size_t)t * 256 + n - 3072] = v;
        else ((bf16_t*)(p.ws + OFF_GATE))[(size_t)t * 256 + n - 3328] = v;
    }
}
DEVFN void p5_cmp1(const Params& p, long gt, long nt) {
    const bf16_t* KV = (const bf16_t*)(p.ws + OFF_KV1); const bf16_t* w1 = (const bf16_t*)(p.ws + OFF_PHIW1); float* hid = (float*)(p.ws + OFF_CMPH);
    for (long i = gt; i < (long)2 * NB * 2 * 127 * 256; i += nt) {
        const int j = (int)(i % 256); long r = i / 256; const int n = (int)(r % 127); r /= 127; const int g = (int)(r % 2); r /= 2; const int b = (int)(r % NB), kv = (int)(r / NB);
        const float* pe = kv ? p.pe_v : p.pe_k; const bf16_t* wj = w1 + ((size_t)kv * 256 + j) * 2048;
        float acc = 0.f;
        for (int ii = 0; ii < 32; ++ii) { const bf16_t* tp = KV + ((size_t)b * SEQ + 16 * n + ii) * 768 + kv * 128 + g * 64;
            for (int d = 0; d < 64; ++d) acc += (bf2f(tp[d]) + pe[ii * 64 + d]) * bf2f(wj[ii * 64 + d]); }
        hid[((((size_t)kv * NB + b) * 2 + g) * 128 + n) * 256 + j] = siluf_(acc);
    }
}
DEVFN void p5_cmp2(const Params& p, long gt, long nt) {
    const float* hid = (const float*)(p.ws + OFF_CMPH); bf16_t* ckv = (bf16_t*)(p.ws + OFF_CMPKV);
    for (long i = gt; i < (long)2 * NB * 2 * 128 * 64; i += nt) {
        const int d = (int)(i % 64); long r = i / 64; const int n = (int)(r % 128); r /= 128; const int g = (int)(r % 2); r /= 2; const int b = (int)(r % NB), kv = (int)(r / NB);
        const float* w2 = kv ? p.phiv_w2 : p.phik_w2; const size_t row = (((size_t)kv * NB + b) * 2 + g) * 128 + n;
        float acc = 0.f;
        if (n < 127) for (int j = 0; j < 256; ++j) acc += hid[row * 256 + j] * w2[j * 64 + d];
        ckv[row * 64 + d] = f2bf(acc);
    }
}
DEVNI void p5_cmp_attn(const Params& p, long gt, long nt) {
    const bf16_t* Q1 = (const bf16_t*)(p.ws + OFF_Q1); const bf16_t* ckv = (const bf16_t*)(p.ws + OFF_CMPKV); const bf16_t* gate = (const bf16_t*)(p.ws + OFF_GATE);
    unsigned* SEL = (unsigned*)(p.ws + OFF_SEL); float* ocmp = p.out; float* IMP = (float*)(p.ws + OFF_IMP);
    for (long i = gt; i < (long)NB * 2 * SEQ; i += nt) {
        const int s = (int)(i % SEQ), g = (int)((i / SEQ) % 2), b = (int)(i / (2 * SEQ)); const int t = b * SEQ + s;
        const bf16_t* kc = ckv + (((size_t)0 * NB + b) * 2 + g) * 128 * 64; const bf16_t* vc = ckv + (((size_t)1 * NB + b) * 2 + g) * 128 * 64;
        const int nvis = s >= 31 ? (s - 31) / 16 + 1 : 0;
        float* imp = IMP + (size_t)i * 32;
        for (int r = 0; r < 8; ++r) {
            const int hidx = g * 8 + r; const float slope = exp2f(-0.5f * (float)(hidx + 1));
            const bf16_t* qp = Q1 + (size_t)t * 1024 + hidx * 64;
            float m = -1e30f;
            for (int n = 0; n < nvis; ++n) { float sc = 0.f;
_Pragma("nounroll") for (int d = 0; d < 64; ++d) sc += bf2f(qp[d]) * bf2f(kc[n * 64 + d]);
                sc = sc * 0.125f - slope * (float)(s - (16 * n + 31)); m = fmaxf(m, sc); }
            float l = 0.f;
            for (int n = 0; n < nvis; ++n) { float sc = 0.f;
_Pragma("nounroll") for (int d = 0; d < 64; ++d) sc += bf2f(qp[d]) * bf2f(kc[n * 64 + d]);
                sc = sc * 0.125f - slope * (float)(s - (16 * n + 31)); l += expf(sc - m); }
            const float inv = nvis > 0 ? 1.0f / l : 0.f;
            float o[64];
#pragma unroll
            for (int d = 0; d < 64; ++d) o[d] = 0.f;
            float carry = 0.f;
            for (int j = 0; j < 32; ++j) {
                float acc = carry; carry = 0.f;
                for (int q4 = 0; q4 < 4; ++q4) { const int n = 4 * j + q4;
                    if (n < nvis) { float sc = 0.f;
_Pragma("nounroll") for (int d = 0; d < 64; ++d) sc += bf2f(qp[d]) * bf2f(kc[n * 64 + d]);
                        sc = sc * 0.125f - slope * (float)(s - (16 * n + 31)); const float pr = expf(sc - m) * inv;
                        acc += pr; if (q4 == 3) carry = pr;
#pragma unroll
                        for (int d = 0; d < 64; ++d) o[d] += pr * bf2f(vc[n * 64 + d]); } }
                imp[j] = (r == 0 ? 0.f : imp[j]) + acc;
            }
            const float g0 = sigmoidf_(bf2f(gate[(size_t)t * 256 + hidx * 3 + 0]));
#pragma unroll
            for (int d = 0; d < 64; ++d) ocmp[(size_t)t * 1024 + hidx * 64 + d] = g0 * o[d];
        }
        const int cur = s >> 6; unsigned mask = 1u | (1u << cur) | (cur > 0 ? (1u << (cur - 1)) : 0u);
        const int nf = cur == 0 ? 1 : (cur == 1 ? 2 : 3), need = 8 - nf;
        for (int j = 1; j < 30; ++j) {
            if (j <= cur - 2) { int rank = 0;
                for (int j2 = 1; j2 < 30; ++j2) if (j2 <= cur - 2 && j2 != j) rank += (imp[j2] > imp[j] || (imp[j2] == imp[j] && j2 < j)) ? 1 : 0;
                if (rank < need) mask |= 1u << j; }
        }
        SEL[i] = mask;
    }
}
DEVNI void p5_slc_win(const Params& p, long gt, long nt) {
    const bf16_t* Q1 = (const bf16_t*)(p.ws + OFF_Q1); const bf16_t* KV = (const bf16_t*)(p.ws + OFF_KV1); const bf16_t* gate = (const bf16_t*)(p.ws + OFF_GATE);
    const unsigned* SEL = (const unsigned*)(p.ws + OFF_SEL); const float* ocmp = p.out; const bf16_t* Z1 = (const bf16_t*)(p.ws + OFF_Z1); bf16_t* Y1 = (bf16_t*)(p.ws + OFF_Y1);
    for (long i = gt; i < (long)T_ * 16; i += nt) {
        const int t = (int)(i / 16), hidx = (int)(i % 16), g = hidx >> 3, b = t / SEQ, s = t % SEQ;
        const float slope = exp2f(-0.5f * (float)(hidx + 1));
        const bf16_t* qp = Q1 + (size_t)t * 1024 + hidx * 64;
        const unsigned mask = SEL[((size_t)b * 2 + g) * SEQ + s];
        float res[64];
        {
            float o[64], m = -1e30f, l = 0.f;
#pragma unroll
            for (int d = 0; d < 64; ++d) o[d] = 0.f;
            for (int j = 0; j < 32; ++j) { if (!((mask >> j) & 1u)) continue;
                for (int kk = 0; kk < 64; ++kk) { const int kpos = j * 64 + kk; if (kpos > s) break;
                    const bf16_t* kp = KV + ((size_t)b * SEQ + kpos) * 768 + 2 * 128 + g * 64; const bf16_t* vp = kp + 128;
                    float sc = 0.f;
#pragma nounroll
                    for (int d = 0; d < 64; ++d) sc += bf2f(qp[d]) * bf2f(kp[d]);
                    sc = sc * 0.125f - slope * (float)(s - kpos);
                    const float mn = fmaxf(m, sc), al = expf(m - mn), pe = expf(sc - mn); l = l * al + pe; m = mn;
#pragma unroll
                    for (int d = 0; d < 64; ++d) o[d] = o[d] * al + pe * bf2f(vp[d]); } }
            const float g1 = sigmoidf_(bf2f(gate[(size_t)t * 256 + hidx * 3 + 1])) / l;
#pragma unroll
            for (int d = 0; d < 64; ++d) res[d] = ocmp[(size_t)t * 1024 + hidx * 64 + d] + g1 * o[d];
        }
        {
            float o[64], m = -1e30f, l = 0.f;
#pragma unroll
            for (int d = 0; d < 64; ++d) o[d] = 0.f;
            for (int kpos = (s - 511 > 0 ? s - 511 : 0); kpos <= s; ++kpos) {
                const bf16_t* kp = KV + ((size_t)b * SEQ + kpos) * 768 + 4 * 128 + g * 64; const bf16_t* vp = kp + 128;
                float sc = 0.f;
#pragma nounroll
                for (int d = 0; d < 64; ++d) sc += bf2f(qp[d]) * bf2f(kp[d]);
                sc = sc * 0.125f - slope * (float)(s - kpos);
                const float mn = fmaxf(m, sc), al = expf(m - mn), pe = expf(sc - mn); l = l * al + pe; m = mn;
#pragma unroll
                for (int d = 0; d < 64; ++d) o[d] = o[d] * al + pe * bf2f(vp[d]); }
            const float g2 = sigmoidf_(bf2f(gate[(size_t)t * 256 + hidx * 3 + 2])) / l;
#pragma unroll
            for (int d = 0; d < 64; ++d) res[d] += g2 * o[d];
        }
#pragma unroll
        for (int d = 0; d < 64; ++d) Y1[(size_t)t * 1280 + hidx * 64 + d] = f2bf(res[d] * siluf_(bf2f(Z1[(size_t)t * 1024 + hidx * 64 + d])));
    }
}
DEVFN void p6_gemm(const Params& p, long gt, long nt) {
    const bf16_t* y = (const bf16_t*)(p.ws + OFF_Y1); const bf16_t* w = (const bf16_t*)(p.ws + OFF_W1OUT); const float* x1 = (const float*)(p.ws + OFF_X1);
    for (long i = gt; i < (long)T_ * DM; i += nt) {
        const int t = (int)(i / DM), n = (int)(i % DM);
        p.out[i] = x1[i] + dot_bf16(y + (size_t)t * NSA_OUT, w + (size_t)n * NSA_OUT, NSA_OUT);
    }
}
DEVFN void p7_final(const Params& p, long gt, long nt) {
    for (long r = gt; r < T_; r += nt) {
        float* xr = p.out + (size_t)r * DM; float ss = 0.f;
        for (int k = 0; k < DM; ++k) ss += xr[k] * xr[k];
        const float rs = 1.0f / sqrtf(ss / DM + EPS);
        for (int k = 0; k < DM; ++k) xr[k] = xr[k] * rs * p.final_norm[k];
    }
}

#ifndef HOST_EMU
static_assert(DM == 1024 && NB == 8, "device build is for the real shapes");
#define LAS __attribute__((address_space(3)))
#define GAS __attribute__((address_space(1)))
typedef unsigned v4u __attribute__((ext_vector_type(4)));
typedef float f32x4 __attribute__((ext_vector_type(4)));
typedef short bf16x8 __attribute__((ext_vector_type(8)));
#define LDS_WAIT() asm volatile("s_waitcnt lgkmcnt(0)" ::: "memory")
#define VM_WAIT() asm volatile("s_waitcnt vmcnt(0)" ::: "memory")
__device__ __forceinline__ unsigned pk2(float lo, float hi) { return (unsigned)f2bf(lo) | ((unsigned)f2bf(hi) << 16); }

__device__ __forceinline__ int fresh_tid();
namespace pg8 {
constexpr int BM = 256, BK = 64, HALF = 128, HTB = HALF * BK * 2  , STAGE_BYTES = 8 * HTB, NXCD = 8, WGM = 8;
__host__ __device__ __forceinline__ int lds_byte(int r, int c) { const int st = (r >> 4) * 2 + (c >> 5), rr = r & 15, cc = c & 31, ob = rr * 64 + cc * 2; return st * 1024 + (ob ^ (((ob >> 9) & 1) << 5)); }
__host__ __device__ __forceinline__ void stage_rc(int b, int& R, int& C) { const int st = b / 1024, sb = b % 1024, swz = sb ^ (((sb >> 9) & 1) << 5); R = (st >> 1) * 16 + swz / 64; C = (st & 1) * 32 + (swz % 64) / 2; }
__host__ __device__ __forceinline__ int perm32(int rho) { const int n = rho >> 4, i = rho & 15; return 8 * (i >> 2) + 4 * n + (i & 3); }
struct Unit { int pm, pn, tag; const char* A; const char* B; };
struct Gemm { int K, lda, ldb, kstepA, kstepB; };
struct StaticOrder {
    int nM, nN, nwg, G, c, K; const char* A; const char* B; int nE, nNe; const char* Ae; const char* Be;
    __host__ __device__ void init(const bf16_t* A_, const bf16_t* B_, int M, int N, int K_, int G_, int c_) { A = (const char*)A_; B = (const char*)B_; K = K_; nM = M / BM; nN = N / BM; nwg = nM * nN; G = G_; c = c_; nE = 0; nNe = 1; Ae = Be = nullptr; }
    __host__ __device__ void extra(const bf16_t* A_, const bf16_t* B_, int M, int N) { Ae = (const char*)A_; Be = (const char*)B_; nNe = N / BM; nE = (M / BM) * nNe; }
    __host__ __device__ bool next(int i, Unit& u) const {
        const long L = (long)i * G + c; const size_t tstep = (size_t)BM * K * 2;
        if (L >= nwg) { const long e = L - nwg; if (e >= nE) return false; u.pm = (int)(e / nNe); u.pn = (int)(e % nNe); u.tag = 1; u.A = Ae + (size_t)u.pm * tstep; u.B = Be + (size_t)u.pn * tstep; return true; }
        int wgid = (int)L; { const int q = nwg / NXCD, r = nwg % NXCD, xcd = wgid % NXCD, off = wgid / NXCD; wgid = (xcd < r ? xcd * (q + 1) : r * (q + 1) + (xcd - r) * q) + off; }
        const int nig = WGM * nN, gid = wgid / nig, fm = gid * WGM, gsz = (nM - fm) < WGM ? (nM - fm) : WGM;
        u.pm = fm + ((wgid % nig) % gsz); u.pn = (wgid % nig) / gsz; u.tag = 0; u.A = A + (size_t)u.pm * tstep; u.B = B + (size_t)u.pn * tstep; return true;
    }
    __device__ __forceinline__ void a_ready(const Unit&) const {}
    __device__ __forceinline__ void done(const Unit&) const {}
};
struct OneUnit {
    Unit u; bool have;
    __host__ __device__ bool next(int i, Unit& o) const { if (i != 0 || !have) return false; o = u; return true; }
    __device__ __forceinline__ void a_ready(const Unit&) const {}
    __device__ __forceinline__ void done(const Unit&) const {}
};
typedef __bf16 bf16x2_t __attribute__((ext_vector_type(2)));
__device__ __forceinline__ unsigned cvt_pk_bf16(float lo, float hi) { const bf16x2_t v = {(__bf16)lo, (__bf16)hi}; return __builtin_bit_cast(unsigned, v); }

struct EpiRoute {
    static constexpr bool PERM = true, AFTER_DRAIN = false;
    unsigned char* ws; bf16_t* xaza; int layer;
    __device__ __forceinline__ void operator()(const f32x4 (&acc)[2][2][4][2], const Unit& u, int wr, int wc, int fr, int fq) const {
        bf16_t* base; int ldc, colt; const int pn = u.pn;
        if (u.tag == 1) { base = (bf16_t*)(ws + OFF_MEMKV) + (size_t)(pn >> 1) * NB * NMEM * 512; ldc = 512; colt = (pn & 1) * 256; }
        else if (layer == 0) {
            if (pn < 8) { base = xaza; ldc = 2048; colt = pn * 256; }
            else if (pn < 14) { base = (bf16_t*)(ws + OFF_Q); ldc = 1536; colt = (pn - 8) * 256; }
            else if (pn < 20) { base = (bf16_t*)(ws + OFF_K); ldc = 1536; colt = (pn - 14) * 256; }
            else if (pn < 26) { base = (bf16_t*)(ws + OFF_V); ldc = 1536; colt = (pn - 20) * 256; }
            else if (pn < 28) { base = (bf16_t*)(ws + OFF_ZB); ldc = 512; colt = (pn - 26) * 256; }
            else if (pn < 29) { base = (bf16_t*)(ws + OFF_QM); ldc = 256; colt = 0; }
            else { base = (bf16_t*)(ws + OFF_ZM); ldc = 256; colt = 0; }
        } else {
            if (pn < 4) { base = (bf16_t*)(ws + OFF_Q1); ldc = 1024; colt = pn * 256; }
            else if (pn < 7) { base = (bf16_t*)(ws + OFF_KV1); ldc = 768; colt = (pn - 4) * 256; }
            else if (pn < 11) { base = (bf16_t*)(ws + OFF_Z1); ldc = 1024; colt = (pn - 7) * 256; }
            else if (pn < 12) { base = (bf16_t*)(ws + OFF_QM1); ldc = 256; colt = 0; }
            else if (pn < 13) { base = (bf16_t*)(ws + OFF_ZM1); ldc = 256; colt = 0; }
            else { base = (bf16_t*)(ws + OFF_GATE); ldc = 256; colt = 0; }
        }
        const int row0 = u.pm * BM + wr * 64 + fr, col0 = colt + wc * 32 + 8 * fq;
#pragma unroll
        for (int ai = 0; ai < 2; ++ai)
#pragma unroll
            for (int m = 0; m < 4; ++m) { bf16_t* rowp = base + (size_t)(row0 + ai * HALF + m * 16) * ldc + col0;
#pragma unroll
                for (int bj = 0; bj < 2; ++bj) { const f32x4 v0 = acc[ai][bj][m][0], v1 = acc[ai][bj][m][1];
                    v4u w; w.x = cvt_pk_bf16(v0[0], v0[1]); w.y = cvt_pk_bf16(v0[2], v0[3]); w.z = cvt_pk_bf16(v1[0], v1[1]); w.w = cvt_pk_bf16(v1[2], v1[3]);
                    *(v4u*)(rowp + bj * HALF) = w; } }
    }
};
struct EpiResid {
    static constexpr bool PERM = false, AFTER_DRAIN = false;
    const float* base; float* out; int ldc;
    __device__ __forceinline__ void operator()(const f32x4 (&acc)[2][2][4][2], const Unit& u, int wr, int wc, int fr, int fq) const {
        const int col0 = u.pn * BM + wc * 32 + 4 * fq;
#pragma unroll
        for (int ai = 0; ai < 2; ++ai)
#pragma unroll
            for (int m = 0; m < 4; ++m) { const size_t off = (size_t)(u.pm * BM + ai * HALF + wr * 64 + m * 16 + fr) * ldc + col0;
#pragma unroll
                for (int bj = 0; bj < 2; ++bj)
#pragma unroll
                    for (int n = 0; n < 2; ++n) { const f32x4 bs = *(const f32x4*)(base + off + bj * HALF + n * 16); *(f32x4*)(out + off + bj * HALF + n * 16) = bs + acc[ai][bj][m][n]; } }
    }
};

struct EpiCmp1 {
    static constexpr bool PERM = true, AFTER_DRAIN = false;
    bf16_t* hid; const float* peb;
    __device__ __forceinline__ void operator()(const f32x4 (&acc)[2][2][4][2], const Unit& u, int wr, int wc, int fr, int fq) const {
        const int kv = u.tag >> 1, g = u.tag & 1, col0 = wc * 32 + 8 * fq;
        float pb[2][8];
#pragma unroll
        for (int bj = 0; bj < 2; ++bj)
#pragma unroll
            for (int e = 0; e < 8; ++e) pb[bj][e] = peb[kv * 256 + bj * HALF + col0 + e];
#pragma unroll
        for (int ai = 0; ai < 2; ++ai)
#pragma unroll
            for (int m = 0; m < 4; ++m) { const int rp = u.pm * BM + ai * HALF + wr * 64 + m * 16 + fr, b = rp >> 7, n = rp & 127;
                bf16_t* rowp = hid + ((((size_t)kv * NB + b) * 2 + g) * 128 + n) * 256 + col0;
#pragma unroll
                for (int bj = 0; bj < 2; ++bj) { float v[8];
#pragma unroll
                    for (int e = 0; e < 4; ++e) { v[e] = acc[ai][bj][m][0][e] + pb[bj][e]; v[4 + e] = acc[ai][bj][m][1][e] + pb[bj][4 + e]; }
#pragma unroll
                    for (int e = 0; e < 8; ++e) v[e] = v[e] * __builtin_amdgcn_rcpf(1.0f + __builtin_amdgcn_exp2f(-v[e] * 1.4426950408889634f));
                    v4u w; w.x = cvt_pk_bf16(v[0], v[1]); w.y = cvt_pk_bf16(v[2], v[3]); w.z = cvt_pk_bf16(v[4], v[5]); w.w = cvt_pk_bf16(v[6], v[7]);
                    *(v4u*)(rowp + bj * HALF) = w; } }
    }
};

template <class Epi, class Sched, bool ALIGN_EPI = false, bool SP2 = false>
__device__ __forceinline__ void gemm_phase(LAS unsigned char* lds, const Gemm g, const Sched& S, const Epi& E) {
    const int tid = fresh_tid(), wid = __builtin_amdgcn_readfirstlane(tid >> 6), lane = tid & 63, wr = wid >> 2, wc = wid & 3, fr = lane & 15, fq = lane >> 4;
    const int K = g.K, nt = K / BK;
    unsigned voffA[2], voffB[2];
#pragma unroll
    for (int i = 0; i < 2; ++i) { int R, C; stage_rc(tid * 16 + i * 8192, R, C); const int Rb = Epi::PERM ? ((R & ~31) + perm32(R & 31)) : R;
        voffA[i] = (unsigned)(R * g.lda + C) * 2u; voffB[i] = (unsigned)(Rb * g.ldb + C) * 2u; }
    const size_t kstepA = (size_t)g.kstepA, kstepB = (size_t)g.kstepB;
    const size_t hstepA = (size_t)HALF * g.lda * 2, hstepB = (size_t)HALF * g.ldb * 2;
    const unsigned ldsw = (unsigned)wid * 1024u;
    const int aoff = lds_byte(wr * 64 + fr, fq * 8), boff = lds_byte(wc * 32 + fr, fq * 8);
#define PG8_SA(b, h) (((b) * 2 + (h)) * HTB)
#define PG8_SB(b, h) ((4 + (b) * 2 + (h)) * HTB)
#define PG8_STAGE(bufoff, gbase, voff) do { _Pragma("unroll") for (int _i = 0; _i < 2; ++_i) \
        __builtin_amdgcn_global_load_lds((const unsigned*)((const char*)(gbase) + (voff)[_i]), (LAS unsigned*)(lds + (bufoff) + ldsw + _i * 8192), 16, 0, 0); } while (0)
#define PG8_LDA(dst, b, h) do { _Pragma("unroll") for (int m = 0; m < 4; ++m) _Pragma("unroll") for (int k = 0; k < 2; ++k) dst[m][k] = *(const LAS bf16x8*)(lds + PG8_SA(b, h) + aoff + m * 2048 + k * 1024); } while (0)
#define PG8_LDB(dst, b, h) do { _Pragma("unroll") for (int n = 0; n < 2; ++n) _Pragma("unroll") for (int k = 0; k < 2; ++k) dst[n][k] = *(const LAS bf16x8*)(lds + PG8_SB(b, h) + boff + n * 2048 + k * 1024); } while (0)
#define PG8_MMA(ai, bj, At, Bt) do { __builtin_amdgcn_s_setprio(1); _Pragma("unroll") for (int m = 0; m < 4; ++m) _Pragma("unroll") for (int n = 0; n < 2; ++n) _Pragma("unroll") for (int k = 0; k < 2; ++k) \
        acc[ai][bj][m][n] = __builtin_amdgcn_mfma_f32_16x16x32_bf16(Bt[n][k], At[m][k], acc[ai][bj][m][n], 0, 0, 0); __builtin_amdgcn_s_setprio(0); } while (0)
#define PG8_WAIT_V(n) asm volatile("s_waitcnt vmcnt(" #n ")" ::: "memory")
#define PG8_WAIT_L(n) asm volatile("s_waitcnt lgkmcnt(" #n ")" ::: "memory")
#define PG8_BAR __builtin_amdgcn_s_barrier()
#define PG8_SCHED __builtin_amdgcn_sched_barrier(0)
    Unit cur, nxt; int ui = 0;
    if (!S.next(0, cur)) return;
    f32x4 acc[2][2][4][2];
#pragma unroll
    for (int a = 0; a < 2; ++a)
#pragma unroll
        for (int b = 0; b < 2; ++b)
#pragma unroll
            for (int m = 0; m < 4; ++m)
#pragma unroll
                for (int n = 0; n < 2; ++n) acc[a][b][m][n] = (f32x4){0.f, 0.f, 0.f, 0.f};
    bf16x8 At[4][2], B0[2][2], B1[2][2];
    const char* cA = cur.A; const char* cB = cur.B;
    S.a_ready(cur);
    static_assert(SP2, "only the two-super-phase loop is kept in this file");
    {
        PG8_STAGE(PG8_SB(0, 0), cB, voffB); PG8_STAGE(PG8_SB(0, 1), cB + hstepB, voffB); PG8_STAGE(PG8_SA(0, 0), cA, voffA); PG8_STAGE(PG8_SA(0, 1), cA + hstepA, voffA);
        if (wr == 1) PG8_BAR;
        PG8_WAIT_V(2); PG8_BAR;
        PG8_STAGE(PG8_SB(1, 0), cB + kstepB, voffB); PG8_STAGE(PG8_SA(1, 0), cA + kstepA, voffA); PG8_STAGE(PG8_SB(1, 1), cB + hstepB + kstepB, voffB);
        PG8_WAIT_V(6); PG8_BAR;
    }
    for (;;) {
        const bool has_next = S.next(ui + 1, nxt);
        const char* nA = has_next ? nxt.A : cA; const char* nB = has_next ? nxt.B : cB;
        for (int t = 0; t < nt; t += 2) {
            const bool last = (t == nt - 2);
            const char* a1 = cA + (size_t)(t + 1) * kstepA;
            const char* a2 = last ? nA : cA + (size_t)(t + 2) * kstepA; const char* b2 = last ? nB : cB + (size_t)(t + 2) * kstepB;
            const char* a3 = a2 + kstepA; const char* b3 = b2 + kstepB;
            if (last && has_next) S.a_ready(nxt);
            PG8_LDB(B0, 0, 0); PG8_LDB(B1, 0, 1); PG8_SCHED; PG8_LDA(At, 0, 0); PG8_STAGE(PG8_SA(1, 1), a1 + hstepA, voffA);
            PG8_WAIT_V(8); PG8_WAIT_L(0); PG8_BAR; PG8_MMA(0, 0, At, B0); PG8_MMA(0, 1, At, B1); PG8_BAR; PG8_SCHED;
            PG8_LDA(At, 0, 1); PG8_STAGE(PG8_SB(0, 0), b2, voffB); PG8_STAGE(PG8_SB(0, 1), b2 + hstepB, voffB); PG8_STAGE(PG8_SA(0, 0), a2, voffA);
            PG8_WAIT_V(8); PG8_WAIT_L(0); PG8_BAR; PG8_MMA(1, 0, At, B0); PG8_MMA(1, 1, At, B1); PG8_BAR; PG8_SCHED;
            PG8_LDB(B0, 1, 0); PG8_LDB(B1, 1, 1); PG8_SCHED; PG8_LDA(At, 1, 0); PG8_STAGE(PG8_SA(0, 1), a2 + hstepA, voffA);
            PG8_WAIT_V(8); PG8_WAIT_L(0); PG8_BAR; PG8_MMA(0, 0, At, B0); PG8_MMA(0, 1, At, B1); PG8_BAR; PG8_SCHED;
            PG8_LDA(At, 1, 1); PG8_STAGE(PG8_SB(1, 0), b3, voffB); PG8_STAGE(PG8_SB(1, 1), b3 + hstepB, voffB); PG8_STAGE(PG8_SA(1, 0), a3, voffA);
            PG8_WAIT_V(8); PG8_WAIT_L(0); PG8_BAR; PG8_MMA(1, 0, At, B0); PG8_MMA(1, 1, At, B1); PG8_BAR; PG8_SCHED;
        }
        if constexpr (ALIGN_EPI) { if (wr == 0) PG8_BAR; }
        if constexpr (!Epi::AFTER_DRAIN) { E(acc, cur, wr, wc, fr, fq); S.done(cur); }
        if (!has_next) break;
#pragma unroll
        for (int a = 0; a < 2; ++a)
#pragma unroll
            for (int b = 0; b < 2; ++b)
#pragma unroll
                for (int m = 0; m < 4; ++m)
#pragma unroll
                    for (int n = 0; n < 2; ++n) acc[a][b][m][n] = (f32x4){0.f, 0.f, 0.f, 0.f};
        cur = nxt; cA = nA; cB = nB; ++ui;
        if constexpr (ALIGN_EPI) { if (wr == 1) PG8_BAR; }
    }
    PG8_WAIT_V(0);
    if constexpr (!ALIGN_EPI) { if (wr == 0) PG8_BAR; }
    PG8_BAR;
#undef PG8_SA
#undef PG8_SB
#undef PG8_STAGE
#undef PG8_LDA
#undef PG8_LDB
#undef PG8_MMA
#undef PG8_WAIT_V
#undef PG8_WAIT_L
#undef PG8_BAR
#undef PG8_SCHED
}
}

constexpr int NWAVES = 8, LDS_BYTES = 147456;
__device__ __forceinline__ float wave_sum(float v) {
#pragma unroll
    for (int o = 1; o < 64; o <<= 1) v += __shfl_xor(v, o);
    return v;
}
template <bool PERM>
__device__ __forceinline__ void p0_transpose_item(const float* W, int K, int N, int NP, bf16_t* WT, LAS float* scr, int item, int lane, const float* ksc = nullptr) {
    const int nblk = NP / 32, kb = item / nblk, nb = item % nblk, k0 = 64 * kb, n0 = 32 * nb;
    int ncol = n0 + (lane & 7) * 4; if (PERM) ncol = nsa_col_orig(ncol);
    f32x4 v[8];
#pragma unroll
    for (int i = 0; i < 8; ++i) { const int kk = 8 * i + (lane >> 3); v[i] = ncol >= 0 ? *(const f32x4*)(W + (size_t)(k0 + kk) * N + ncol) : (f32x4){0.f, 0.f, 0.f, 0.f}; if (ksc) v[i] = v[i] * ksc[k0 + kk]; }
#pragma unroll
    for (int i = 0; i < 8; ++i) { const int kk = 8 * i + (lane >> 3); LAS float* d = scr + kk * 33 + (lane & 7) * 4; d[0] = v[i][0]; d[1] = v[i][1]; d[2] = v[i][2]; d[3] = v[i][3]; }
    LDS_WAIT(); asm volatile("" ::: "memory");
    const int c = lane & 7;
#pragma unroll
    for (int j = 0; j < 4; ++j) { const int n = (lane >> 3) + 8 * j; const LAS float* s = scr + (8 * c) * 33 + n;
        v4u o; o.x = pk2(s[0 * 33], s[1 * 33]); o.y = pk2(s[2 * 33], s[3 * 33]); o.z = pk2(s[4 * 33], s[5 * 33]); o.w = pk2(s[6 * 33], s[7 * 33]);
        *(v4u*)(WT + (size_t)(n0 + n) * K + k0 + 8 * c) = o; }
    LDS_WAIT(); asm volatile("" ::: "memory");
}
__device__ __forceinline__ void rms_row_to_bf16(const float* xrow, const float* g, bf16_t* orow, int lane) {
    const f32x4* xr = (const f32x4*)xrow + lane; const f32x4* gr = (const f32x4*)g + lane;
    f32x4 v[4]; float s = 0.f;
#pragma unroll
    for (int j = 0; j < 4; ++j) { v[j] = xr[64 * j]; s += (v[j].x * v[j].x + v[j].y * v[j].y) + (v[j].z * v[j].z + v[j].w * v[j].w); }
    const float rs = 1.f / sqrtf(wave_sum(s) * (1.f / 1024.f) + EPS);
    unsigned long long* o8 = (unsigned long long*)orow + lane;
#pragma unroll
    for (int j = 0; j < 4; ++j) { const f32x4 gg = g ? gr[64 * j] : (f32x4){1.f, 1.f, 1.f, 1.f};
        o8[64 * j] = (unsigned long long)pk2(v[j].x * rs * gg.x, v[j].y * rs * gg.y) | ((unsigned long long)pk2(v[j].z * rs * gg.z, v[j].w * rs * gg.w) << 32); }
}
__device__ __forceinline__ void rms_row_inplace(float* xrow, const float* g, int lane) {
    f32x4* xr = (f32x4*)xrow + lane; const f32x4* gr = (const f32x4*)g + lane;
    f32x4 v[4]; float s = 0.f;
#pragma unroll
    for (int j = 0; j < 4; ++j) { v[j] = xr[64 * j]; s += (v[j].x * v[j].x + v[j].y * v[j].y) + (v[j].z * v[j].z + v[j].w * v[j].w); }
    const float rs = 1.f / sqrtf(wave_sum(s) * (1.f / 1024.f) + EPS);
#pragma unroll
    for (int j = 0; j < 4; ++j) xr[64 * j] = v[j] * rs * gr[64 * j];
}

typedef float f32x16 __attribute__((ext_vector_type(16)));
typedef short s16x4 __attribute__((ext_vector_type(4)));
typedef short v4i16_t __attribute__((ext_vector_type(4)));
typedef unsigned v2u __attribute__((ext_vector_type(2)));
#define MFMA32(a, b, c) __builtin_amdgcn_mfma_f32_32x32x16_bf16(a, b, c, 0, 0, 0)
constexpr float LOG2E = 1.4426950408889634f, LN2 = 0.6931471805599453f;
__device__ __forceinline__ int crow(int r, int hi) { return (r & 3) + 8 * (r >> 2) + 4 * hi; }
__device__ __forceinline__ s16x4 vtr(const LAS unsigned char* p) { return __builtin_bit_cast(s16x4, __builtin_amdgcn_ds_read_tr16_b64_v4i16((LAS v4i16_t*)p)); }
__device__ __forceinline__ float xmax32(float v) { auto rr = __builtin_amdgcn_permlane32_swap(__float_as_uint(v), __float_as_uint(v), false, false); return fmaxf(__uint_as_float(rr[0]), __uint_as_float(rr[1])); }
__device__ __forceinline__ float xsum32(float v) { auto rr = __builtin_amdgcn_permlane32_swap(__float_as_uint(v), __float_as_uint(v), false, false); return __uint_as_float(rr[0]) + __uint_as_float(rr[1]); }
__device__ __forceinline__ float ex2(float x) { return __builtin_amdgcn_exp2f(x); }
__device__ __forceinline__ bf16x8 pack8(const f32x16& v, int r0) {
    v4u w; w.x = pg8::cvt_pk_bf16(v[r0], v[r0 + 1]); w.y = pg8::cvt_pk_bf16(v[r0 + 2], v[r0 + 3]); w.z = pg8::cvt_pk_bf16(v[r0 + 4], v[r0 + 5]); w.w = pg8::cvt_pk_bf16(v[r0 + 6], v[r0 + 7]);
    return __builtin_bit_cast(bf16x8, w);
}
__device__ __forceinline__ bf16x8 vfrag(const LAS unsigned char* p) { const s16x4 a = vtr(p), b = vtr(p + 512); return (bf16x8){a[0], a[1], a[2], a[3], b[0], b[1], b[2], b[3]}; }

struct KVRegs { v4u k, v; };
__device__ __forceinline__ KVRegs kv_load(const bf16_t* Kg, const bf16_t* Vg, int ld, int tid) {
    const int key = (tid & 7) + 8 * (tid >> 6), ch = (tid >> 3) & 7;
    KVRegs r; r.k = *(const v4u*)(Kg + (size_t)key * ld + ch * 8); r.v = *(const v4u*)(Vg + (size_t)key * ld + ch * 8); return r;
}
__device__ __forceinline__ void kv_store(LAS unsigned char* buf, const KVRegs& r, int tid) {
    const int key = (tid & 7) + 8 * (tid >> 6), ch = (tid >> 3) & 7;
    *(LAS v4u*)(buf + ch * 1024 + key * 16) = r.k;
    *(LAS v4u*)(buf + 8192 + (ch >> 2) * 4096 + key * 64 + (ch & 3) * 16) = r.v;
}
struct Sm64 { f32x16 o[2]; float m, l; };
__device__ __forceinline__ void sm64_init(Sm64& st) {
#pragma unroll
    for (int r = 0; r < 16; ++r) { st.o[0][r] = 0.f; st.o[1][r] = 0.f; }
    st.m = -1e30f; st.l = 0.f;
}
__device__ __forceinline__ void qk64(f32x16& s0, f32x16& s1, const bf16x8 (&qf)[4], const LAS unsigned char* buf, int r32, int hi) {
    const LAS unsigned char* kp = buf + hi * 1024 + r32 * 16;
#pragma unroll
    for (int r = 0; r < 16; ++r) { s0[r] = 0.f; s1[r] = 0.f; }
#pragma unroll
    for (int d0 = 0; d0 < 4; ++d0) { const bf16x8 k0 = *(const LAS bf16x8*)(kp + d0 * 2048), k1 = *(const LAS bf16x8*)(kp + d0 * 2048 + 512);
        s0 = MFMA32(k0, qf[d0], s0); s1 = MFMA32(k1, qf[d0], s1); }
}
__device__ __forceinline__ void pv64(f32x16 (&o)[2], const f32x16& p0, const f32x16& p1, const LAS unsigned char* buf, int lane, int hi) {
    const bf16x8 pf0 = pack8(p0, 0), pf1 = pack8(p0, 8), pf2 = pack8(p1, 0), pf3 = pack8(p1, 8);
    const LAS unsigned char* vp = buf + 8192 + ((lane >> 4) & 1) * 32 + (lane & 3) * 8 + (4 * hi + ((lane & 15) >> 2)) * 64;
#pragma unroll
    for (int dt = 0; dt < 2; ++dt) {
        o[dt] = MFMA32(vfrag(vp + dt * 4096), pf0, o[dt]); o[dt] = MFMA32(vfrag(vp + dt * 4096 + 1024), pf1, o[dt]);
        o[dt] = MFMA32(vfrag(vp + dt * 4096 + 2048), pf2, o[dt]); o[dt] = MFMA32(vfrag(vp + dt * 4096 + 3072), pf3, o[dt]);
    }
}
typedef float f32x2 __attribute__((ext_vector_type(2)));
template <int MODE>
__device__ __forceinline__ void tile64(Sm64& st, const bf16x8 (&qf)[4], const LAS unsigned char* buf, int lane, float c2, const float (&kb)[16], float off, float off32, int lim, int lo) {
    const int r32 = lane & 31, hi = lane >> 5;
    f32x16 s0, s1; qk64(s0, s1, qf, buf, r32, hi);
    const f32x2 c2v = {c2, c2};
#pragma unroll
    for (int r = 0; r < 16; r += 2) { const f32x2 kv2 = {kb[r], kb[r + 1]};
        f32x2 a = {s0[r], s0[r + 1]}, b = {s1[r], s1[r + 1]};
        a = __builtin_elementwise_fma(a, c2v, kv2); b = __builtin_elementwise_fma(b, c2v, kv2);
        s0[r] = a.x; s0[r + 1] = a.y; s1[r] = b.x; s1[r + 1] = b.y; }
    if (MODE != 0) {
        const int l0 = lim - 4 * hi, l1 = lim - 32 - 4 * hi, g0 = lo - 4 * hi, g1 = lo - 32 - 4 * hi;
#pragma unroll
        for (int r = 0; r < 16; ++r) { const int kc = (r & 3) + 8 * (r >> 2);
            const bool v0 = (kc <= l0) && (MODE == 1 || kc >= g0), v1 = (kc <= l1) && (MODE == 1 || kc >= g1);
            s0[r] = v0 ? s0[r] : -INFINITY; s1[r] = v1 ? s1[r] : -INFINITY; }
    }
    float m0 = fmaxf(s0[0], s0[1]), m1 = fmaxf(s1[0], s1[1]);
#pragma unroll
    for (int r = 2; r < 16; r += 2) { m0 = fmaxf(fmaxf(m0, s0[r]), s0[r + 1]); m1 = fmaxf(fmaxf(m1, s1[r]), s1[r + 1]); }
    const float mx = xmax32(fmaxf(m0 + off, m1 + off32));
    const float mn = fmaxf(st.m, mx), al = ex2(st.m - mn);
    const f32x2 d0 = {off - mn, off - mn}, d1 = {off32 - mn, off32 - mn};
    f32x2 sum2 = {0.f, 0.f};
#pragma unroll
    for (int r = 0; r < 16; r += 2) { f32x2 a = {s0[r], s0[r + 1]}, b = {s1[r], s1[r + 1]};
        a = a + d0; b = b + d1;
        a.x = ex2(a.x); a.y = ex2(a.y); b.x = ex2(b.x); b.y = ex2(b.y);
        sum2 = sum2 + a; sum2 = sum2 + b;
        s0[r] = a.x; s0[r + 1] = a.y; s1[r] = b.x; s1[r + 1] = b.y; }
    const float sum = xsum32(sum2.x + sum2.y);
    st.l = st.l * al + sum; st.m = mn;
    const f32x2 alv = {al, al};
#pragma unroll
    for (int r = 0; r < 16; r += 2) { f32x2 a = {st.o[0][r], st.o[0][r + 1]}, b = {st.o[1][r], st.o[1][r + 1]}; a = a * alv; b = b * alv;
        st.o[0][r] = a.x; st.o[0][r + 1] = a.y; st.o[1][r] = b.x; st.o[1][r + 1] = b.y; }
    pv64(st.o, s0, s1, buf, lane, hi);
}

__device__ __forceinline__ void nsa_unit(const Params& p, LAS unsigned char* lds, int unit) {
    const int tid = fresh_tid(), lane = tid & 63, r32 = lane & 31, hi = lane >> 5, w = __builtin_amdgcn_readfirstlane(tid >> 6);
    const int q32 = unit & 63, g = (unit >> 6) & 1, b = unit >> 7;
    const int q0 = q32 * 32, cur = q0 >> 6, hidx = g * 8 + w, s = q0 + r32;
    const size_t trow = (size_t)b * SEQ + s;
    const bf16_t* Q1 = (const bf16_t*)(p.ws + OFF_Q1); const bf16_t* KV = (const bf16_t*)(p.ws + OFF_KV1); const bf16_t* gate = (const bf16_t*)(p.ws + OFF_GATE);
    const bf16_t* ckv = (const bf16_t*)(p.ws + OFF_CMPKV); const bf16_t* Z1 = (const bf16_t*)(p.ws + OFF_Z1); bf16_t* Y1 = (bf16_t*)(p.ws + OFF_Y1);
    const float slope2 = exp2f(-0.5f * (float)(hidx + 1)) * LOG2E, c2 = 0.125f * LOG2E;
    float kb[16];
#pragma unroll
    for (int r = 0; r < 16; ++r) kb[r] = slope2 * (float)crow(r, hi);
    LAS unsigned char* buf0 = lds; LAS unsigned char* buf1 = lds + 16384;
    LAS float* impw = (LAS float*)(lds + 32768) + w * 1024; LAS float* impt = (LAS float*)(lds + 65536); LAS unsigned* msk = (LAS unsigned*)(lds + 65536 + 4224);
    bf16x8 qf[4];
#pragma unroll
    for (int d0 = 0; d0 < 4; ++d0) qf[d0] = *(const bf16x8*)(Q1 + trow * 1024 + hidx * 64 + d0 * 16 + hi * 8);
    const float g0 = sigmoidf_(bf2f(gate[trow * 256 + hidx * 3 + 0])), g1 = sigmoidf_(bf2f(gate[trow * 256 + hidx * 3 + 1])), g2 = sigmoidf_(bf2f(gate[trow * 256 + hidx * 3 + 2]));
    LAS float* otl = (LAS float*)(lds + 73728);
    {
        const bf16_t* kc = ckv + (((size_t)0 * NB + b) * 2 + g) * 128 * 64; const bf16_t* vc = ckv + (((size_t)1 * NB + b) * 2 + g) * 128 * 64;
        { const KVRegs r0 = kv_load(kc, vc, 64, tid), r1 = kv_load(kc + 64 * 64, vc + 64 * 64, 64, tid); kv_store(buf0, r0, tid); kv_store(buf1, r1, tid); }
        __syncthreads();
        f32x16 sc[4]; qk64(sc[0], sc[1], qf, buf0, r32, hi); qk64(sc[2], sc[3], qf, buf1, r32, hi);
        float mx = -INFINITY;
#pragma unroll
        for (int T = 0; T < 4; ++T)
#pragma unroll
            for (int r = 0; r < 16; ++r) { const int n = 32 * T + crow(r, hi), dist = s - (16 * n + 31);
                const float v = dist >= 0 ? fmaf(sc[T][r], c2, -slope2 * (float)dist) : -INFINITY; sc[T][r] = v; mx = fmaxf(mx, v); }
        mx = fmaxf(xmax32(mx), -1e30f);
        float sum = 0.f;
#pragma unroll
        for (int T = 0; T < 4; ++T)
#pragma unroll
            for (int r = 0; r < 16; ++r) { sc[T][r] = ex2(sc[T][r] - mx); sum += sc[T][r]; }
        sum = xsum32(sum);
        const float inv = sum > 0.f ? 1.0f / sum : 0.f;
        float prev_y = 0.f;
#pragma unroll
        for (int T = 0; T < 4; ++T)
#pragma unroll
            for (int c = 0; c < 4; ++c) { const float x3 = sc[T][4 * c + 3], y = __shfl_xor(x3, 32);
                const float sum4 = (sc[T][4 * c] + sc[T][4 * c + 1]) + (sc[T][4 * c + 2] + x3);
                impw[r32 * 32 + 8 * T + 2 * c + hi] = (sum4 + (hi ? y : prev_y)) * inv; prev_y = y; }
        f32x16 oc[2];
#pragma unroll
        for (int r = 0; r < 16; ++r) { oc[0][r] = 0.f; oc[1][r] = 0.f; }
        pv64(oc, sc[0], sc[1], buf0, lane, hi); pv64(oc, sc[2], sc[3], buf1, lane, hi);
        const float f0 = g0 * inv;
#pragma unroll
        for (int r = 0; r < 16; ++r) { otl[r * 512 + tid] = oc[0][r] * f0; otl[(16 + r) * 512 + tid] = oc[1][r] * f0; }
    }
    __syncthreads();
    for (int idx = tid; idx < 1024; idx += 512) { float a = 0.f;
#pragma unroll
        for (int ww = 0; ww < 8; ++ww) a += ((LAS float*)(lds + 32768))[ww * 1024 + idx];
        impt[(idx >> 5) * 33 + (idx & 31)] = a; }
    __syncthreads();
    {
        const int nf = cur == 0 ? 1 : (cur == 1 ? 2 : 3), need = 8 - nf;
#pragma unroll
        for (int pi = 0; pi < 2; ++pi) {
            const int q = pi * 16 + 2 * w + hi, j = r32; bool sel;
            if (j == 0 || j == cur || j == cur - 1) sel = true;
            else if (j <= cur - 2) { const float v = impt[q * 33 + j]; int rank = 0;
                for (int j2 = 1; j2 <= cur - 2; ++j2) { const float v2 = impt[q * 33 + j2]; rank += (j2 != j && (v2 > v || (v2 == v && j2 < j))) ? 1 : 0; }
                sel = rank < need; }
            else sel = false;
            const unsigned long long bal = __ballot(sel);
            if (lane == 0) msk[pi * 16 + 2 * w] = (unsigned)bal;
            if (lane == 32) msk[pi * 16 + 2 * w + 1] = (unsigned)(bal >> 32);
        }
    }
    __syncthreads();
    const unsigned mymask = msk[r32];
    unsigned uni = mymask;
#pragma unroll
    for (int o = 1; o < 32; o <<= 1) uni |= (unsigned)__shfl_xor((int)uni, o);
    uni = (unsigned)__builtin_amdgcn_readfirstlane((int)uni);
    const int nslc = __builtin_popcount(uni), wlo = (q0 - 511 > 0 ? q0 - 511 : 0) >> 6, nwin = cur - wlo + 1, ntile = nslc + nwin;
    const bf16_t* kvb = KV + (size_t)b * SEQ * 768 + g * 64;
    unsigned rem_l = uni, rem_c = uni;
    auto tile_j = [&](int i, unsigned& rem) { int j; if (i < nslc) { j = __builtin_ctz(rem); rem &= rem - 1; } else j = wlo + (i - nslc); return j; };
    auto kvl = [&](int i, unsigned& rem) { const int j = tile_j(i, rem); const int col = i < nslc ? 256 : 512; return kv_load(kvb + (size_t)64 * j * 768 + col, kvb + (size_t)64 * j * 768 + col + 128, 768, tid); };
    KVRegs ra, rb;
    { const KVRegs r0 = kvl(0, rem_l); kv_store(buf0, r0, tid); }
    if (1 < ntile) ra = kvl(1, rem_l);
    __syncthreads();
    Sm64 st; sm64_init(st);
    for (int i = 0; i < ntile; ++i) {
        if (i + 2 < ntile) rb = kvl(i + 2, rem_l);
        const int j = tile_j(i, rem_c); const LAS unsigned char* buf = (i & 1) ? buf1 : buf0;
        const float off = slope2 * (float)(64 * j - s), off32 = off + 32.0f * slope2;
        if (i < nslc) { const bool has = (mymask >> j) & 1u; const float offh = has ? off : -INFINITY, offh32 = has ? off32 : -INFINITY;
            if (j < cur) tile64<0>(st, qf, buf, lane, c2, kb, offh, offh32, 0, 0);
            else tile64<1>(st, qf, buf, lane, c2, kb, offh, offh32, s - 64 * j, 0);
            if (i == nslc - 1) { const float f1 = g1 / st.l;
#pragma unroll
                for (int r = 0; r < 16; ++r) { otl[r * 512 + tid] += st.o[0][r] * f1; otl[(16 + r) * 512 + tid] += st.o[1][r] * f1; }
                sm64_init(st); }
        } else {
            if (64 * j + 63 <= q0 && 64 * j >= q0 - 480) tile64<0>(st, qf, buf, lane, c2, kb, off, off32, 0, 0);
            else tile64<2>(st, qf, buf, lane, c2, kb, off, off32, s - 64 * j, s - 511 - 64 * j);
        }
        if (i + 1 < ntile) kv_store((i & 1) ? buf0 : buf1, ra, tid);
        ra = rb;
        __syncthreads();
    }
    f32x16 ot[2];
    { const float f2 = g2 / st.l;
#pragma unroll
      for (int r = 0; r < 16; ++r) { ot[0][r] = otl[r * 512 + tid] + st.o[0][r] * f2; ot[1][r] = otl[(16 + r) * 512 + tid] + st.o[1][r] * f2; } }
#pragma unroll
    for (int dt = 0; dt < 2; ++dt)
#pragma unroll
        for (int c = 0; c < 4; ++c) { const int d = 32 * dt + 8 * c + 4 * hi;
            const v2u zz = *(const v2u*)(Z1 + trow * 1024 + hidx * 64 + d);
            const float y0 = ot[dt][4 * c] * siluf_(lo16(zz.x)), y1 = ot[dt][4 * c + 1] * siluf_(hi16(zz.x)), y2 = ot[dt][4 * c + 2] * siluf_(lo16(zz.y)), y3 = ot[dt][4 * c + 3] * siluf_(hi16(zz.y));
            v2u o2; o2.x = pg8::cvt_pk_bf16(y0, y1); o2.y = pg8::cvt_pk_bf16(y2, y3);
            *(v2u*)(Y1 + trow * 1280 + hidx * 64 + d) = o2; }
}

__device__ __forceinline__ void mem_unit(const bf16_t* mkv, const bf16_t* QMb, const bf16_t* ZMb, bf16_t* Y, int ldy, LAS unsigned char* lds, int unit) {
    const int tid = fresh_tid(), lane = tid & 63, r32 = lane & 31, hi = lane >> 5, w = __builtin_amdgcn_readfirstlane(tid >> 6);
    const int qc = unit & 7, h = (unit >> 3) & 3, b = unit >> 5;
    const size_t trow = (size_t)b * SEQ + qc * 256 + w * 32 + r32;
    const bf16_t* kb = mkv + (size_t)b * NMEM * 512 + h * 64;
#pragma unroll
    for (int t = 0; t < 4; ++t) { const KVRegs r = kv_load(kb + (size_t)t * 64 * 512, kb + (size_t)t * 64 * 512 + 256, 512, tid); kv_store(lds + t * 16384, r, tid); }
    bf16x8 qf[4];
#pragma unroll
    for (int d0 = 0; d0 < 4; ++d0) qf[d0] = *(const bf16x8*)(QMb + trow * 256 + h * 64 + d0 * 16 + hi * 8);
    __syncthreads();
    Sm64 st; sm64_init(st);
    float kb0[16];
#pragma unroll
    for (int r = 0; r < 16; ++r) kb0[r] = 0.f;
#pragma unroll 1
    for (int t = 0; t < 4; ++t) tile64<0>(st, qf, lds + t * 16384, lane, 0.125f * LOG2E, kb0, 0.f, 0.f, 0, 0);
    const float inv = 1.0f / st.l;
#pragma unroll
    for (int dt = 0; dt < 2; ++dt)
#pragma unroll
        for (int c = 0; c < 4; ++c) { const int d = 32 * dt + 8 * c + 4 * hi;
            const v2u zz = *(const v2u*)(ZMb + trow * 256 + h * 64 + d);
            const float y0 = st.o[dt][4 * c] * inv * siluf_(lo16(zz.x)), y1 = st.o[dt][4 * c + 1] * inv * siluf_(hi16(zz.x)), y2 = st.o[dt][4 * c + 2] * inv * siluf_(lo16(zz.y)), y3 = st.o[dt][4 * c + 3] * inv * siluf_(hi16(zz.y));
            v2u o2; o2.x = pg8::cvt_pk_bf16(y0, y1); o2.y = pg8::cvt_pk_bf16(y2, y3);
            *(v2u*)(Y + trow * ldy + h * 64 + d) = o2; }
    __syncthreads();
}

__device__ __forceinline__ void dil_task(const Params& p, LAS unsigned char* wl  , int task, int lane, bool dry = false) {
    const int r32 = lane & 31, hi = lane >> 5;
    const int grp = task >> 11, idx = task & 2047, dil = grp == 0 ? 1 : (grp == 1 ? 4 : 16), lg = grp * 2, nq = 64 >> lg;
    const int qi = idx & (nq - 1), rest = idx >> (6 - lg), h = rest & 3, brho = rest >> 2, b = brho >> lg, rho = brho & (dil - 1);
    const int hh = grp * 4 + h, i0 = 32 * qi, isub = i0 + r32;
    bf16_t* Q = (bf16_t*)(p.ws + OFF_Q); const bf16_t* K = (const bf16_t*)(p.ws + OFF_K); const bf16_t* V = (const bf16_t*)(p.ws + OFF_V); float* LSE = (float*)(p.ws + OFF_LSE);
    const size_t base = (size_t)b * SEQ + rho;
    const size_t trow = base + (size_t)isub * dil;
    const float slope2 = exp2f(-8.0f * (float)(hh + 1) / 12.0f) * (float)dil * LOG2E, c2 = 0.08838834764831845f * LOG2E;
    bf16x8 qf[8];
#pragma unroll
    for (int d0 = 0; d0 < 8; ++d0) qf[d0] = *(const bf16x8*)(Q + trow * 1536 + hh * 128 + d0 * 16 + hi * 8);
    f32x16 o[4]; float m = -1e30f, l = 0.f;
#pragma unroll
    for (int dt = 0; dt < 4; ++dt)
#pragma unroll
        for (int r = 0; r < 16; ++r) o[dt][r] = 0.f;
    LAS unsigned char* kl = wl; LAS unsigned char* vl = wl + 8192;
    const LAS unsigned char* vp = vl + ((lane >> 4) & 1) * 32 + (lane & 3) * 8 + (4 * hi + ((lane & 15) >> 2)) * 64;
    const int jt0 = qi - 4 > 0 ? qi - 4 : 0;
    v4u kr[8], vr[8];
    const int ekey = lane >> 4, ech = lane & 15;
#define DIL_LOAD(jt_) do { _Pragma("unroll") for (int it = 0; it < 8; ++it) { const size_t go = (base + (size_t)(32 * (jt_) + 4 * it + ekey) * dil) * 1536 + hh * 128 + ech * 8; \
        kr[it] = *(const v4u*)(K + go); vr[it] = *(const v4u*)(V + go); } } while (0)
    DIL_LOAD(jt0);
    for (int jt = jt0; jt <= qi; ++jt) {
        asm volatile("s_waitcnt lgkmcnt(0)" ::: "memory");
#pragma unroll
        for (int it = 0; it < 8; ++it) { const int key = 4 * it + ekey;
            *(LAS v4u*)(kl + key * 256 + ((ech ^ (key & 15)) * 16)) = kr[it];
            *(LAS v4u*)(vl + (ech >> 2) * 2048 + key * 64 + (ech & 3) * 16) = vr[it]; }
        if (jt < qi) DIL_LOAD(jt + 1);
        asm volatile("s_waitcnt lgkmcnt(0)" ::: "memory");
        f32x16 sc;
#pragma unroll
        for (int r = 0; r < 16; ++r) sc[r] = 0.f;
#pragma unroll
        for (int d0 = 0; d0 < 8; ++d0) { const bf16x8 kf = *(const LAS bf16x8*)(kl + r32 * 256 + (((2 * d0 + hi) ^ (r32 & 15)) * 16)); sc = MFMA32(kf, qf[d0], sc); }
        float mx = -INFINITY;
#pragma unroll
        for (int r = 0; r < 16; ++r) { const int dist = isub - (32 * jt + crow(r, hi));
            const float v = (dist >= 0 && dist <= 128) ? fmaf(sc[r], c2, -slope2 * (float)dist) : -INFINITY; sc[r] = v; mx = fmaxf(mx, v); }
        mx = xmax32(mx);
        const float mn = fmaxf(m, mx), al = ex2(m - mn);
        float sum = 0.f;
#pragma unroll
        for (int r = 0; r < 16; ++r) { sc[r] = ex2(sc[r] - mn); sum += sc[r]; }
        sum = xsum32(sum); l = l * al + sum; m = mn;
#pragma unroll
        for (int dt = 0; dt < 4; ++dt)
#pragma unroll
            for (int r = 0; r < 16; ++r) o[dt][r] *= al;
        const bf16x8 pf0 = pack8(sc, 0), pf1 = pack8(sc, 8);
#pragma unroll
        for (int dt = 0; dt < 4; ++dt) { o[dt] = MFMA32(vfrag(vp + dt * 2048), pf0, o[dt]); o[dt] = MFMA32(vfrag(vp + dt * 2048 + 1024), pf1, o[dt]); }
    }
#undef DIL_LOAD
    const float inv = 1.0f / l;
#pragma unroll
    for (int dt = 0; dt < 4; ++dt)
#pragma unroll
        for (int c = 0; c < 4; ++c) { const int d = 32 * dt + 8 * c + 4 * hi;
            v2u o2; o2.x = pg8::cvt_pk_bf16(o[dt][4 * c] * inv, o[dt][4 * c + 1] * inv); o2.y = pg8::cvt_pk_bf16(o[dt][4 * c + 2] * inv, o[dt][4 * c + 3] * inv);
            if (!dry) *(v2u*)(Q + trow * 1536 + hh * 128 + d) = o2; else asm volatile("" :: "v"(o2.x), "v"(o2.y)); }
    if (hi == 0 && !dry) LSE[((size_t)grp * T_ + trow) * 4 + h] = (m + __builtin_amdgcn_logf(l)) * LN2;
}

__device__ __forceinline__ float sigm_(float x) { return __builtin_amdgcn_rcpf(1.0f + ex2(-x * LOG2E)); }
__device__ __forceinline__ void lru_unit(const Params& p, LAS unsigned char* lds, int unit) {
    const int tid = fresh_tid(), lane = tid & 63, r32 = lane & 31, hi = lane >> 5, w = __builtin_amdgcn_readfirstlane(tid >> 6);
    const int hh = unit & 1, blk = (unit >> 1) & 15, b = unit >> 5;
    const int cj = blk * 64 + hh * 32 + r32;
    const bf16_t* xaza = (const bf16_t*)p.out; bf16_t* Y0 = (bf16_t*)(p.ws + OFF_Y0);
    LAS float* cw = (LAS float*)lds; LAS float* tot = (LAS float*)(lds + 2048); LAS float* xcs = (LAS float*)(lds + 8192 + w * 8704);
    LAS unsigned char* xst = lds + 77824; LAS unsigned char* zst = lds + 115200 + w * 2048;
    if (tid < 256) cw[tid] = p.conv_w[(tid >> 6) * 1024 + blk * 64 + (tid & 63)]; else if (tid < 320) cw[tid] = p.conv_b[blk * 64 + tid - 256];
    bf16x8 wa[4], wx[4];
#pragma unroll
    for (int ks = 0; ks < 4; ++ks) { float fa[8], fx[8];
#pragma unroll
        for (int jj = 0; jj < 8; ++jj) { const size_t wi = (size_t)blk * 4096 + (size_t)(16 * ks + 8 * hi + jj) * 64 + hh * 32 + r32; fa[jj] = p.ga_w[wi]; fx[jj] = p.gx_w[wi]; }
        v4u a4, x4; a4.x = pg8::cvt_pk_bf16(fa[0], fa[1]); a4.y = pg8::cvt_pk_bf16(fa[2], fa[3]); a4.z = pg8::cvt_pk_bf16(fa[4], fa[5]); a4.w = pg8::cvt_pk_bf16(fa[6], fa[7]);
        x4.x = pg8::cvt_pk_bf16(fx[0], fx[1]); x4.y = pg8::cvt_pk_bf16(fx[2], fx[3]); x4.z = pg8::cvt_pk_bf16(fx[4], fx[5]); x4.w = pg8::cvt_pk_bf16(fx[6], fx[7]);
        wa[ks] = __builtin_bit_cast(bf16x8, a4); wx[ks] = __builtin_bit_cast(bf16x8, x4); }
    const float ba = p.ga_b[cj], bx = p.gx_b[cj], sp8 = -8.0f * log1pf(expf(-p.lam[cj]));
    v4u xr[5], zr[2];
#define LRU_LOAD(c_) do { const int t0c_ = (c_) * 256; \
        _Pragma("unroll") for (int i = 0; i < 5; ++i) { const int e = tid + 512 * i, row = e >> 3, tt = t0c_ - 3 + row; xr[i] = (v4u){0u, 0u, 0u, 0u}; \
            if (e < 2072 && tt >= 0) xr[i] = *(const v4u*)(xaza + ((size_t)b * SEQ + tt) * 2048 + blk * 64 + (e & 7) * 8); } \
        _Pragma("unroll") for (int i = 0; i < 2; ++i) { const int e = lane + 64 * i; zr[i] = *(const v4u*)(xaza + ((size_t)b * SEQ + t0c_ + w * 32 + (e >> 2)) * 2048 + 1024 + blk * 64 + hh * 32 + (e & 3) * 8); } } while (0)
    LRU_LOAD(0);
    float hchunk = 0.f;
#pragma unroll 1
    for (int c = 0; c < 8; ++c) {
        const int t0 = c * 256 + w * 32;
        const size_t rowb = (size_t)b * SEQ + t0;
#pragma unroll
        for (int i = 0; i < 5; ++i) { const int e = tid + 512 * i; if (e < 2072) *(LAS v4u*)(xst + (e >> 3) * 144 + (e & 7) * 16) = xr[i]; }
#pragma unroll
        for (int i = 0; i < 2; ++i) { const int e = lane + 64 * i; *(LAS v4u*)(zst + (e >> 2) * 64 + (e & 3) * 16) = zr[i]; }
        __syncthreads();
        if (c < 7) LRU_LOAD(c + 1);
        bf16x8 af[4];
#pragma unroll
        for (int ks = 0; ks < 4; ++ks) { const int i0 = 16 * ks + 8 * hi; float acc[8];
            { const f32x4 b0 = *(const LAS f32x4*)(cw + 256 + i0), b1 = *(const LAS f32x4*)(cw + 256 + i0 + 4); acc[0] = b0[0]; acc[1] = b0[1]; acc[2] = b0[2]; acc[3] = b0[3]; acc[4] = b1[0]; acc[5] = b1[1]; acc[6] = b1[2]; acc[7] = b1[3]; }
#pragma unroll
            for (int k = 0; k < 4; ++k) { const v4u v = *(const LAS v4u*)(xst + (w * 32 + r32 + k) * 144 + i0 * 2);
                const f32x4 w0 = *(const LAS f32x4*)(cw + k * 64 + i0), w1 = *(const LAS f32x4*)(cw + k * 64 + i0 + 4);
                acc[0] += w0[0] * lo16(v.x); acc[1] += w0[1] * hi16(v.x); acc[2] += w0[2] * lo16(v.y); acc[3] += w0[3] * hi16(v.y);
                acc[4] += w1[0] * lo16(v.z); acc[5] += w1[1] * hi16(v.z); acc[6] += w1[2] * lo16(v.w); acc[7] += w1[3] * hi16(v.w); }
            *(LAS f32x4*)(xcs + r32 * 68 + i0) = (f32x4){acc[0], acc[1], acc[2], acc[3]}; *(LAS f32x4*)(xcs + r32 * 68 + i0 + 4) = (f32x4){acc[4], acc[5], acc[6], acc[7]};
            v4u pk; pk.x = pg8::cvt_pk_bf16(acc[0], acc[1]); pk.y = pg8::cvt_pk_bf16(acc[2], acc[3]); pk.z = pg8::cvt_pk_bf16(acc[4], acc[5]); pk.w = pg8::cvt_pk_bf16(acc[6], acc[7]);
            af[ks] = __builtin_bit_cast(bf16x8, pk); }
        f32x16 ra, rx;
#pragma unroll
        for (int r = 0; r < 16; ++r) { ra[r] = 0.f; rx[r] = 0.f; }
#pragma unroll
        for (int ks = 0; ks < 4; ++ks) { ra = MFMA32(af[ks], wa[ks], ra); rx = MFMA32(af[ks], wx[ks], rx); }
        asm volatile("s_waitcnt lgkmcnt(0)" ::: "memory");
        float a[16], u[16];
#pragma unroll
        for (int r = 0; r < 16; ++r) { const int tl = crow(r, hi); const float xc = xcs[tl * 68 + hh * 32 + r32];
            const float rg = sigm_(ra[r] + ba), ig = sigm_(rx[r] + bx), la = sp8 * rg;
            a[r] = ex2(la * LOG2E);
            const float om = fmaf(-a[r], a[r], 1.0f);
            const float mult = (t0 + tl == 0) ? 1.0f : __builtin_amdgcn_sqrtf(om);
            u[r] = xc * ig * mult; }
        float EA[8], EU[8];
#pragma unroll
        for (int cg = 0; cg < 4; ++cg) { const int r0 = 4 * cg;
            const float GA = (a[r0] * a[r0 + 1]) * (a[r0 + 2] * a[r0 + 3]), GU = ((u[r0] * a[r0 + 1] + u[r0 + 1]) * a[r0 + 2] + u[r0 + 2]) * a[r0 + 3] + u[r0 + 3];
            const float PA = __shfl_xor(GA, 32), PU = __shfl_xor(GU, 32);
            EA[2 * cg] = hi ? PA : GA; EU[2 * cg] = hi ? PU : GU; EA[2 * cg + 1] = hi ? GA : PA; EU[2 * cg + 1] = hi ? GU : PU; }
        float TA = 1.f, TU = 0.f;
#pragma unroll
        for (int g = 0; g < 8; ++g) { TU = EA[g] * TU + EU[g]; TA *= EA[g]; }
        LAS float* tt2 = tot + (c & 1) * 512;
        if (hi == 0) { tt2[(w * 32 + r32) * 2] = TA; tt2[(w * 32 + r32) * 2 + 1] = TU; }
        __syncthreads();
        float h = hchunk, hin = 0.f;
#pragma unroll
        for (int ww = 0; ww < 8; ++ww) { if (ww == w) hin = h; h = tt2[(ww * 32 + r32) * 2] * h + tt2[(ww * 32 + r32) * 2 + 1]; }
        hchunk = h;
        float hown[4], hg = hin;
#pragma unroll
        for (int g = 0; g < 8; ++g) { if ((g & 1) == hi) hown[g >> 1] = hg; hg = EA[g] * hg + EU[g]; }
        LAS bf16_t* zy = (LAS bf16_t*)zst;
#pragma unroll
        for (int cg = 0; cg < 4; ++cg) { float hc = hown[cg];
#pragma unroll
            for (int q = 0; q < 4; ++q) { const int r = 4 * cg + q; hc = a[r] * hc + u[r];
                const int tl = crow(r, hi); const float z = bf2f(zy[tl * 32 + r32]); zy[tl * 32 + r32] = f2bf(hc * z * sigm_(z)); } }
        asm volatile("s_waitcnt lgkmcnt(0)" ::: "memory");
#pragma unroll
        for (int i = 0; i < 2; ++i) { const int e = lane + 64 * i; const v4u yv = *(const LAS v4u*)(zst + (e >> 2) * 64 + (e & 3) * 16);
            *(v4u*)(Y0 + (rowb + (e >> 2)) * 1792 + blk * 64 + hh * 32 + (e & 3) * 8) = yv; }
        asm volatile("s_waitcnt lgkmcnt(0)" ::: "memory");
    }
#undef LRU_LOAD
    __syncthreads();
}

__device__ __forceinline__ void cmp1_task(const Params& p, int task, int lane) {
    const int r32 = lane & 31, hi = lane >> 5;
    const int ct = task & 7, rt = (task >> 3) & 3, g = (task >> 5) & 1, b = (task >> 6) & 7, kv = task >> 9;
    const bf16_t* KV = (const bf16_t*)(p.ws + OFF_KV1); const bf16_t* w1 = (const bf16_t*)(p.ws + OFF_PHIW1) + (size_t)kv * 256 * 2048; bf16_t* hid = (bf16_t*)(p.ws + OFF_CMPH);
    const float* peb = (const float*)(p.ws + OFF_PEB) + kv * 256;
    const int n = rt * 32 + r32;
    const bf16_t* ar = KV + ((size_t)b * SEQ + 16 * n) * 768 + kv * 128 + g * 64 + hi * 8;
    const bf16_t* br = w1 + (size_t)(ct * 32 + r32) * 2048 + hi * 8;
    f32x16 acc;
#pragma unroll
    for (int r = 0; r < 16; ++r) acc[r] = 0.f;
#pragma unroll 4
    for (int i = 0; i < 32; ++i) {
#pragma unroll
        for (int q = 0; q < 4; ++q) { const bf16x8 af = *(const bf16x8*)(ar + (size_t)i * 768 + 16 * q), bf = *(const bf16x8*)(br + i * 64 + 16 * q); acc = MFMA32(af, bf, acc); }
    }
    float pb = 0.f;
#pragma unroll 8
    for (int c = 0; c < 64; ++c) pb += peb[c * 512 + ct * 32 + r32];
    const size_t rowbase = (((size_t)kv * NB + b) * 2 + g) * 128 + rt * 32;
#pragma unroll
    for (int r = 0; r < 16; ++r) { const float v = acc[r] + pb; hid[(rowbase + crow(r, hi)) * 256 + ct * 32 + r32] = f2bf(v * sigm_(v)); }
}
__device__ __forceinline__ void cmp2_task(const Params& p, int task, int lane) {
    const int r32 = lane & 31, hi = lane >> 5;
    const int dtile = task & 1, rt = (task >> 1) & 63, kv = task >> 7;
    const bf16_t* hid = (const bf16_t*)(p.ws + OFF_CMPH) + ((size_t)kv * 2048 + rt * 32 + r32) * 256 + hi * 8;
    const bf16_t* w2 = (const bf16_t*)(p.ws + OFF_PHIW2) + ((size_t)kv * 64 + dtile * 32 + r32) * 256 + hi * 8;
    bf16_t* ckv = (bf16_t*)(p.ws + OFF_CMPKV) + ((size_t)kv * 2048 + rt * 32) * 64 + dtile * 32 + r32;
    f32x16 acc;
#pragma unroll
    for (int r = 0; r < 16; ++r) acc[r] = 0.f;
#pragma unroll
    for (int ks = 0; ks < 16; ++ks) acc = MFMA32(*(const bf16x8*)(hid + 16 * ks), *(const bf16x8*)(w2 + 16 * ks), acc);
#pragma unroll
    for (int r = 0; r < 16; ++r) { const int row = rt * 32 + crow(r, hi); ckv[(size_t)crow(r, hi) * 64] = f2bf((row & 127) == 127 ? 0.f : acc[r]); }
}

__device__ __forceinline__ void memkv_task(const Params& p, int task, int lane) {
    const int r32 = lane & 31, hi = lane >> 5;
    const int ct = task & 15, rt = (task >> 4) & 63, l = task >> 10;
    const float* ar = p.mem + (size_t)(rt * 32 + r32) * DM + hi * 8;
    const bf16_t* br = (const bf16_t*)(p.ws + OFF_WMKV) + ((size_t)l * 512 + ct * 32 + r32) * DM + hi * 8;
    bf16_t* mkv = (bf16_t*)(p.ws + OFF_MEMKV) + (size_t)l * NB * NMEM * 512;
    f32x16 acc; float ss = 0.f;
#pragma unroll
    for (int r = 0; r < 16; ++r) acc[r] = 0.f;
#pragma unroll 4
    for (int ks = 0; ks < DM / 16; ++ks) { const f32x4 x0 = *(const f32x4*)(ar + 16 * ks), x1 = *(const f32x4*)(ar + 16 * ks + 4);
        ss += (x0[0] * x0[0] + x0[1] * x0[1]) + (x0[2] * x0[2] + x0[3] * x0[3]) + (x1[0] * x1[0] + x1[1] * x1[1]) + (x1[2] * x1[2] + x1[3] * x1[3]);
        v4u pk; pk.x = pg8::cvt_pk_bf16(x0[0], x0[1]); pk.y = pg8::cvt_pk_bf16(x0[2], x0[3]); pk.z = pg8::cvt_pk_bf16(x1[0], x1[1]); pk.w = pg8::cvt_pk_bf16(x1[2], x1[3]);
        acc = MFMA32(__builtin_bit_cast(bf16x8, pk), *(const bf16x8*)(br + 16 * ks), acc); }
    ss = xsum32(ss);
    const float rs = 1.0f / sqrtf(ss * (1.0f / DM) + EPS);
#pragma unroll
    for (int r = 0; r < 16; ++r) { const float rr = __shfl(rs, crow(r, hi)); mkv[(size_t)(rt * 32 + crow(r, hi)) * 512 + ct * 32 + r32] = f2bf(acc[r] * rr); }
}

#define XB_TMO      128
#define XB_XCNT(j)  (256  + 64 * (j))
#define XB_XSUB(j)  (1280 + 64 * (j))
#define XB_XGEN(j)  (2304 + 64 * (j))
#define XB_TOP      3328
#define XB_TOPGEN   3392
#define XCD_BAR_WORDS 3456
#define XB_SPIN_CAP (1u << 18)
__device__ __forceinline__ unsigned xb_ld(unsigned* p)              { return __hip_atomic_load(p, __ATOMIC_RELAXED, __HIP_MEMORY_SCOPE_AGENT); }
__device__ __forceinline__ unsigned xb_add(unsigned* p, unsigned v) { return __hip_atomic_fetch_add(p, v, __ATOMIC_RELAXED, __HIP_MEMORY_SCOPE_AGENT); }
__device__ __forceinline__ unsigned xb_xcc_id() { return (unsigned)__builtin_amdgcn_s_getreg((3 << 11) | 20) & 0xFu; }
#define XB_SPIN(cond, bar) do { unsigned _sp = 0; while (cond) { __builtin_amdgcn_s_sleep(1); \
    if ((++_sp & 255u) == 0u) { if (xb_ld(&(bar)[XB_TMO])) break; if (_sp > XB_SPIN_CAP) { atomicAdd(&(bar)[XB_TMO], 1u); break; } } } } while (0)
struct XcdBarrier { unsigned* bar; unsigned x; volatile LAS unsigned* st; };
__device__ __forceinline__ XcdBarrier xcd_barrier_post(unsigned* bar, volatile LAS unsigned* st) {
    XcdBarrier b; b.bar = bar; b.x = xb_xcc_id(); b.st = st;
    if (threadIdx.x == 0) (void)xb_add(&bar[XB_XCNT(b.x)], 1u);
    return b;
}
__device__ __forceinline__ void xcd_barrier_complete(unsigned* bar, unsigned x, unsigned& nloc, unsigned& nx) {
    const unsigned G = gridDim.x * gridDim.y * gridDim.z;
    unsigned sum, cnt, mine, sp = 0u;
    for (;;) {
        sum = 0u; cnt = 0u; mine = 0u;
#pragma unroll
        for (unsigned j = 0; j < 16; ++j) { const unsigned c = xb_ld(&bar[XB_XCNT(j)]); sum += c; cnt += (c > 0u) ? 1u : 0u; mine = (j == x) ? c : mine; }
        if (sum == G) break;
        __builtin_amdgcn_s_sleep(1);
        if ((++sp & 255u) == 0u) { if (xb_ld(&bar[XB_TMO])) break; if (sp > XB_SPIN_CAP) { atomicAdd(&bar[XB_TMO], 1u); break; } }
    }
    nloc = mine > 0u ? mine : 1u; nx = cnt > 0u ? cnt : 1u;
}
__device__ __forceinline__ void xcd_barrier(const XcdBarrier& b) {
    asm volatile("s_waitcnt vmcnt(0)" ::: "memory");
    __syncthreads();
    if (threadIdx.x == 0) {
        unsigned* bar = b.bar;
        __builtin_amdgcn_s_waitcnt(0);
        unsigned nloc = b.st[0], nx = b.st[1];
        if (nloc == 0u) { xcd_barrier_complete(bar, b.x, nloc, nx); b.st[0] = nloc; b.st[1] = nx; }
        const unsigned old = xb_add(&bar[XB_XSUB(b.x)], 1u);
        const unsigned gen = old / nloc;
        if (old + 1u == (gen + 1u) * nloc) {
            __builtin_amdgcn_fence(__ATOMIC_RELEASE, "agent");
            asm volatile("s_waitcnt vmcnt(0)" ::: "memory");
            const unsigned og = xb_add(&bar[XB_TOP], 1u);
            const unsigned tg = og / nx;
            if (og + 1u == (tg + 1u) * nx) xb_add(&bar[XB_TOPGEN], 1u);
            else XB_SPIN(xb_ld(&bar[XB_TOPGEN]) == tg, bar);
            __builtin_amdgcn_fence(__ATOMIC_ACQUIRE, "agent");
            xb_add(&bar[XB_XGEN(b.x)], 1u);
            asm volatile("s_waitcnt vmcnt(0)" ::: "memory");
        } else {
            XB_SPIN(xb_ld(&bar[XB_XGEN(b.x)]) == gen, bar);
            __builtin_amdgcn_fence(__ATOMIC_ACQUIRE, "agent");
            asm volatile("s_waitcnt vmcnt(0)" ::: "memory");
        }
    }
    __syncthreads();
}
#define GSYNC() xcd_barrier(bar)

__device__ __forceinline__ int fresh_tid() { int t = threadIdx.x; asm volatile("" : "+v"(t)); return t; }
#ifndef PROBE_REP
#define PROBE_REP -1
#endif
#define REP(k) for (int rep_ = 0; rep_ < ((PROBE_REP == (k)) ? 2 : 1); ++rep_)
#define PH_IDS() const int tid = fresh_tid(), lane = tid & 63, wave = __builtin_amdgcn_readfirstlane(tid >> 6); const long gt = (long)blockIdx.x * 512 + tid, nt = (long)G * 512; \
    const int gw = blockIdx.x * NWAVES + wave, NGW = G * NWAVES; (void)lane; (void)gt; (void)nt; (void)gw; (void)NGW
__device__ __forceinline__ Params load_params() {
    Params p{};
#if defined(__HIP_DEVICE_COMPILE__)
    typedef const __attribute__((address_space(4))) unsigned long long* kq_t;
    kq_t k = (kq_t)__builtin_amdgcn_kernarg_segment_ptr(); asm volatile("" : "+s"(k));
    unsigned long long* d = (unsigned long long*)&p;
#pragma unroll
    for (int i = 0; i < (int)(sizeof(Params) / 8); ++i) d[i] = k[i];
#endif
    return p;
}
#define PP() const Params p = load_params()
__global__ void __launch_bounds__(NWAVES * 64, 2) mega(Params p_unused_arg) {
    extern __shared__ __attribute__((aligned(16))) unsigned char lds_raw[];
    LAS unsigned char* lds = (LAS unsigned char*)lds_raw;
    const int G = gridDim.x;
    if (threadIdx.x < 4) ((LAS unsigned*)(lds + LDS_BYTES - 64))[threadIdx.x] = 0u;
    __syncthreads();
    XcdBarrier bar; { PP(); bar.bar = (unsigned*)(p.ws + OFF_CTRL); } bar.x = xb_xcc_id(); bar.st = (volatile LAS unsigned*)(lds + LDS_BYTES - 64);
    if (threadIdx.x == 0) bar.st[2] = xb_add(&bar.bar[XB_XCNT(bar.x)], 1u);

#ifndef NPASS
#define NPASS 1
#endif
#ifndef SKIPMASK
#define SKIPMASK 0
#endif
#define RUN(k) if (!(NPASS > 1 && pass_ == 0 && ((SKIPMASK >> (k)) & 1)))
    for (int pass_ = 0; pass_ < NPASS; ++pass_) {
    RUN(0) {
        PP(); PH_IDS();
        LAS float* scr = (LAS float*)(lds + wave * 16384);
        constexpr int I0 = (DM / 64) * (HAWK_IN / 32), I1 = (HAWK_OUT / 64) * (DM / 32), I2 = (DM / 64) * (NSA_INP / 32), I3 = (NSA_OUT / 64) * (DM / 32), I4 = (2048 / 64) * (256 / 32), I5 = (DM / 64) * (512 / 32), I6 = (256 / 64) * (64 / 32);
        for (int it = gw; it < I0 + I1 + I2 + I3 + 2 * I4 + 2 * I5 + 2 * I6; it += NGW) {
            int r = it;
            if (r < I0) { p0_transpose_item<false>(p.hawk_w_in, DM, HAWK_IN, HAWK_IN, (bf16_t*)(p.ws + OFF_W0IN), scr, r, lane); continue; } r -= I0;
            if (r < I1) { p0_transpose_item<false>(p.hawk_w_out, HAWK_OUT, DM, DM, (bf16_t*)(p.ws + OFF_W0OUT), scr, r, lane); continue; } r -= I1;
            if (r < I2) { p0_transpose_item<true>(p.nsa_w_in, DM, NSA_IN, NSA_INP, (bf16_t*)(p.ws + OFF_W1IN), scr, r, lane); continue; } r -= I2;
            if (r < I3) { p0_transpose_item<false>(p.nsa_w_out, NSA_OUT, DM, DM, (bf16_t*)(p.ws + OFF_W1OUT), scr, r, lane); continue; } r -= I3;
            if (r < I4) { p0_transpose_item<false>(p.phik_w1, 2048, 256, 256, (bf16_t*)(p.ws + OFF_PHIW1), scr, r, lane); continue; } r -= I4;
            if (r < I4) { p0_transpose_item<false>(p.phiv_w1, 2048, 256, 256, (bf16_t*)(p.ws + OFF_PHIW1) + 256 * 2048, scr, r, lane); continue; } r -= I4;
            if (r < I5) { p0_transpose_item<false>(p.hawk_w_mem_kv, DM, 512, 512, (bf16_t*)(p.ws + OFF_WMKV), scr, r, lane, p.hawk_mem_norm); continue; } r -= I5;
            if (r < I5) { p0_transpose_item<false>(p.nsa_w_mem_kv, DM, 512, 512, (bf16_t*)(p.ws + OFF_WMKV) + 512 * DM, scr, r, lane, p.nsa_mem_norm); continue; } r -= I5;
            if (r < I6) { p0_transpose_item<false>(p.phik_w2, 256, 64, 64, (bf16_t*)(p.ws + OFF_PHIW2), scr, r, lane); continue; } r -= I6;
            p0_transpose_item<false>(p.phiv_w2, 256, 64, 64, (bf16_t*)(p.ws + OFF_PHIW2) + 64 * 256, scr, r, lane);
        }
        for (int m = gw; m < T_; m += NGW) rms_row_to_bf16(p.x + (size_t)m * DM, p.hawk_norm, (bf16_t*)(p.ws + OFF_XN) + (size_t)m * DM, lane);
        for (int m = gw; m < NB * NMEM; m += NGW) rms_row_to_bf16(p.mem + (size_t)m * DM, nullptr, (bf16_t*)(p.ws + OFF_MEMN) + (size_t)m * DM, lane);
        if (gt < 32768) { const int o = (int)gt & 511, kv = o >> 8, j = o & 255, k0 = ((int)gt >> 9) * 32; const float* pe = kv ? p.pe_v : p.pe_k; const float* w1 = kv ? p.phiv_w1 : p.phik_w1; float a = 0.f;
#pragma unroll 8
            for (int k = 0; k < 32; ++k) a += pe[k0 + k] * w1[(size_t)(k0 + k) * 256 + j];
            ((float*)(p.ws + OFF_PEB))[gt] = a; }
    }
    GSYNC();
    if (threadIdx.x == 0) { bool even = (G % 8) == 0;
        for (unsigned j = 0; j < 16; ++j) { const unsigned c = xb_ld(&bar.bar[XB_XCNT(j)]); even = even && (c == (j < 8 ? (unsigned)G / 8u : 0u)); }
        bar.st[3] = even ? bar.st[2] * 8u + bar.x : blockIdx.x; }
    __syncthreads();
    const int vcu = (int)bar.st[3];
    RUN(2) { PP(); pg8::Gemm g{DM, DM, DM, 128, 128}; pg8::StaticOrder S; S.init((const bf16_t*)(p.ws + OFF_XN), (const bf16_t*)(p.ws + OFF_W0IN), T_, HAWK_IN, DM, G, vcu);
      S.extra((const bf16_t*)(p.ws + OFF_MEMN), (const bf16_t*)(p.ws + OFF_WMKV), NB * NMEM, 1024);
      pg8::EpiRoute E{p.ws, (bf16_t*)p.out, 0};
      pg8::gemm_phase<pg8::EpiRoute, pg8::StaticOrder, true, true>(lds, g, S, E); }
    GSYNC();
    {
        PP(); PH_IDS();
        if (gw < 512) { float v = ((const float*)(p.ws + OFF_PEB))[lane * 512 + gw]; v = wave_sum(v); if (lane == 0) ((float*)(p.ws + OFF_PEBS))[gw] = v; }
        RUN(3) for (int u = blockIdx.x; u < 256; u += G) lru_unit(p, lds, u);
        RUN(4) for (int task = gw; task < 6144; task += NGW) dil_task(p, lds + wave * 16384, task, lane);
        __syncthreads();
        RUN(5) for (int u = blockIdx.x; u < 256; u += G) mem_unit((const bf16_t*)(p.ws + OFF_MEMKV), (const bf16_t*)(p.ws + OFF_QM), (const bf16_t*)(p.ws + OFF_ZM), (bf16_t*)(p.ws + OFF_Y0) + 1536, 1792, lds, u);
    }
    GSYNC();
    RUN(6) { PP(); PH_IDS();
        const bf16_t* Q = (const bf16_t*)(p.ws + OFF_Q); const bf16_t* ZB = (const bf16_t*)(p.ws + OFF_ZB); const float* LSE = (const float*)(p.ws + OFF_LSE); bf16_t* Y0 = (bf16_t*)(p.ws + OFF_Y0);
        for (long i = gt; i < (long)T_ * 64; i += nt) { const int t = (int)(i >> 6), c8 = ((int)i & 63) * 8, h = c8 >> 7;
            const float l0 = LSE[((size_t)0 * T_ + t) * 4 + h], l1 = LSE[((size_t)1 * T_ + t) * 4 + h], l2 = LSE[((size_t)2 * T_ + t) * 4 + h];
            const float mx = fmaxf(l0, fmaxf(l1, l2)), e0 = __expf(l0 - mx), e1 = __expf(l1 - mx), e2 = __expf(l2 - mx), inv = 1.0f / (e0 + e1 + e2), w0 = e0 * inv, w1 = e1 * inv, w2 = e2 * inv;
            const v4u a = *(const v4u*)(Q + (size_t)t * 1536 + c8), b = *(const v4u*)(Q + (size_t)t * 1536 + 512 + c8), c = *(const v4u*)(Q + (size_t)t * 1536 + 1024 + c8), z = *(const v4u*)(ZB + (size_t)t * 512 + c8);
            v4u o;
#define CMB(f) { const float zl = lo16(z.f), zh = hi16(z.f); o.f = pg8::cvt_pk_bf16((w0 * lo16(a.f) + w1 * lo16(b.f) + w2 * lo16(c.f)) * zl * sigm_(zl), (w0 * hi16(a.f) + w1 * hi16(b.f) + w2 * hi16(c.f)) * zh * sigm_(zh)); }
            CMB(x) CMB(y) CMB(z) CMB(w)
#undef CMB
            *(v4u*)(Y0 + (size_t)t * 1792 + 1024 + c8) = o; } }
    GSYNC();
    RUN(7) { PP(); pg8::Gemm g{HAWK_OUT, HAWK_OUT, HAWK_OUT, 128, 128}; pg8::StaticOrder S; S.init((const bf16_t*)(p.ws + OFF_Y0), (const bf16_t*)(p.ws + OFF_W0OUT), T_, DM, HAWK_OUT, G, vcu);
      pg8::EpiResid E{p.x, (float*)(p.ws + OFF_X1), DM};
      pg8::gemm_phase<pg8::EpiResid, pg8::StaticOrder, true, true>(lds, g, S, E); }
    GSYNC();
    RUN(8) { PP(); PH_IDS(); for (int m = gw; m < T_; m += NGW) rms_row_to_bf16((const float*)(p.ws + OFF_X1) + (size_t)m * DM, p.nsa_norm, (bf16_t*)(p.ws + OFF_XN) + (size_t)m * DM, lane); }
    GSYNC();
    RUN(9) { PP(); pg8::Gemm g{DM, DM, DM, 128, 128}; pg8::StaticOrder S; S.init((const bf16_t*)(p.ws + OFF_XN), (const bf16_t*)(p.ws + OFF_W1IN), T_, NSA_INP, DM, G, vcu);
      pg8::EpiRoute E{p.ws, (bf16_t*)p.out, 1};
      pg8::gemm_phase<pg8::EpiRoute, pg8::StaticOrder, true, true>(lds, g, S, E); }
    GSYNC();
    {
        PP();
        if (vcu < 16) {
            RUN(10) { const int kv = vcu >> 3, g = (vcu >> 2) & 1, rt = vcu & 3;
                pg8::Gemm gm{2048, 16 * 768, 2048, 768 * 2, 128}; pg8::OneUnit S; S.have = true; S.u.pm = rt; S.u.pn = 0; S.u.tag = kv * 2 + g;
                S.u.A = (const char*)((const bf16_t*)(p.ws + OFF_KV1) + kv * 128 + g * 64) + (size_t)rt * 256 * (16 * 768) * 2; S.u.B = (const char*)((const bf16_t*)(p.ws + OFF_PHIW1) + (size_t)kv * 256 * 2048);
                pg8::EpiCmp1 E{(bf16_t*)(p.ws + OFF_CMPH), (const float*)(p.ws + OFF_PEBS)};
                pg8::gemm_phase<pg8::EpiCmp1, pg8::OneUnit, true, true>(lds, gm, S, E); }
        } else {
            RUN(11) for (int u = vcu - 16; u < 256; u += G - 16) mem_unit((const bf16_t*)(p.ws + OFF_MEMKV) + (size_t)NB * NMEM * 512, (const bf16_t*)(p.ws + OFF_QM1), (const bf16_t*)(p.ws + OFF_ZM1), (bf16_t*)(p.ws + OFF_Y1) + 1024, 1280, lds, u);
        }
    }
    GSYNC();
    RUN(12) { PP(); PH_IDS(); for (int task = gw; task < 256; task += NGW) cmp2_task(p, task, lane); }
    GSYNC();
    RUN(13) { PP(); for (int u = blockIdx.x; u < 1024; u += G) nsa_unit(p, lds, u); }
    GSYNC();
    RUN(14) { PP(); pg8::Gemm g{NSA_OUT, NSA_OUT, NSA_OUT, 128, 128}; pg8::StaticOrder S; S.init((const bf16_t*)(p.ws + OFF_Y1), (const bf16_t*)(p.ws + OFF_W1OUT), T_, DM, NSA_OUT, G, vcu);
      pg8::EpiResid E{(const float*)(p.ws + OFF_X1), p.out, DM};
      pg8::gemm_phase<pg8::EpiResid, pg8::StaticOrder, true, true>(lds, g, S, E); }
    GSYNC();
    RUN(15) { PP(); PH_IDS(); for (int m = gw; m < T_; m += NGW) rms_row_inplace(p.out + (size_t)m * DM, p.final_norm, lane); }
    if (pass_ + 1 < NPASS) GSYNC();
    }
}

extern "C" void kernel_launch(void* const* d_in, const int* in_sizes, int n_in, void* d_out, int out_size, void* d_ws, size_t ws_size, hipStream_t stream) {
    static int grid_blocks = 0;
    if (!grid_blocks) {
        int dev = 0, cus = 0, per_cu = 0;
        (void)hipGetDevice(&dev);
        (void)hipDeviceGetAttribute(&cus, hipDeviceAttributeMultiprocessorCount, dev);
        if (hipFuncSetAttribute((const void*)mega, hipFuncAttributeMaxDynamicSharedMemorySize, LDS_BYTES) != hipSuccess) fprintf(stderr, "hipFuncSetAttribute failed\n");
        (void)hipOccupancyMaxActiveBlocksPerMultiprocessor(&per_cu, (const void*)mega, NWAVES * 64, LDS_BYTES);
        if (per_cu < 1) fprintf(stderr, "occupancy query reports %d blocks per CU\n", per_cu);
        grid_blocks = cus;
        if (ws_size < WS_END) fprintf(stderr, "workspace too small: %zu < %zu\n", ws_size, (size_t)WS_END);
    }
    Params p{};
    const float** f = (const float**)&p;
    for (int i = 0; i < 26; ++i) f[i] = (const float*)d_in[i];
    p.out = (float*)d_out; p.ws = (unsigned char*)d_ws;
    (void)hipMemsetAsync((unsigned char*)d_ws + OFF_CTRL, 0, 16384, stream);
    void* args[] = {&p};
    hipError_t e = hipLaunchCooperativeKernel((void*)mega, dim3(grid_blocks), dim3(NWAVES * 64), args, LDS_BYTES, stream);
    if (e != hipSuccess) fprintf(stderr, "cooperative launch failed: %s (grid %d)\n", hipGetErrorString(e), grid_blocks);
}
#endif
```

```cpp
#ifndef HOST_EMU
#include <hip/hip_runtime.h>
#include <hip/hip_cooperative_groups.h>
namespace cg = cooperative_groups;
#define DEVFN __device__ __forceinline__
#define DEVNI __device__ __forceinline__
#else
#include <cmath>
#include <cstdint>
#include <cstring>
#define DEVFN static inline
#define DEVNI static
#endif
#include <cstdio>
#include <cstdint>

#ifndef BATCH_
#define BATCH_ 8
#endif
#ifndef DM_
#define DM_ 1024
#endif

typedef unsigned short bf16_t;
constexpr int SEQ = 2048, NB = BATCH_, T_ = NB * SEQ, DM = DM_, NMEM = 256;
constexpr int HAWK_IN = 7680, HAWK_OUT = 1792, NSA_IN = 3376, NSA_INP = 3584, NSA_OUT = 1280;
constexpr float EPS = 1e-6f;

DEVFN float bf2f(bf16_t h) { union { unsigned u; float f; } c; c.u = (unsigned)h << 16; return c.f; }
DEVFN bf16_t f2bf(float f) { union { unsigned u; float f; } c; c.f = f; unsigned u = c.u; u += 0x7fffu + ((u >> 16) & 1u); return (bf16_t)(u >> 16); }
DEVFN float sigmoidf_(float x) { return 1.0f / (1.0f + expf(-x)); }
DEVFN float siluf_(float x) { return x / (1.0f + expf(-x)); }

constexpr size_t al256(size_t x) { return (x + 255) & ~(size_t)255; }
constexpr size_t OFF_CTRL = 0;
constexpr size_t OFF_W0OUT = 65536;
constexpr size_t OFF_W1IN = OFF_W0OUT + al256((size_t)DM * HAWK_OUT * 2);
constexpr size_t OFF_W1OUT = OFF_W1IN + al256((size_t)NSA_INP * DM * 2);
constexpr size_t OFF_PHIW1 = OFF_W1OUT + al256((size_t)DM * NSA_OUT * 2);
constexpr size_t OFF_MEMKV = OFF_PHIW1 + al256((size_t)2 * 256 * 2048 * 2);
constexpr size_t OFF_LSE = OFF_MEMKV + al256((size_t)2 * NB * NMEM * 512 * 2);
constexpr size_t OFF_PEB = OFF_LSE + al256((size_t)3 * T_ * 4 * 4) + 65536;
constexpr size_t OFF_PHIW2 = OFF_LSE + al256((size_t)3 * T_ * 4 * 4);
constexpr size_t OFF_PEBS = OFF_PHIW2 + 65536 + 131072;
constexpr size_t OFF_WMKV = OFF_PEBS + 4096;
constexpr size_t OFF_RA = OFF_WMKV + al256((size_t)2 * 512 * DM * 2);
constexpr size_t RA_BYTES = (size_t)T_ * 1792 * 2;
constexpr size_t OFF_XN = OFF_RA;
constexpr size_t OFF_W0IN = OFF_RA + (size_t)T_ * 1024 * 2;
constexpr size_t OFF_MEMN = OFF_W0IN + (size_t)HAWK_IN * DM * 2;
static_assert(OFF_MEMN + (size_t)NB * NMEM * DM * 2 <= OFF_RA + RA_BYTES, "region A: MEMN");
constexpr size_t OFF_Y0 = OFF_RA;
constexpr size_t OFF_Y1 = OFF_RA;
constexpr size_t OFF_CMPH = OFF_RA + (size_t)T_ * 1280 * 2;
constexpr size_t OFF_CMPKV = OFF_CMPH + al256((size_t)2 * NB * 2 * 128 * 256 * 4);
constexpr size_t OFF_SEL = OFF_CMPKV + al256((size_t)2 * NB * 2 * 128 * 64 * 4);
constexpr size_t OFF_IMP = OFF_SEL + al256((size_t)NB * 2 * SEQ * 4);
static_assert(OFF_W0IN + (size_t)HAWK_IN * DM * 2 <= OFF_RA + RA_BYTES, "region A: XN0 | W0IN");
static_assert(OFF_IMP + (size_t)NB * 2 * SEQ * 32 * 4 <= OFF_RA + RA_BYTES, "region A: layer-1 temporaries");
constexpr size_t OFF_Q = OFF_RA + RA_BYTES;
constexpr size_t OFF_K = OFF_Q + (size_t)T_ * 1536 * 2;
constexpr size_t OFF_V = OFF_K + (size_t)T_ * 1536 * 2;
constexpr size_t OFF_ZB = OFF_V + (size_t)T_ * 1536 * 2;
constexpr size_t OFF_QM = OFF_ZB + (size_t)T_ * 512 * 2;
constexpr size_t OFF_ZM = OFF_QM + (size_t)T_ * 256 * 2;
constexpr size_t WS_END = OFF_ZM + (size_t)T_ * 256 * 2;
constexpr size_t OFF_X1 = OFF_K;
constexpr size_t OFF_Z1 = OFF_K + (size_t)T_ * 1024 * 4;
constexpr size_t OFF_Q1 = OFF_Q;
constexpr size_t OFF_QM1 = OFF_Q + (size_t)T_ * 1024 * 2;
constexpr size_t OFF_ZM1 = OFF_QM1 + (size_t)T_ * 256 * 2;
constexpr size_t OFF_KV1 = OFF_ZB;
constexpr size_t OFF_GATE = OFF_ZM;
static_assert(OFF_Z1 + (size_t)T_ * 1024 * 2 <= OFF_ZB, "Z1 overlay");
static_assert(BATCH_ != 8 || DM_ != 1024 || WS_END <= (size_t)256 * 1024 * 1024, "workspace too big");

struct Params {
    const float *x, *mem, *hawk_norm, *hawk_w_in, *conv_w, *conv_b, *ga_w, *ga_b, *gx_w, *gx_b, *lam, *hawk_mem_norm, *hawk_w_mem_kv, *hawk_w_out;
    const float *nsa_norm, *nsa_w_in, *pe_k, *pe_v, *phik_w1, *phik_w2, *phiv_w1, *phiv_w2, *nsa_mem_norm, *nsa_w_mem_kv, *nsa_w_out, *final_norm;
    float* out; unsigned char* ws;
};

DEVFN int nsa_col_orig(int n) {
    if (n < 1792) return n;
    if (n < 2816) return n - 1792 + 1840;
    if (n < 3072) return n - 2816 + 2864;
    if (n < 3328) return n - 3072 + 3120;
    if (n < 3376) return n - 3328 + 1792;
    return -1;
}

DEVFN void p0_convert(const Params& p, long gt, long nt) {
    bf16_t* w0in = (bf16_t*)(p.ws + OFF_W0IN); bf16_t* w0out = (bf16_t*)(p.ws + OFF_W0OUT);
    bf16_t* w1in = (bf16_t*)(p.ws + OFF_W1IN); bf16_t* w1out = (bf16_t*)(p.ws + OFF_W1OUT); bf16_t* phiw1 = (bf16_t*)(p.ws + OFF_PHIW1);
    for (long i = gt; i < (long)DM * HAWK_IN; i += nt) { const int k = (int)(i / HAWK_IN), n = (int)(i % HAWK_IN); w0in[(size_t)n * DM + k] = f2bf(p.hawk_w_in[i]); }
    for (long i = gt; i < (long)HAWK_OUT * DM; i += nt) { const int k = (int)(i / DM), n = (int)(i % DM); w0out[(size_t)n * HAWK_OUT + k] = f2bf(p.hawk_w_out[i]); }
    for (long i = gt; i < (long)DM * NSA_INP; i += nt) { const int k = (int)(i / NSA_INP), n = (int)(i % NSA_INP); const int no = nsa_col_orig(n);
        w1in[(size_t)n * DM + k] = no >= 0 ? f2bf(p.nsa_w_in[(size_t)k * NSA_IN + no]) : (bf16_t)0; }
    for (long i = gt; i < (long)NSA_OUT * DM; i += nt) { const int k = (int)(i / DM), n = (int)(i % DM); w1out[(size_t)n * NSA_OUT + k] = f2bf(p.nsa_w_out[i]); }
    for (long i = gt; i < (long)2 * 2048 * 256; i += nt) { const int kv = (int)(i / (2048 * 256)), r = (int)(i % (2048 * 256)), k = r / 256, n = r % 256;
        phiw1[(size_t)kv * 256 * 2048 + (size_t)n * 2048 + k] = f2bf((kv ? p.phiv_w1 : p.phik_w1)[r]); }
}
DEVFN void rows_rmsnorm(const float* x, const float* g, bf16_t* xn, long gt, long nt) {
    for (long r = gt; r < T_; r += nt) {
        const float* xr = x + (size_t)r * DM; float ss = 0.f;
        for (int k = 0; k < DM; ++k) ss += xr[k] * xr[k];
        const float rs = 1.0f / sqrtf(ss / DM + EPS);
        for (int k = 0; k < DM; ++k) xn[(size_t)r * DM + k] = f2bf(xr[k] * rs * g[k]);
    }
}
DEVFN void p0_memkv(const Params& p, long gt, long nt) {
    bf16_t* mkv = (bf16_t*)(p.ws + OFF_MEMKV);
    for (long i = gt; i < (long)2 * NB * NMEM * 512; i += nt) {
        const int l = (int)(i / ((long)NB * NMEM * 512)), r = (int)((i / 512) % (NB * NMEM)), c = (int)(i % 512);
        const float* mr = p.mem + (size_t)r * DM; const float* g = l ? p.nsa_mem_norm : p.hawk_mem_norm; const float* w = l ? p.nsa_w_mem_kv : p.hawk_w_mem_kv;
        float ss = 0.f, acc = 0.f;
        for (int k = 0; k < DM; ++k) { const float v = mr[k]; ss += v * v; acc += v * g[k] * w[(size_t)k * 512 + c]; }
        mkv[i] = f2bf(acc / sqrtf(ss / DM + EPS));
    }
}

struct __attribute__((aligned(16))) U4 { unsigned x, y, z, w; };
DEVFN float lo16(unsigned u) { union { unsigned u; float f; } c; c.u = u << 16; return c.f; }
DEVFN float hi16(unsigned u) { union { unsigned u; float f; } c; c.u = u & 0xffff0000u; return c.f; }
DEVFN float dot_bf16(const bf16_t* a, const bf16_t* b, int n) {
    float s0 = 0.f, s1 = 0.f, s2 = 0.f, s3 = 0.f;
    for (int k = 0; k < n; k += 8) { const U4 va = *(const U4*)(a + k), vb = *(const U4*)(b + k);
        s0 += lo16(va.x) * lo16(vb.x) + hi16(va.x) * hi16(vb.x); s1 += lo16(va.y) * lo16(vb.y) + hi16(va.y) * hi16(vb.y);
        s2 += lo16(va.z) * lo16(vb.z) + hi16(va.z) * hi16(vb.z); s3 += lo16(va.w) * lo16(vb.w) + hi16(va.w) * hi16(vb.w); }
    return (s0 + s1) + (s2 + s3);
}

DEVFN void p1_gemm(const Params& p, long gt, long nt) {
    const bf16_t* xn = (const bf16_t*)(p.ws + OFF_XN); const bf16_t* w = (const bf16_t*)(p.ws + OFF_W0IN);
    bf16_t* xaza = (bf16_t*)p.out;
    for (long i = gt; i < (long)T_ * HAWK_IN; i += nt) {
        const int t = (int)(i / HAWK_IN), n = (int)(i % HAWK_IN);
        const bf16_t v = f2bf(dot_bf16(xn + (size_t)t * DM, w + (size_t)n * DM, DM));
        if (n < 2048) xaza[(size_t)t * 2048 + n] = v;
        else if (n < 3584) ((bf16_t*)(p.ws + OFF_Q))[(size_t)t * 1536 + n - 2048] = v;
        else if (n < 5120) ((bf16_t*)(p.ws + OFF_K))[(size_t)t * 1536 + n - 3584] = v;
        else if (n < 6656) ((bf16_t*)(p.ws + OFF_V))[(size_t)t * 1536 + n - 5120] = v;
        else if (n < 7168) ((bf16_t*)(p.ws + OFF_ZB))[(size_t)t * 512 + n - 6656] = v;
        else if (n < 7424) ((bf16_t*)(p.ws + OFF_QM))[(size_t)t * 256 + n - 7168] = v;
        else ((bf16_t*)(p.ws + OFF_ZM))[(size_t)t * 256 + n - 7424] = v;
    }
}

DEVFN void p2_lru(const Params& p, long gt, long nt) {
    const bf16_t* xaza = (const bf16_t*)p.out; bf16_t* Y0 = (bf16_t*)(p.ws + OFF_Y0);
    for (long i = gt; i < (long)NB * 1024; i += nt) {
        const int b = (int)(i / 1024), c = (int)(i % 1024), blk = c >> 6, j = c & 63;
        const float sp = log1pf(expf(-p.lam[c]));
        const float* gaw = p.ga_w + (size_t)blk * 4096; const float* gxw = p.gx_w + (size_t)blk * 4096;
        float h = 0.f;
        for (int t = 0; t < SEQ; ++t) {
            float ra = p.ga_b[c], ri = p.gx_b[c], xcj = 0.f;
            for (int ii = 0; ii < 64; ++ii) {
                const int cc = blk * 64 + ii; float xc = p.conv_b[cc];
                for (int k = 0; k < 4; ++k) { const int tt = t - 3 + k; if (tt >= 0) xc += p.conv_w[k * 1024 + cc] * bf2f(xaza[((size_t)b * SEQ + tt) * 2048 + cc]); }
                ra += xc * gaw[ii * 64 + j]; ri += xc * gxw[ii * 64 + j];
                if (ii == j) xcj = xc;
            }
            const float r = sigmoidf_(ra), ig = sigmoidf_(ri);
            const float log_a = -8.0f * r * sp, a = expf(log_a);
            const float mult = t == 0 ? 1.0f : sqrtf(-expm1f(2.0f * log_a));
            h = a * h + xcj * ig * mult;
            const size_t tt0 = (size_t)b * SEQ + t;
            Y0[tt0 * 1792 + c] = f2bf(h * siluf_(bf2f(xaza[tt0 * 2048 + 1024 + c])));
        }
    }
}
DEVNI void p2_dilated(const Params& p, long gt, long nt) {
    bf16_t* Q = (bf16_t*)(p.ws + OFF_Q); const bf16_t* K = (const bf16_t*)(p.ws + OFF_K); const bf16_t* V = (const bf16_t*)(p.ws + OFF_V);
    float* LSE = (float*)(p.ws + OFF_LSE);
    for (long i = gt; i < (long)T_ * 12; i += nt) {
        const int t = (int)(i / 12), hh = (int)(i % 12), g = hh >> 2, h = hh & 3, s = t % SEQ;
        const int dil = g == 0 ? 1 : (g == 1 ? 4 : 16);
        const float slope = exp2f(-8.0f * (float)(hh + 1) / 12.0f), scale = 0.08838834764831845f;
        bf16_t* qp = Q + (size_t)t * 1536 + hh * 128;
        float o[128], m = -1e30f, l = 0.f;
#pragma unroll
        for (int d = 0; d < 128; ++d) o[d] = 0.f;
        for (int jj = 0; jj <= 128; ++jj) {
            const int sk = s - jj * dil; if (sk < 0) break;
            const bf16_t* kp = K + (size_t)(t - jj * dil) * 1536 + hh * 128; const bf16_t* vp = V + (size_t)(t - jj * dil) * 1536 + hh * 128;
            float sc = 0.f;
#pragma nounroll
            for (int d = 0; d < 128; ++d) sc += bf2f(qp[d]) * bf2f(kp[d]);
            sc = sc * scale - slope * (float)(jj * dil);
            const float mn = fmaxf(m, sc), al = expf(m - mn), pe = expf(sc - mn);
            l = l * al + pe; m = mn;
#pragma unroll
            for (int d = 0; d < 128; ++d) o[d] = o[d] * al + pe * bf2f(vp[d]);
        }
        const float inv = 1.0f / l;
#pragma unroll
        for (int d = 0; d < 128; ++d) qp[d] = f2bf(o[d] * inv);
        LSE[((size_t)g * T_ + t) * 4 + h] = m + logf(l);
    }
}
DEVFN void p2_combine(const Params& p, long gt, long nt) {
    const bf16_t* Q = (const bf16_t*)(p.ws + OFF_Q); const bf16_t* ZB = (const bf16_t*)(p.ws + OFF_ZB); const float* LSE = (const float*)(p.ws + OFF_LSE); bf16_t* Y0 = (bf16_t*)(p.ws + OFF_Y0);
    for (long i = gt; i < (long)T_ * 512; i += nt) {
        const int t = (int)(i / 512), c = (int)(i % 512), h = c >> 7;
        const float l0 = LSE[((size_t)0 * T_ + t) * 4 + h], l1 = LSE[((size_t)1 * T_ + t) * 4 + h], l2 = LSE[((size_t)2 * T_ + t) * 4 + h];
        const float mx = fmaxf(l0, fmaxf(l1, l2)), e0 = expf(l0 - mx), e1 = expf(l1 - mx), e2 = expf(l2 - mx), inv = 1.0f / (e0 + e1 + e2);
        const float o = (e0 * bf2f(Q[(size_t)t * 1536 + c]) + e1 * bf2f(Q[(size_t)t * 1536 + 512 + c]) + e2 * bf2f(Q[(size_t)t * 1536 + 1024 + c])) * inv;
        Y0[(size_t)t * 1792 + 1024 + c] = f2bf(o * siluf_(bf2f(ZB[i])));
    }
}
DEVNI void mem_attn(const bf16_t* mkv, const bf16_t* QMb, const bf16_t* ZMb, bf16_t* Y, int ldy, long gt, long nt) {
    for (long i = gt; i < (long)T_ * 4; i += nt) {
        const int t = (int)(i / 4), h = (int)(i % 4), b = t / SEQ;
        const bf16_t* qp = QMb + (size_t)t * 256 + h * 64;
        float o[64], m = -1e30f, l = 0.f;
#pragma unroll
        for (int d = 0; d < 64; ++d) o[d] = 0.f;
        for (int j = 0; j < NMEM; ++j) {
            const bf16_t* kp = mkv + ((size_t)b * NMEM + j) * 512 + h * 64; const bf16_t* vp = kp + 256;
            float sc = 0.f;
#pragma nounroll
            for (int d = 0; d < 64; ++d) sc += bf2f(qp[d]) * bf2f(kp[d]);
            sc *= 0.125f;
            const float mn = fmaxf(m, sc), al = expf(m - mn), pe = expf(sc - mn);
            l = l * al + pe; m = mn;
#pragma unroll
            for (int d = 0; d < 64; ++d) o[d] = o[d] * al + pe * bf2f(vp[d]);
        }
        const float inv = 1.0f / l;
#pragma unroll
        for (int d = 0; d < 64; ++d) Y[(size_t)t * ldy + h * 64 + d] = f2bf(o[d] * inv * siluf_(bf2f(ZMb[(size_t)t * 256 + h * 64 + d])));
    }
}

DEVFN void p3_gemm(const Params& p, long gt, long nt) {
    const bf16_t* y = (const bf16_t*)(p.ws + OFF_Y0); const bf16_t* w = (const bf16_t*)(p.ws + OFF_W0OUT); float* x1 = (float*)(p.ws + OFF_X1);
    for (long i = gt; i < (long)T_ * DM; i += nt) {
        const int t = (int)(i / DM), n = (int)(i % DM);
        x1[i] = p.x[i] + dot_bf16(y + (size_t)t * HAWK_OUT, w + (size_t)n * HAWK_OUT, HAWK_OUT);
    }
}
DEVFN void p4_gemm(const Params& p, long gt, long nt) {
    const bf16_t* xn = (const bf16_t*)(p.ws + OFF_XN); const bf16_t* w = (const bf16_t*)(p.ws + OFF_W1IN);
    for (long i = gt; i < (long)T_ * NSA_IN; i += nt) {
        const int t = (int)(i / NSA_IN), n = (int)(i % NSA_IN);
        const float a = dot_bf16(xn + (size_t)t * DM, w + (size_t)n * DM, DM); const bf16_t v = f2bf(a);
        if (n < 1024) ((bf16_t*)(p.ws + OFF_Q1))[(size_t)t * 1024 + n] = v;
        else if (n < 1792) ((bf16_t*)(p.ws + OFF_KV1))[(size_t)t * 768 + n - 1024] = v;
        else if (n < 2816) ((bf16_t*)(p.ws + OFF_Z1))[(size_t)t * 1024 + n - 1792] = v;
        else if (n < 3072) ((bf16_t*)(p.ws + OFF_QM1))[(size_t)t * 256 + n - 2816] = v;
        else if (n < 3328) ((bf16_t*)(p.ws + OFF_ZM1))[(size_t)t * 256 + n - 3072] = v;
        else ((bf16_t*)(p.ws + OFF_GATE))[(size_t)t * 256 + n - 3328] = v;
    }
}
DEVFN void p5_cmp1(const Params& p, long gt, long nt) {
    const bf16_t* KV = (const bf16_t*)(p.ws + OFF_KV1); const bf16_t* w1 = (const bf16_t*)(p.ws + OFF_PHIW1); float* hid = (float*)(p.ws + OFF_CMPH);
    for (long i = gt; i < (long)2 * NB * 2 * 127 * 256; i += nt) {
        const int j = (int)(i % 256); long r = i / 256; const int n = (int)(r % 127); r /= 127; const int g = (int)(r % 2); r /= 2; const int b = (int)(r % NB), kv = (int)(r / NB);
        const float* pe = kv ? p.pe_v : p.pe_k; const bf16_t* wj = w1 + ((size_t)kv * 256 + j) * 2048;
        float acc = 0.f;
        for (int ii = 0; ii < 32; ++ii) { const bf16_t* tp = KV + ((size_t)b * SEQ + 16 * n + ii) * 768 + kv * 128 + g * 64;
            for (int d = 0; d < 64; ++d) acc += (bf2f(tp[d]) + pe[ii * 64 + d]) * bf2f(wj[ii * 64 + d]); }
        hid[((((size_t)kv * NB + b) * 2 + g) * 128 + n) * 256 + j] = siluf_(acc);
    }
}
DEVFN void p5_cmp2(const Params& p, long gt, long nt) {
    const float* hid = (const float*)(p.ws + OFF_CMPH); bf16_t* ckv = (bf16_t*)(p.ws + OFF_CMPKV);
    for (long i = gt; i < (long)2 * NB * 2 * 128 * 64; i += nt) {
        const int d = (int)(i % 64); long r = i / 64; const int n = (int)(r % 128); r /= 128; const int g = (int)(r % 2); r /= 2; const int b = (int)(r % NB), kv = (int)(r / NB);
        const float* w2 = kv ? p.phiv_w2 : p.phik_w2; const size_t row = (((size_t)kv * NB + b) * 2 + g) * 128 + n;
        float acc = 0.f;
        if (n < 127) for (int j = 0; j < 256; ++j) acc += hid[row * 256 + j] * w2[j * 64 + d];
        ckv[row * 64 + d] = f2bf(acc);
    }
}
DEVNI void p5_cmp_attn(const Params& p, long gt, long nt) {
    const bf16_t* Q1 = (const bf16_t*)(p.ws + OFF_Q1); const bf16_t* ckv = (const bf16_t*)(p.ws + OFF_CMPKV); const bf16_t* gate = (const bf16_t*)(p.ws + OFF_GATE);
    unsigned* SEL = (unsigned*)(p.ws + OFF_SEL); float* ocmp = p.out; float* IMP = (float*)(p.ws + OFF_IMP);
    for (long i = gt; i < (long)NB * 2 * SEQ; i += nt) {
        const int s = (int)(i % SEQ), g = (int)((i / SEQ) % 2), b = (int)(i / (2 * SEQ)); const int t = b * SEQ + s;
        const bf16_t* kc = ckv + (((size_t)0 * NB + b) * 2 + g) * 128 * 64; const bf16_t* vc = ckv + (((size_t)1 * NB + b) * 2 + g) * 128 * 64;
        const int nvis = s >= 31 ? (s - 31) / 16 + 1 : 0;
        float* imp = IMP + (size_t)i * 32;
        for (int r = 0; r < 8; ++r) {
            const int hidx = g * 8 + r; const float slope = exp2f(-0.5f * (float)(hidx + 1));
            const bf16_t* qp = Q1 + (size_t)t * 1024 + hidx * 64;
            float m = -1e30f;
            for (int n = 0; n < nvis; ++n) { float sc = 0.f;
_Pragma("nounroll") for (int d = 0; d < 64; ++d) sc += bf2f(qp[d]) * bf2f(kc[n * 64 + d]);
                sc = sc * 0.125f - slope * (float)(s - (16 * n + 31)); m = fmaxf(m, sc); }
            float l = 0.f;
            for (int n = 0; n < nvis; ++n) { float sc = 0.f;
_Pragma("nounroll") for (int d = 0; d < 64; ++d) sc += bf2f(qp[d]) * bf2f(kc[n * 64 + d]);
                sc = sc * 0.125f - slope * (float)(s - (16 * n + 31)); l += expf(sc - m); }
            const float inv = nvis > 0 ? 1.0f / l : 0.f;
            float o[64];
#pragma unroll
            for (int d = 0; d < 64; ++d) o[d] = 0.f;
            float carry = 0.f;
            for (int j = 0; j < 32; ++j) {
                float acc = carry; carry = 0.f;
                for (int q4 = 0; q4 < 4; ++q4) { const int n = 4 * j + q4;
                    if (n < nvis) { float sc = 0.f;
_Pragma("nounroll") for (int d = 0; d < 64; ++d) sc += bf2f(qp[d]) * bf2f(kc[n * 64 + d]);
                        sc = sc * 0.125f - slope * (float)(s - (16 * n + 31)); const float pr = expf(sc - m) * inv;
                        acc += pr; if (q4 == 3) carry = pr;
#pragma unroll
                        for (int d = 0; d < 64; ++d) o[d] += pr * bf2f(vc[n * 64 + d]); } }
                imp[j] = (r == 0 ? 0.f : imp[j]) + acc;
            }
            const float g0 = sigmoidf_(bf2f(gate[(size_t)t * 256 + hidx * 3 + 0]));
#pragma unroll
            for (int d = 0; d < 64; ++d) ocmp[(size_t)t * 1024 + hidx * 64 + d] = g0 * o[d];
        }
        const int cur = s >> 6; unsigned mask = 1u | (1u << cur) | (cur > 0 ? (1u << (cur - 1)) : 0u);
        const int nf = cur == 0 ? 1 : (cur == 1 ? 2 : 3), need = 8 - nf;
        for (int j = 1; j < 30; ++j) {
            if (j <= cur - 2) { int rank = 0;
                for (int j2 = 1; j2 < 30; ++j2) if (j2 <= cur - 2 && j2 != j) rank += (imp[j2] > imp[j] || (imp[j2] == imp[j] && j2 < j)) ? 1 : 0;
                if (rank < need) mask |= 1u << j; }
        }
        SEL[i] = mask;
    }
}
DEVNI void p5_slc_win(const Params& p, long gt, long nt) {
    const bf16_t* Q1 = (const bf16_t*)(p.ws + OFF_Q1); const bf16_t* KV = (const bf16_t*)(p.ws + OFF_KV1); const bf16_t* gate = (const bf16_t*)(p.ws + OFF_GATE);
    const unsigned* SEL = (const unsigned*)(p.ws + OFF_SEL); const float* ocmp = p.out; const bf16_t* Z1 = (const bf16_t*)(p.ws + OFF_Z1); bf16_t* Y1 = (bf16_t*)(p.ws + OFF_Y1);
    for (long i = gt; i < (long)T_ * 16; i += nt) {
        const int t = (int)(i / 16), hidx = (int)(i % 16), g = hidx >> 3, b = t / SEQ, s = t % SEQ;
        const float slope = exp2f(-0.5f * (float)(hidx + 1));
        const bf16_t* qp = Q1 + (size_t)t * 1024 + hidx * 64;
        const unsigned mask = SEL[((size_t)b * 2 + g) * SEQ + s];
        float res[64];
        {
            float o[64], m = -1e30f, l = 0.f;
#pragma unroll
            for (int d = 0; d < 64; ++d) o[d] = 0.f;
            for (int j = 0; j < 32; ++j) { if (!((mask >> j) & 1u)) continue;
                for (int kk = 0; kk < 64; ++kk) { const int kpos = j * 64 + kk; if (kpos > s) break;
                    const bf16_t* kp = KV + ((size_t)b * SEQ + kpos) * 768 + 2 * 128 + g * 64; const bf16_t* vp = kp + 128;
                    float sc = 0.f;
#pragma nounroll
                    for (int d = 0; d < 64; ++d) sc += bf2f(qp[d]) * bf2f(kp[d]);
                    sc = sc * 0.125f - slope * (float)(s - kpos);
                    const float mn = fmaxf(m, sc), al = expf(m - mn), pe = expf(sc - mn); l = l * al + pe; m = mn;
#pragma unroll
                    for (int d = 0; d < 64; ++d) o[d] = o[d] * al + pe * bf2f(vp[d]); } }
            const float g1 = sigmoidf_(bf2f(gate[(size_t)t * 256 + hidx * 3 + 1])) / l;
#pragma unroll
            for (int d = 0; d < 64; ++d) res[d] = ocmp[(size_t)t * 1024 + hidx * 64 + d] + g1 * o[d];
        }
        {
            float o[64], m = -1e30f, l = 0.f;
#pragma unroll
            for (int d = 0; d < 64; ++d) o[d] = 0.f;
            for (int kpos = (s - 511 > 0 ? s - 511 : 0); kpos <= s; ++kpos) {
                const bf16_t* kp = KV + ((size_t)b * SEQ + kpos) * 768 + 4 * 128 + g * 64; const bf16_t* vp = kp + 128;
                float sc = 0.f;
#pragma nounroll
                for (int d = 0; d < 64; ++d) sc += bf2f(qp[d]) * bf2f(kp[d]);
                sc = sc * 0.125f - slope * (float)(s - kpos);
                const float mn = fmaxf(m, sc), al = expf(m - mn), pe = expf(sc - mn); l = l * al + pe; m = mn;
#pragma unroll
                for (int d = 0; d < 64; ++d) o[d] = o[d] * al + pe * bf2f(vp[d]); }
            const float g2 = sigmoidf_(bf2f(gate[(size_t)t * 256 + hidx * 3 + 2])) / l;
#pragma unroll
            for (int d = 0; d < 64; ++d) res[d] += g2 * o[d];
        }
#pragma unroll
        for (int d = 0; d < 64; ++d) Y1[(size_t)t * 1280 + hidx * 64 + d] = f2bf(res[d] * siluf_(bf2f(Z1[(size_t)t * 1024 + hidx * 64 + d])));
    }
}
DEVFN void p6_gemm(const Params& p, long gt, long nt) {
    const bf16_t* y = (const bf16_t*)(p.ws + OFF_Y1); const bf16_t* w = (const bf16_t*)(p.ws + OFF_W1OUT); const float* x1 = (const float*)(p.ws + OFF_X1);
    for (long i = gt; i < (long)T_ * DM; i += nt) {
        const int t = (int)(i / DM), n = (int)(i % DM);
        p.out[i] = x1[i] + dot_bf16(y + (size_t)t * NSA_OUT, w + (size_t)n * NSA_OUT, NSA_OUT);
    }
}
DEVFN void p7_final(const Params& p, long gt, long nt) {
    for (long r = gt; r < T_; r += nt) {
        float* xr = p.out + (size_t)r * DM; float ss = 0.f;
        for (int k = 0; k < DM; ++k) ss += xr[k] * xr[k];
        const float rs = 1.0f / sqrtf(ss / DM + EPS);
        for (int k = 0; k < DM; ++k) xr[k] = xr[k] * rs * p.final_norm[k];
    }
}

#ifndef HOST_EMU
static_assert(DM == 1024 && NB == 8, "device build is for the real shapes");
#define LAS __attribute__((address_space(3)))
#define GAS __attribute__((address_space(1)))
typedef unsigned v4u __attribute__((ext_vector_type(4)));
typedef float f32x4 __attribute__((ext_vector_type(4)));
typedef short bf16x8 __attribute__((ext_vector_type(8)));
typedef unsigned v2u __attribute__((ext_vector_type(2)));
#define LDS_WAIT() asm volatile("s_waitcnt lgkmcnt(0)" ::: "memory")
#define VM_WAIT() asm volatile("s_waitcnt vmcnt(0)" ::: "memory")
__device__ __forceinline__ unsigned pk2(float lo, float hi) { return (unsigned)f2bf(lo) | ((unsigned)f2bf(hi) << 16); }

__device__ __forceinline__ int fresh_tid();
namespace pg8 {
constexpr int BM = 256, BK = 64, HALF = 128, HTB = HALF * BK * 2  , STAGE_BYTES = 8 * HTB, NXCD = 8, WGM = 8;
__host__ __device__ __forceinline__ int lds_byte(int r, int c) { const int st = (r >> 4) * 2 + (c >> 5), rr = r & 15, cc = c & 31, ob = rr * 64 + cc * 2; return st * 1024 + (ob ^ (((ob >> 9) & 1) << 5)); }
__host__ __device__ __forceinline__ void stage_rc(int b, int& R, int& C) { const int st = b / 1024, sb = b % 1024, swz = sb ^ (((sb >> 9) & 1) << 5); R = (st >> 1) * 16 + swz / 64; C = (st & 1) * 32 + (swz % 64) / 2; }
__host__ __device__ __forceinline__ int perm32(int rho) { const int n = rho >> 4, i = rho & 15; return 8 * (i >> 2) + 4 * n + (i & 3); }
struct Unit { int pm, pn, tag; const char* A; const char* B; };
struct Gemm { int K, lda, ldb, kstepA, kstepB; };
struct StaticOrder {
    int nM, nN, nwg, G, c, K; const char* A; const char* B; int nE, nNe; const char* Ae; const char* Be;
    __host__ __device__ void init(const bf16_t* A_, const bf16_t* B_, int M, int N, int K_, int G_, int c_) { A = (const char*)A_; B = (const char*)B_; K = K_; nM = M / BM; nN = N / BM; nwg = nM * nN; G = G_; c = c_; nE = 0; nNe = 1; Ae = Be = nullptr; }
    __host__ __device__ void extra(const bf16_t* A_, const bf16_t* B_, int M, int N) { Ae = (const char*)A_; Be = (const char*)B_; nNe = N / BM; nE = (M / BM) * nNe; }
    __host__ __device__ bool next(int i, Unit& u) const {
        const long L = (long)i * G + c; const size_t tstep = (size_t)BM * K * 2;
        if (L >= nwg) { const long e = L - nwg; if (e >= nE) return false; u.pm = (int)(e / nNe); u.pn = (int)(e % nNe); u.tag = 1; u.A = Ae + (size_t)u.pm * tstep; u.B = Be + (size_t)u.pn * tstep; return true; }
        int wgid = (int)L; { const int q = nwg / NXCD, r = nwg % NXCD, xcd = wgid % NXCD, off = wgid / NXCD; wgid = (xcd < r ? xcd * (q + 1) : r * (q + 1) + (xcd - r) * q) + off; }
        const int nig = WGM * nN, gid = wgid / nig, fm = gid * WGM, gsz = (nM - fm) < WGM ? (nM - fm) : WGM;
        u.pm = fm + ((wgid % nig) % gsz); u.pn = (wgid % nig) / gsz; u.tag = 0; u.A = A + (size_t)u.pm * tstep; u.B = B + (size_t)u.pn * tstep; return true;
    }
    __device__ __forceinline__ void a_ready(const Unit&) const {}
    __device__ __forceinline__ void done(const Unit&) const {}
};
struct OneUnit {
    Unit u; bool have;
    __host__ __device__ bool next(int i, Unit& o) const { if (i != 0 || !have) return false; o = u; return true; }
    __device__ __forceinline__ void a_ready(const Unit&) const {}
    __device__ __forceinline__ void done(const Unit&) const {}
};
typedef __bf16 bf16x2_t __attribute__((ext_vector_type(2)));
__device__ __forceinline__ unsigned cvt_pk_bf16(float lo, float hi) { const bf16x2_t v = {(__bf16)lo, (__bf16)hi}; return __builtin_bit_cast(unsigned, v); }

struct EpiRoute {
    static constexpr bool PERM = true, AFTER_DRAIN = false;
    unsigned char* ws; bf16_t* xaza; int layer;
    __device__ __forceinline__ void operator()(const f32x4 (&acc)[2][2][4][2], const Unit& u, int wr, int wc, int fr, int fq) const {
        bf16_t* base; int ldc, colt; const int pn = u.pn;
        if (u.tag == 1) { base = (bf16_t*)(ws + OFF_MEMKV) + (size_t)(pn >> 1) * NB * NMEM * 512; ldc = 512; colt = (pn & 1) * 256; }
        else if (layer == 0) {
            if (pn < 8) { base = xaza; ldc = 2048; colt = pn * 256; }
            else if (pn < 14) { base = (bf16_t*)(ws + OFF_Q); ldc = 1536; colt = (pn - 8) * 256; }
            else if (pn < 20) { base = (bf16_t*)(ws + OFF_K); ldc = 1536; colt = (pn - 14) * 256; }
            else if (pn < 26) { base = (bf16_t*)(ws + OFF_V); ldc = 1536; colt = (pn - 20) * 256; }
            else if (pn < 28) { base = (bf16_t*)(ws + OFF_ZB); ldc = 512; colt = (pn - 26) * 256; }
            else if (pn < 29) { base = (bf16_t*)(ws + OFF_QM); ldc = 256; colt = 0; }
            else { base = (bf16_t*)(ws + OFF_ZM); ldc = 256; colt = 0; }
        } else {
            if (pn < 4) { base = (bf16_t*)(ws + OFF_Q1); ldc = 1024; colt = pn * 256; }
            else if (pn < 7) { base = (bf16_t*)(ws + OFF_KV1); ldc = 768; colt = (pn - 4) * 256; }
            else if (pn < 11) { base = (bf16_t*)(ws + OFF_Z1); ldc = 1024; colt = (pn - 7) * 256; }
            else if (pn < 12) { base = (bf16_t*)(ws + OFF_QM1); ldc = 256; colt = 0; }
            else if (pn < 13) { base = (bf16_t*)(ws + OFF_ZM1); ldc = 256; colt = 0; }
            else { base = (bf16_t*)(ws + OFF_GATE); ldc = 256; colt = 0; }
        }
        const int row0 = u.pm * BM + wr * 64 + fr, col0 = colt + wc * 32 + 8 * fq;
#pragma unroll
        for (int ai = 0; ai < 2; ++ai)
#pragma unroll
            for (int m = 0; m < 4; ++m) { bf16_t* rowp = base + (size_t)(row0 + ai * HALF + m * 16) * ldc + col0;
#pragma unroll
                for (int bj = 0; bj < 2; ++bj) { const f32x4 v0 = acc[ai][bj][m][0], v1 = acc[ai][bj][m][1];
                    v4u w; w.x = cvt_pk_bf16(v0[0], v0[1]); w.y = cvt_pk_bf16(v0[2], v0[3]); w.z = cvt_pk_bf16(v1[0], v1[1]); w.w = cvt_pk_bf16(v1[2], v1[3]);
                    *(v4u*)(rowp + bj * HALF) = w; } }
    }
};
struct EpiResid {
    static constexpr bool PERM = false, AFTER_DRAIN = false;
    const float* base; float* out; int ldc;
    __device__ __forceinline__ void operator()(const f32x4 (&acc)[2][2][4][2], const Unit& u, int wr, int wc, int fr, int fq) const {
        const int col0 = u.pn * BM + wc * 32 + 4 * fq;
#pragma unroll
        for (int ai = 0; ai < 2; ++ai)
#pragma unroll
            for (int m = 0; m < 4; ++m) { const size_t off = (size_t)(u.pm * BM + ai * HALF + wr * 64 + m * 16 + fr) * ldc + col0;
#pragma unroll
                for (int bj = 0; bj < 2; ++bj)
#pragma unroll
                    for (int n = 0; n < 2; ++n) { const f32x4 bs = *(const f32x4*)(base + off + bj * HALF + n * 16); *(f32x4*)(out + off + bj * HALF + n * 16) = bs + acc[ai][bj][m][n]; } }
    }
};

struct EpiResidNorm {
    static constexpr bool PERM = false, AFTER_DRAIN = true;
    const float* base; float* outx; float* outn; bf16_t* xn; const float* gain; int ldc; float* xb; unsigned* cnt;
    __device__ __forceinline__ void fused(f32x4 (&acc)[2][2][4][2], const Unit& u, int wr, int wc, int fr, int fq, LAS unsigned char* lds, int wid, int lane) const {
        LAS float* P = (LAS float*)lds; LAS float* S = (LAS float*)(lds + 4096);
        const int col0 = u.pn * BM + wc * 32 + 4 * fq, tid = wid * 64 + lane;
#pragma unroll
        for (int ai = 0; ai < 2; ++ai)
#pragma unroll
            for (int m = 0; m < 4; ++m) { const int rl = ai * HALF + wr * 64 + m * 16 + fr; const size_t off = (size_t)(u.pm * BM + rl) * ldc + col0; float ss = 0.f;
#pragma unroll
                for (int bj = 0; bj < 2; ++bj)
#pragma unroll
                    for (int n = 0; n < 2; ++n) { const f32x4 v = *(const f32x4*)(base + off + bj * HALF + n * 16) + acc[ai][bj][m][n]; acc[ai][bj][m][n] = v;
                        if (outx) *(f32x4*)(outx + off + bj * HALF + n * 16) = v;
                        ss += (v[0] * v[0] + v[1] * v[1]) + (v[2] * v[2] + v[3] * v[3]); }
                ss += __shfl_xor(ss, 16); ss += __shfl_xor(ss, 32);
                if (fq == 0) P[rl * 4 + wc] = ss; }
        asm volatile("s_waitcnt lgkmcnt(0)" ::: "memory"); __builtin_amdgcn_s_barrier(); asm volatile("" ::: "memory");
        if (tid < 256) { const float t = (P[tid * 4] + P[tid * 4 + 1]) + (P[tid * 4 + 2] + P[tid * 4 + 3]);
            __hip_atomic_store((unsigned*)xb + ((size_t)(u.pm * BM + tid) * 4 + u.pn), __float_as_uint(t), __ATOMIC_RELAXED, __HIP_MEMORY_SCOPE_AGENT); }
        asm volatile("s_waitcnt vmcnt(0)" ::: "memory");
        if (tid < 256 && lane == 0) __hip_atomic_fetch_add(cnt + 64 * u.pm, 1u, __ATOMIC_RELAXED, __HIP_MEMORY_SCOPE_AGENT);
        if (wid == 0) { unsigned sp = 0;
            while ((unsigned)__builtin_amdgcn_readfirstlane(__hip_atomic_load(cnt + 64 * u.pm, __ATOMIC_RELAXED, __HIP_MEMORY_SCOPE_AGENT)) < 16u) { __builtin_amdgcn_s_sleep(2); if (++sp > (1u << 20)) break; }
            __builtin_amdgcn_fence(__ATOMIC_ACQUIRE, "agent"); }
        asm volatile("s_waitcnt vmcnt(0) lgkmcnt(0)" ::: "memory"); __builtin_amdgcn_s_barrier(); asm volatile("" ::: "memory");
        if (tid < 256) { const unsigned* q = (const unsigned*)xb + (size_t)(u.pm * BM + tid) * 4; float t = 0.f;
#pragma unroll
            for (int k = 0; k < 4; ++k) t += __uint_as_float(__hip_atomic_load(q + k, __ATOMIC_RELAXED, __HIP_MEMORY_SCOPE_AGENT));
            S[tid] = 1.0f / sqrtf(t * (1.0f / 1024.0f) + 1e-6f); }
        asm volatile("s_waitcnt vmcnt(0) lgkmcnt(0)" ::: "memory"); __builtin_amdgcn_s_barrier(); asm volatile("" ::: "memory");
        f32x4 gv[2][2];
#pragma unroll
        for (int bj = 0; bj < 2; ++bj)
#pragma unroll
            for (int n = 0; n < 2; ++n) gv[bj][n] = *(const f32x4*)(gain + col0 + bj * HALF + n * 16);
#pragma unroll
        for (int ai = 0; ai < 2; ++ai)
#pragma unroll
            for (int m = 0; m < 4; ++m) { const int rl = ai * HALF + wr * 64 + m * 16 + fr; const size_t off = (size_t)(u.pm * BM + rl) * ldc + col0; const float rs = S[rl];
#pragma unroll
                for (int bj = 0; bj < 2; ++bj)
#pragma unroll
                    for (int n = 0; n < 2; ++n) { const f32x4 o = acc[ai][bj][m][n] * rs * gv[bj][n];
                        if (outn) *(f32x4*)(outn + off + bj * HALF + n * 16) = o;
                        if (xn) { v2u w; w.x = cvt_pk_bf16(o[0], o[1]); w.y = cvt_pk_bf16(o[2], o[3]); *(v2u*)(xn + off + bj * HALF + n * 16) = w; } } }
    }
};
struct EpiCmp1 {
    static constexpr bool PERM = true, AFTER_DRAIN = false;
    bf16_t* hid; const float* peb;
    __device__ __forceinline__ void operator()(const f32x4 (&acc)[2][2][4][2], const Unit& u, int wr, int wc, int fr, int fq) const {
        const int kv = u.tag >> 1, g = u.tag & 1, col0 = wc * 32 + 8 * fq;
        float pb[2][8];
#pragma unroll
        for (int bj = 0; bj < 2; ++bj)
#pragma unroll
            for (int e = 0; e < 8; ++e) pb[bj][e] = peb[kv * 256 + bj * HALF + col0 + e];
#pragma unroll
        for (int ai = 0; ai < 2; ++ai)
#pragma unroll
            for (int m = 0; m < 4; ++m) { const int rp = u.pm * BM + ai * HALF + wr * 64 + m * 16 + fr, b = rp >> 7, n = rp & 127;
                bf16_t* rowp = hid + ((((size_t)kv * NB + b) * 2 + g) * 128 + n) * 256 + col0;
#pragma unroll
                for (int bj = 0; bj < 2; ++bj) { float v[8];
#pragma unroll
                    for (int e = 0; e < 4; ++e) { v[e] = acc[ai][bj][m][0][e] + pb[bj][e]; v[4 + e] = acc[ai][bj][m][1][e] + pb[bj][4 + e]; }
#pragma unroll
                    for (int e = 0; e < 8; ++e) v[e] = v[e] * __builtin_amdgcn_rcpf(1.0f + __builtin_amdgcn_exp2f(-v[e] * 1.4426950408889634f));
                    v4u w; w.x = cvt_pk_bf16(v[0], v[1]); w.y = cvt_pk_bf16(v[2], v[3]); w.z = cvt_pk_bf16(v[4], v[5]); w.w = cvt_pk_bf16(v[6], v[7]);
                    *(v4u*)(rowp + bj * HALF) = w; } }
    }
};

template <class Epi, class Sched, bool ALIGN_EPI = false, bool SP2 = false>
__device__ __forceinline__ void gemm_phase(LAS unsigned char* lds, const Gemm g, const Sched& S, const Epi& E) {
    const int tid = fresh_tid(), wid = __builtin_amdgcn_readfirstlane(tid >> 6), lane = tid & 63, wr = wid >> 2, wc = wid & 3, fr = lane & 15, fq = lane >> 4;
    const int K = g.K, nt = K / BK;
    unsigned voffA[2], voffB[2];
#pragma unroll
    for (int i = 0; i < 2; ++i) { int R, C; stage_rc(tid * 16 + i * 8192, R, C); const int Rb = Epi::PERM ? ((R & ~31) + perm32(R & 31)) : R;
        voffA[i] = (unsigned)(R * g.lda + C) * 2u; voffB[i] = (unsigned)(Rb * g.ldb + C) * 2u; }
    const size_t kstepA = (size_t)g.kstepA, kstepB = (size_t)g.kstepB;
    const size_t hstepA = (size_t)HALF * g.lda * 2, hstepB = (size_t)HALF * g.ldb * 2;
    const unsigned ldsw = (unsigned)wid * 1024u;
    const int aoff = lds_byte(wr * 64 + fr, fq * 8), boff = lds_byte(wc * 32 + fr, fq * 8);
#define PG8_SA(b, h) (((b) * 2 + (h)) * HTB)
#define PG8_SB(b, h) ((4 + (b) * 2 + (h)) * HTB)
#define PG8_STAGE(bufoff, gbase, voff) do { _Pragma("unroll") for (int _i = 0; _i < 2; ++_i) \
        __builtin_amdgcn_global_load_lds((const unsigned*)((const char*)(gbase) + (voff)[_i]), (LAS unsigned*)(lds + (bufoff) + ldsw + _i * 8192), 16, 0, 0); } while (0)
#define PG8_LDA(dst, b, h) do { _Pragma("unroll") for (int m = 0; m < 4; ++m) _Pragma("unroll") for (int k = 0; k < 2; ++k) dst[m][k] = *(const LAS bf16x8*)(lds + PG8_SA(b, h) + aoff + m * 2048 + k * 1024); } while (0)
#define PG8_LDB(dst, b, h) do { _Pragma("unroll") for (int n = 0; n < 2; ++n) _Pragma("unroll") for (int k = 0; k < 2; ++k) dst[n][k] = *(const LAS bf16x8*)(lds + PG8_SB(b, h) + boff + n * 2048 + k * 1024); } while (0)
#define PG8_MMA(ai, bj, At, Bt) do { __builtin_amdgcn_s_setprio(1); _Pragma("unroll") for (int m = 0; m < 4; ++m) _Pragma("unroll") for (int n = 0; n < 2; ++n) _Pragma("unroll") for (int k = 0; k < 2; ++k) \
        acc[ai][bj][m][n] = __builtin_amdgcn_mfma_f32_16x16x32_bf16(Bt[n][k], At[m][k], acc[ai][bj][m][n], 0, 0, 0); __builtin_amdgcn_s_setprio(0); } while (0)
#define PG8_WAIT_V(n) asm volatile("s_waitcnt vmcnt(" #n ")" ::: "memory")
#define PG8_WAIT_L(n) asm volatile("s_waitcnt lgkmcnt(" #n ")" ::: "memory")
#define PG8_BAR __builtin_amdgcn_s_barrier()
#define PG8_SCHED __builtin_amdgcn_sched_barrier(0)
    Unit cur, nxt; int ui = 0;
    if (!S.next(0, cur)) return;
    f32x4 acc[2][2][4][2];
#pragma unroll
    for (int a = 0; a < 2; ++a)
#pragma unroll
        for (int b = 0; b < 2; ++b)
#pragma unroll
            for (int m = 0; m < 4; ++m)
#pragma unroll
                for (int n = 0; n < 2; ++n) acc[a][b][m][n] = (f32x4){0.f, 0.f, 0.f, 0.f};
    bf16x8 At[4][2], B0[2][2], B1[2][2];
    const char* cA = cur.A; const char* cB = cur.B;
    S.a_ready(cur);
    static_assert(SP2, "only the two-super-phase loop is kept in this file");
    {
        PG8_STAGE(PG8_SB(0, 0), cB, voffB); PG8_STAGE(PG8_SB(0, 1), cB + hstepB, voffB); PG8_STAGE(PG8_SA(0, 0), cA, voffA); PG8_STAGE(PG8_SA(0, 1), cA + hstepA, voffA);
        if (wr == 1) PG8_BAR;
        PG8_WAIT_V(2); PG8_BAR;
        PG8_STAGE(PG8_SB(1, 0), cB + kstepB, voffB); PG8_STAGE(PG8_SA(1, 0), cA + kstepA, voffA); PG8_STAGE(PG8_SB(1, 1), cB + hstepB + kstepB, voffB);
        PG8_WAIT_V(6); PG8_BAR;
    }
    for (;;) {
        const bool has_next = S.next(ui + 1, nxt);
        const char* nA = has_next ? nxt.A : cA; const char* nB = has_next ? nxt.B : cB;
        for (int t = 0; t < nt; t += 2) {
            const bool last = (t == nt - 2);
            const char* a1 = cA + (size_t)(t + 1) * kstepA;
            const char* a2 = last ? nA : cA + (size_t)(t + 2) * kstepA; const char* b2 = last ? nB : cB + (size_t)(t + 2) * kstepB;
            const char* a3 = a2 + kstepA; const char* b3 = b2 + kstepB;
            if (last && has_next) S.a_ready(nxt);
            PG8_LDB(B0, 0, 0); PG8_LDB(B1, 0, 1); PG8_SCHED; PG8_LDA(At, 0, 0); PG8_STAGE(PG8_SA(1, 1), a1 + hstepA, voffA);
            PG8_WAIT_V(8); PG8_WAIT_L(0); PG8_BAR; PG8_MMA(0, 0, At, B0); PG8_MMA(0, 1, At, B1); PG8_BAR; PG8_SCHED;
            PG8_LDA(At, 0, 1); PG8_STAGE(PG8_SB(0, 0), b2, voffB); PG8_STAGE(PG8_SB(0, 1), b2 + hstepB, voffB); PG8_STAGE(PG8_SA(0, 0), a2, voffA);
            PG8_WAIT_V(8); PG8_WAIT_L(0); PG8_BAR; PG8_MMA(1, 0, At, B0); PG8_MMA(1, 1, At, B1); PG8_BAR; PG8_SCHED;
            PG8_LDB(B0, 1, 0); PG8_LDB(B1, 1, 1); PG8_SCHED; PG8_LDA(At, 1, 0); PG8_STAGE(PG8_SA(0, 1), a2 + hstepA, voffA);
            PG8_WAIT_V(8); PG8_WAIT_L(0); PG8_BAR; PG8_MMA(0, 0, At, B0); PG8_MMA(0, 1, At, B1); PG8_BAR; PG8_SCHED;
            PG8_LDA(At, 1, 1); PG8_STAGE(PG8_SB(1, 0), b3, voffB); PG8_STAGE(PG8_SB(1, 1), b3 + hstepB, voffB); PG8_STAGE(PG8_SA(1, 0), a3, voffA);
            PG8_WAIT_V(8); PG8_WAIT_L(0); PG8_BAR; PG8_MMA(1, 0, At, B0); PG8_MMA(1, 1, At, B1); PG8_BAR; PG8_SCHED;
        }
        if constexpr (ALIGN_EPI) { if (wr == 0) PG8_BAR; }
        if constexpr (!Epi::AFTER_DRAIN) { E(acc, cur, wr, wc, fr, fq); S.done(cur); }
        if (!has_next) break;
#pragma unroll
        for (int a = 0; a < 2; ++a)
#pragma unroll
            for (int b = 0; b < 2; ++b)
#pragma unroll
                for (int m = 0; m < 4; ++m)
#pragma unroll
                    for (int n = 0; n < 2; ++n) acc[a][b][m][n] = (f32x4){0.f, 0.f, 0.f, 0.f};
        cur = nxt; cA = nA; cB = nB; ++ui;
        if constexpr (ALIGN_EPI) { if (wr == 1) PG8_BAR; }
    }
    PG8_WAIT_V(0);
    if constexpr (!ALIGN_EPI) { if (wr == 0) PG8_BAR; }
    PG8_BAR;
    if constexpr (Epi::AFTER_DRAIN) { E.fused(acc, cur, wr, wc, fr, fq, lds, wid, lane); S.done(cur); }
#undef PG8_SA
#undef PG8_SB
#undef PG8_STAGE
#undef PG8_LDA
#undef PG8_LDB
#undef PG8_MMA
#undef PG8_WAIT_V
#undef PG8_WAIT_L
#undef PG8_BAR
#undef PG8_SCHED
}
}

constexpr int NWAVES = 8, LDS_BYTES = 147456;
__device__ __forceinline__ float wave_sum(float v) {
#pragma unroll
    for (int o = 1; o < 64; o <<= 1) v += __shfl_xor(v, o);
    return v;
}
template <bool PERM>
__device__ __forceinline__ void p0_transpose_item(const float* W, int K, int N, int NP, bf16_t* WT, LAS float* scr, int item, int lane, const float* ksc = nullptr) {
    const int nblk = NP / 32, kb = item / nblk, nb = item % nblk, k0 = 64 * kb, n0 = 32 * nb;
    int ncol = n0 + (lane & 7) * 4; if (PERM) ncol = nsa_col_orig(ncol);
    f32x4 v[8];
#pragma unroll
    for (int i = 0; i < 8; ++i) { const int kk = 8 * i + (lane >> 3); v[i] = ncol >= 0 ? *(const f32x4*)(W + (size_t)(k0 + kk) * N + ncol) : (f32x4){0.f, 0.f, 0.f, 0.f}; if (ksc) v[i] = v[i] * ksc[k0 + kk]; }
#pragma unroll
    for (int i = 0; i < 8; ++i) { const int kk = 8 * i + (lane >> 3); LAS float* d = scr + kk * 33 + (lane & 7) * 4; d[0] = v[i][0]; d[1] = v[i][1]; d[2] = v[i][2]; d[3] = v[i][3]; }
    LDS_WAIT(); asm volatile("" ::: "memory");
    const int c = lane & 7;
#pragma unroll
    for (int j = 0; j < 4; ++j) { const int n = (lane >> 3) + 8 * j; const LAS float* s = scr + (8 * c) * 33 + n;
        v4u o; o.x = pk2(s[0 * 33], s[1 * 33]); o.y = pk2(s[2 * 33], s[3 * 33]); o.z = pk2(s[4 * 33], s[5 * 33]); o.w = pk2(s[6 * 33], s[7 * 33]);
        *(v4u*)(WT + (size_t)(n0 + n) * K + k0 + 8 * c) = o; }
    LDS_WAIT(); asm volatile("" ::: "memory");
}
__device__ __forceinline__ void rms_row_to_bf16(const float* xrow, const float* g, bf16_t* orow, int lane) {
    const f32x4* xr = (const f32x4*)xrow + lane; const f32x4* gr = (const f32x4*)g + lane;
    f32x4 v[4]; float s = 0.f;
#pragma unroll
    for (int j = 0; j < 4; ++j) { v[j] = xr[64 * j]; s += (v[j].x * v[j].x + v[j].y * v[j].y) + (v[j].z * v[j].z + v[j].w * v[j].w); }
    const float rs = 1.f / sqrtf(wave_sum(s) * (1.f / 1024.f) + EPS);
    unsigned long long* o8 = (unsigned long long*)orow + lane;
#pragma unroll
    for (int j = 0; j < 4; ++j) { const f32x4 gg = g ? gr[64 * j] : (f32x4){1.f, 1.f, 1.f, 1.f};
        o8[64 * j] = (unsigned long long)pk2(v[j].x * rs * gg.x, v[j].y * rs * gg.y) | ((unsigned long long)pk2(v[j].z * rs * gg.z, v[j].w * rs * gg.w) << 32); }
}
__device__ __forceinline__ void rms_rows4_to_bf16(const float* x, const float* g, bf16_t* o, int m0, int stride, int nrows, int lane) {
    f32x4 v[4][4];
#pragma unroll
    for (int k = 0; k < 4; ++k) { const int m = m0 + k * stride; if (m < nrows) {
#pragma unroll
        for (int j = 0; j < 4; ++j) v[k][j] = ((const f32x4*)(x + (size_t)m * 1024) + lane)[64 * j]; } }
    f32x4 gg[4];
#pragma unroll
    for (int j = 0; j < 4; ++j) gg[j] = g ? ((const f32x4*)g + lane)[64 * j] : (f32x4){1.f, 1.f, 1.f, 1.f};
#pragma unroll
    for (int k = 0; k < 4; ++k) { const int m = m0 + k * stride; if (m < nrows) { float s = 0.f;
#pragma unroll
        for (int j = 0; j < 4; ++j) s += (v[k][j].x * v[k][j].x + v[k][j].y * v[k][j].y) + (v[k][j].z * v[k][j].z + v[k][j].w * v[k][j].w);
        const float rs = 1.f / sqrtf(wave_sum(s) * (1.f / 1024.f) + EPS);
        unsigned long long* o8 = (unsigned long long*)(o + (size_t)m * 1024) + lane;
#pragma unroll
        for (int j = 0; j < 4; ++j) o8[64 * j] = (unsigned long long)pk2(v[k][j].x * rs * gg[j].x, v[k][j].y * rs * gg[j].y) | ((unsigned long long)pk2(v[k][j].z * rs * gg[j].z, v[k][j].w * rs * gg[j].w) << 32); } }
}
__device__ __forceinline__ void rms_row_inplace(float* xrow, const float* g, int lane) {
    f32x4* xr = (f32x4*)xrow + lane; const f32x4* gr = (const f32x4*)g + lane;
    f32x4 v[4]; float s = 0.f;
#pragma unroll
    for (int j = 0; j < 4; ++j) { v[j] = xr[64 * j]; s += (v[j].x * v[j].x + v[j].y * v[j].y) + (v[j].z * v[j].z + v[j].w * v[j].w); }
    const float rs = 1.f / sqrtf(wave_sum(s) * (1.f / 1024.f) + EPS);
#pragma unroll
    for (int j = 0; j < 4; ++j) xr[64 * j] = v[j] * rs * gr[64 * j];
}

typedef float f32x16 __attribute__((ext_vector_type(16)));
typedef short s16x4 __attribute__((ext_vector_type(4)));
typedef short v4i16_t __attribute__((ext_vector_type(4)));
#define MFMA32(a, b, c) __builtin_amdgcn_mfma_f32_32x32x16_bf16(a, b, c, 0, 0, 0)
constexpr float LOG2E = 1.4426950408889634f, LN2 = 0.6931471805599453f;
__device__ __forceinline__ int crow(int r, int hi) { return (r & 3) + 8 * (r >> 2) + 4 * hi; }
__device__ __forceinline__ s16x4 vtr(const LAS unsigned char* p) { return __builtin_bit_cast(s16x4, __builtin_amdgcn_ds_read_tr16_b64_v4i16((LAS v4i16_t*)p)); }
__device__ __forceinline__ float xmax32(float v) { auto rr = __builtin_amdgcn_permlane32_swap(__float_as_uint(v), __float_as_uint(v), false, false); return fmaxf(__uint_as_float(rr[0]), __uint_as_float(rr[1])); }
__device__ __forceinline__ float xsum32(float v) { auto rr = __builtin_amdgcn_permlane32_swap(__float_as_uint(v), __float_as_uint(v), false, false); return __uint_as_float(rr[0]) + __uint_as_float(rr[1]); }
__device__ __forceinline__ float ex2(float x) { return __builtin_amdgcn_exp2f(x); }
__device__ __forceinline__ float sigm_(float x) { return __builtin_amdgcn_rcpf(1.0f + ex2(-x * LOG2E)); }
__device__ __forceinline__ bf16x8 pack8(const f32x16& v, int r0) {
    v4u w; w.x = pg8::cvt_pk_bf16(v[r0], v[r0 + 1]); w.y = pg8::cvt_pk_bf16(v[r0 + 2], v[r0 + 3]); w.z = pg8::cvt_pk_bf16(v[r0 + 4], v[r0 + 5]); w.w = pg8::cvt_pk_bf16(v[r0 + 6], v[r0 + 7]);
    return __builtin_bit_cast(bf16x8, w);
}
__device__ __forceinline__ bf16x8 vfrag(const LAS unsigned char* p) { const s16x4 a = vtr(p), b = vtr(p + 512); return (bf16x8){a[0], a[1], a[2], a[3], b[0], b[1], b[2], b[3]}; }

struct KVRegs { v4u k, v; };
__device__ __forceinline__ KVRegs kv_load(const bf16_t* Kg, const bf16_t* Vg, int ld, int tid) {
    const int key = (tid & 7) + 8 * (tid >> 6), ch = (tid >> 3) & 7;
    KVRegs r; r.k = *(const v4u*)(Kg + (size_t)key * ld + ch * 8); r.v = *(const v4u*)(Vg + (size_t)key * ld + ch * 8); return r;
}
__device__ __forceinline__ void kv_store(LAS unsigned char* buf, const KVRegs& r, int tid) {
    const int key = (tid & 7) + 8 * (tid >> 6), ch = (tid >> 3) & 7;
    *(LAS v4u*)(buf + ch * 1024 + key * 16) = r.k;
    *(LAS v4u*)(buf + 8192 + (ch >> 2) * 4096 + key * 64 + (ch & 3) * 16) = r.v;
}
struct Sm64 { f32x16 o[2]; float m, l; };
__device__ __forceinline__ void sm64_init(Sm64& st) {
#pragma unroll
    for (int r = 0; r < 16; ++r) { st.o[0][r] = 0.f; st.o[1][r] = 0.f; }
    st.m = -1e30f; st.l = 0.f;
}
__device__ __forceinline__ void qk64(f32x16& s0, f32x16& s1, const bf16x8 (&qf)[4], const LAS unsigned char* buf, int r32, int hi, float kbs = 0.f) {
    const LAS unsigned char* kp = buf + hi * 1024 + r32 * 16;
    const float kbh = kbs * (float)(4 * hi);
#pragma unroll
    for (int r = 0; r < 16; ++r) { s0[r] = fmaf(kbs, (float)((r & 3) + 8 * (r >> 2)), kbh); s1[r] = s0[r]; }
#pragma unroll
    for (int d0 = 0; d0 < 4; ++d0) { const bf16x8 k0 = *(const LAS bf16x8*)(kp + d0 * 2048), k1 = *(const LAS bf16x8*)(kp + d0 * 2048 + 512);
        s0 = MFMA32(k0, qf[d0], s0); s1 = MFMA32(k1, qf[d0], s1); }
}
__device__ __forceinline__ void pv64(f32x16 (&o)[2], const f32x16& p0, const f32x16& p1, const LAS unsigned char* buf, int lane, int hi) {
    const bf16x8 pf0 = pack8(p0, 0), pf1 = pack8(p0, 8), pf2 = pack8(p1, 0), pf3 = pack8(p1, 8);
    const LAS unsigned char* vp = buf + 8192 + ((lane >> 4) & 1) * 32 + (lane & 3) * 8 + (4 * hi + ((lane & 15) >> 2)) * 64;
#pragma unroll
    for (int dt = 0; dt < 2; ++dt) {
        o[dt] = MFMA32(vfrag(vp + dt * 4096), pf0, o[dt]); o[dt] = MFMA32(vfrag(vp + dt * 4096 + 1024), pf1, o[dt]);
        o[dt] = MFMA32(vfrag(vp + dt * 4096 + 2048), pf2, o[dt]); o[dt] = MFMA32(vfrag(vp + dt * 4096 + 3072), pf3, o[dt]);
    }
}
typedef float f32x2 __attribute__((ext_vector_type(2)));
template <int MODE>
__device__ __forceinline__ void tile64(Sm64& st, const bf16x8 (&qf)[4], const LAS unsigned char* buf, int lane, float c2, float kbs, float off, float off32, int lim, int lo) {
    const int r32 = lane & 31, hi = lane >> 5;
    f32x16 s0, s1; qk64(s0, s1, qf, buf, r32, hi, kbs);
    if (MODE != 0) {
        const int l0 = lim - 4 * hi, l1 = lim - 32 - 4 * hi, g0 = lo - 4 * hi, g1 = lo - 32 - 4 * hi;
#pragma unroll
        for (int r = 0; r < 16; ++r) { const int kc = (r & 3) + 8 * (r >> 2);
            const bool v0 = (kc <= l0) && (MODE == 1 || kc >= g0), v1 = (kc <= l1) && (MODE == 1 || kc >= g1);
            s0[r] = v0 ? s0[r] : -INFINITY; s1[r] = v1 ? s1[r] : -INFINITY; }
    }
    float m0 = fmaxf(s0[0], s0[1]), m1 = fmaxf(s1[0], s1[1]);
#pragma unroll
    for (int r = 2; r < 16; r += 2) { m0 = fmaxf(fmaxf(m0, s0[r]), s0[r + 1]); m1 = fmaxf(fmaxf(m1, s1[r]), s1[r + 1]); }
    const float mx = xmax32(fmaxf(fmaf(m0, c2, off), fmaf(m1, c2, off32)));
    const float mn = fmaxf(st.m, mx), al = ex2(st.m - mn);
    const f32x2 c2v = {c2, c2}, d0 = {off - mn, off - mn}, d1 = {off32 - mn, off32 - mn};
    f32x2 sum2 = {0.f, 0.f};
#pragma unroll
    for (int r = 0; r < 16; r += 2) { f32x2 a = {s0[r], s0[r + 1]}, b = {s1[r], s1[r + 1]};
        a = __builtin_elementwise_fma(a, c2v, d0); b = __builtin_elementwise_fma(b, c2v, d1);
        a.x = ex2(a.x); a.y = ex2(a.y); b.x = ex2(b.x); b.y = ex2(b.y);
        sum2 = sum2 + a; sum2 = sum2 + b;
        s0[r] = a.x; s0[r + 1] = a.y; s1[r] = b.x; s1[r + 1] = b.y; }
    const float sum = xsum32(sum2.x + sum2.y);
    st.l = st.l * al + sum; st.m = mn;
    const f32x2 alv = {al, al};
#pragma unroll
    for (int r = 0; r < 16; r += 2) { f32x2 a = {st.o[0][r], st.o[0][r + 1]}, b = {st.o[1][r], st.o[1][r + 1]}; a = a * alv; b = b * alv;
        st.o[0][r] = a.x; st.o[0][r + 1] = a.y; st.o[1][r] = b.x; st.o[1][r + 1] = b.y; }
    pv64(st.o, s0, s1, buf, lane, hi);
}

template <unsigned NOPT>
__device__ __forceinline__ void nsa_unit(const Params& p, LAS unsigned char* lds, int unit) {
    const int tid = fresh_tid(), lane = tid & 63, r32 = lane & 31, hi = lane >> 5, w = __builtin_amdgcn_readfirstlane(tid >> 6);
    const int q32 = unit & 63, g = (unit >> 6) & 1, b = unit >> 7;
    const int q0 = q32 * 32, cur = q0 >> 6, hidx = g * 8 + w, s = q0 + r32;
    const size_t trow = (size_t)b * SEQ + s;
    const bf16_t* Q1 = (const bf16_t*)(p.ws + OFF_Q1); const bf16_t* KV = (const bf16_t*)(p.ws + OFF_KV1); const bf16_t* gate = (const bf16_t*)(p.ws + OFF_GATE);
    const bf16_t* ckv = (const bf16_t*)(p.ws + OFF_CMPKV); const bf16_t* Z1 = (const bf16_t*)(p.ws + OFF_Z1); bf16_t* Y1 = (bf16_t*)(p.ws + OFF_Y1);
    const float slope2 = exp2f(-0.5f * (float)(hidx + 1)) * LOG2E, c2 = 0.125f * LOG2E;
    const float kbs = slope2 / c2;
    LAS unsigned char* buf0 = lds; LAS unsigned char* buf1 = lds + 16384;
    LAS float* impw = (LAS float*)(lds + 32768) + w * 1024; LAS float* impt = (LAS float*)(lds + 65536); LAS unsigned* msk = (LAS unsigned*)(lds + 65536 + 4224);
    bf16x8 qf[4];
#pragma unroll
    for (int d0 = 0; d0 < 4; ++d0) qf[d0] = *(const bf16x8*)(Q1 + trow * 1024 + hidx * 64 + d0 * 16 + hi * 8);
    const float g0 = sigm_(bf2f(gate[trow * 256 + hidx * 3 + 0])), g1 = sigm_(bf2f(gate[trow * 256 + hidx * 3 + 1])), g2 = sigm_(bf2f(gate[trow * 256 + hidx * 3 + 2]));
    LAS float* otl = (LAS float*)(lds + 73728);
    {
        const bf16_t* kc = ckv + (((size_t)0 * NB + b) * 2 + g) * 128 * 64; const bf16_t* vc = ckv + (((size_t)1 * NB + b) * 2 + g) * 128 * 64;
        { const KVRegs r0 = kv_load(kc, vc, 64, tid), r1 = kv_load(kc + 64 * 64, vc + 64 * 64, 64, tid); kv_store(buf0, r0, tid); kv_store(buf1, r1, tid); }
        __syncthreads();
        if (!(NOPT & 4u)) {
        f32x16 sc[4]; qk64(sc[0], sc[1], qf, buf0, r32, hi); qk64(sc[2], sc[3], qf, buf1, r32, hi);
        float mx = -INFINITY;
#pragma unroll
        for (int T = 0; T < 4; ++T)
#pragma unroll
            for (int r = 0; r < 16; ++r) { const int n = 32 * T + crow(r, hi), dist = s - (16 * n + 31);
                const float v = dist >= 0 ? fmaf(sc[T][r], c2, -slope2 * (float)dist) : -INFINITY; sc[T][r] = v; mx = fmaxf(mx, v); }
        mx = fmaxf(xmax32(mx), -1e30f);
        float sum = 0.f;
#pragma unroll
        for (int T = 0; T < 4; ++T)
#pragma unroll
            for (int r = 0; r < 16; ++r) { sc[T][r] = ex2(sc[T][r] - mx); sum += sc[T][r]; }
        sum = xsum32(sum);
        const float inv = sum > 0.f ? 1.0f / sum : 0.f;
        float prev_y = 0.f;
#pragma unroll
        for (int T = 0; T < 4; ++T)
#pragma unroll
            for (int c = 0; c < 4; ++c) { const float x3 = sc[T][4 * c + 3], y = __shfl_xor(x3, 32);
                const float sum4 = (sc[T][4 * c] + sc[T][4 * c + 1]) + (sc[T][4 * c + 2] + x3);
                impw[r32 * 32 + 8 * T + 2 * c + hi] = (sum4 + (hi ? y : prev_y)) * inv; prev_y = y; }
        f32x16 oc[2];
#pragma unroll
        for (int r = 0; r < 16; ++r) { oc[0][r] = 0.f; oc[1][r] = 0.f; }
        pv64(oc, sc[0], sc[1], buf0, lane, hi); pv64(oc, sc[2], sc[3], buf1, lane, hi);
        const float f0 = g0 * inv;
#pragma unroll
        for (int r = 0; r < 16; ++r) { otl[r * 512 + tid] = oc[0][r] * f0; otl[(16 + r) * 512 + tid] = oc[1][r] * f0; }
        }
    }
    __syncthreads();
    if (!(NOPT & 8u))
    for (int idx = tid; idx < 1024; idx += 512) { float a = 0.f;
#pragma unroll
        for (int ww = 0; ww < 8; ++ww) a += ((LAS float*)(lds + 32768))[ww * 1024 + idx];
        impt[(idx >> 5) * 33 + (idx & 31)] = a; }
    __syncthreads();
    {
        const int nf = cur == 0 ? 1 : (cur == 1 ? 2 : 3), need = 8 - nf;
#pragma unroll
        for (int pi = 0; pi < 2; ++pi) {
            const int q = pi * 16 + 2 * w + hi, j = r32; bool sel;
            if (j == 0 || j == cur || j == cur - 1) sel = true;
            else if ((NOPT & 8u) == 0 && j <= cur - 2) { const float v = impt[q * 33 + j]; int rank = 0;
#pragma unroll
                for (int j2 = 1; j2 < 30; ++j2) { const float v2 = impt[q * 33 + j2]; rank += (j2 <= cur - 2 && j2 != j && (v2 > v || (v2 == v && j2 < j))) ? 1 : 0; }
                sel = rank < need; }
            else sel = false;
            const unsigned long long bal = __ballot(sel);
            if (lane == 0) msk[pi * 16 + 2 * w] = (unsigned)bal;
            if (lane == 32) msk[pi * 16 + 2 * w + 1] = (unsigned)(bal >> 32);
        }
    }
    __syncthreads();
    const unsigned mymask = msk[r32];
    unsigned uni = mymask;
#pragma unroll
    for (int o = 1; o < 32; o <<= 1) uni |= (unsigned)__shfl_xor((int)uni, o);
    uni = (unsigned)__builtin_amdgcn_readfirstlane((int)uni);
    const int nslc = __builtin_popcount(uni), wlo = (q0 - 511 > 0 ? q0 - 511 : 0) >> 6, nwin = cur - wlo + 1, ntile = nslc + nwin;
    const bf16_t* kvb = KV + (size_t)b * SEQ * 768 + g * 64;
    unsigned rem_l = uni, rem_c = uni;
    auto tile_j = [&](int i, unsigned& rem) { int j; if (i < nslc) { j = __builtin_ctz(rem); rem &= rem - 1; } else j = wlo + (i - nslc); return j; };
    auto kvl = [&](int i, unsigned& rem) { const int j = tile_j(i, rem); const int col = i < nslc ? 256 : 512; return kv_load(kvb + (size_t)64 * j * 768 + col, kvb + (size_t)64 * j * 768 + col + 128, 768, tid); };
    KVRegs ra0, ra1;
    { const KVRegs r0 = kvl(0, rem_l); kv_store(lds, r0, tid); if (1 < ntile) { const KVRegs r1 = kvl(1, rem_l); kv_store(lds + 16384, r1, tid); } }
    __syncthreads();
    Sm64 st; sm64_init(st);
    auto do_tile = [&](int i) {
        const int j = tile_j(i, rem_c); const LAS unsigned char* buf = lds + (i & 3) * 16384;
        if (NOPT & 1u) return;
        const float off = slope2 * (float)(64 * j - s), off32 = off + 32.0f * slope2;
        if (i < nslc) { const bool has = (mymask >> j) & 1u; const float offh = has ? off : -INFINITY, offh32 = has ? off32 : -INFINITY;
            if (j < cur) tile64<0>(st, qf, buf, lane, c2, kbs, offh, offh32, 0, 0);
            else tile64<1>(st, qf, buf, lane, c2, kbs, offh, offh32, s - 64 * j, 0);
            if (i == nslc - 1) { const float f1 = g1 / st.l;
#pragma unroll
                for (int r = 0; r < 16; ++r) { otl[r * 512 + tid] += st.o[0][r] * f1; otl[(16 + r) * 512 + tid] += st.o[1][r] * f1; }
                sm64_init(st); }
        } else {
            if (64 * j + 63 <= q0 && 64 * j >= q0 - 480) tile64<0>(st, qf, buf, lane, c2, kbs, off, off32, 0, 0);
            else tile64<2>(st, qf, buf, lane, c2, kbs, off, off32, s - 64 * j, s - 511 - 64 * j);
        }
    };
    for (int i = 0; i < ((NOPT & 2u) ? 0 : ntile); i += 2) {
        if (i + 2 < ntile) ra0 = kvl(i + 2, rem_l);
        if (i + 3 < ntile) ra1 = kvl(i + 3, rem_l);
        do_tile(i);
        if (i + 1 < ntile) do_tile(i + 1);
        if (i + 2 < ntile) kv_store(lds + ((i + 2) & 3) * 16384, ra0, tid);
        if (i + 3 < ntile) kv_store(lds + ((i + 3) & 3) * 16384, ra1, tid);
        __syncthreads();
    }
    f32x16 ot[2];
    { const float f2 = g2 / st.l;
#pragma unroll
      for (int r = 0; r < 16; ++r) { ot[0][r] = otl[r * 512 + tid] + st.o[0][r] * f2; ot[1][r] = otl[(16 + r) * 512 + tid] + st.o[1][r] * f2; } }
#pragma unroll
    for (int dt = 0; dt < 2; ++dt)
#pragma unroll
        for (int c = 0; c < 4; ++c) { const int d = 32 * dt + 8 * c + 4 * hi;
            const v2u zz = *(const v2u*)(Z1 + trow * 1024 + hidx * 64 + d);
            const float z0 = lo16(zz.x), z1 = hi16(zz.x), z2 = lo16(zz.y), z3 = hi16(zz.y);
            const float y0 = ot[dt][4 * c] * z0 * sigm_(z0), y1 = ot[dt][4 * c + 1] * z1 * sigm_(z1), y2 = ot[dt][4 * c + 2] * z2 * sigm_(z2), y3 = ot[dt][4 * c + 3] * z3 * sigm_(z3);
            v2u o2; o2.x = pg8::cvt_pk_bf16(y0, y1); o2.y = pg8::cvt_pk_bf16(y2, y3);
            *(v2u*)(Y1 + trow * 1280 + hidx * 64 + d) = o2; }
}

__device__ __forceinline__ void mem_unit(const bf16_t* mkv, const bf16_t* QMb, const bf16_t* ZMb, bf16_t* Y, int ldy, LAS unsigned char* lds, int unit) {
    const int tid = fresh_tid(), lane = tid & 63, r32 = lane & 31, hi = lane >> 5, w = __builtin_amdgcn_readfirstlane(tid >> 6);
    const int qc = unit & 7, h = (unit >> 3) & 3, b = unit >> 5;
    const size_t trow = (size_t)b * SEQ + qc * 256 + w * 32 + r32;
    const bf16_t* kb = mkv + (size_t)b * NMEM * 512 + h * 64;
#pragma unroll
    for (int t = 0; t < 4; ++t) { const KVRegs r = kv_load(kb + (size_t)t * 64 * 512, kb + (size_t)t * 64 * 512 + 256, 512, tid); kv_store(lds + t * 16384, r, tid); }
    bf16x8 qf[4];
#pragma unroll
    for (int d0 = 0; d0 < 4; ++d0) qf[d0] = *(const bf16x8*)(QMb + trow * 256 + h * 64 + d0 * 16 + hi * 8);
    __syncthreads();
    Sm64 st; sm64_init(st);
#pragma unroll 1
    for (int t = 0; t < 4; ++t) tile64<0>(st, qf, lds + t * 16384, lane, 0.125f * LOG2E, 0.f, 0.f, 0.f, 0, 0);
    const float inv = 1.0f / st.l;
#pragma unroll
    for (int dt = 0; dt < 2; ++dt)
#pragma unroll
        for (int c = 0; c < 4; ++c) { const int d = 32 * dt + 8 * c + 4 * hi;
            const v2u zz = *(const v2u*)(ZMb + trow * 256 + h * 64 + d);
            const float z0 = lo16(zz.x), z1 = hi16(zz.x), z2 = lo16(zz.y), z3 = hi16(zz.y);
            const float y0 = st.o[dt][4 * c] * inv * z0 * sigm_(z0), y1 = st.o[dt][4 * c + 1] * inv * z1 * sigm_(z1), y2 = st.o[dt][4 * c + 2] * inv * z2 * sigm_(z2), y3 = st.o[dt][4 * c + 3] * inv * z3 * sigm_(z3);
            v2u o2; o2.x = pg8::cvt_pk_bf16(y0, y1); o2.y = pg8::cvt_pk_bf16(y2, y3);
            *(v2u*)(Y + trow * ldy + h * 64 + d) = o2; }
    __syncthreads();
}

__device__ __forceinline__ void dil_task(const Params& p, LAS unsigned char* wl  , int task, int lane, bool dry = false) {
    const int r32 = lane & 31, hi = lane >> 5;
    const int grp = task >> 11, idx = task & 2047, dil = grp == 0 ? 1 : (grp == 1 ? 4 : 16), lg = grp * 2, nq = 64 >> lg;
    const int qi = idx & (nq - 1), rest = idx >> (6 - lg), h = rest & 3, brho = rest >> 2, b = brho >> lg, rho = brho & (dil - 1);
    const int hh = grp * 4 + h, i0 = 32 * qi, isub = i0 + r32;
    bf16_t* Q = (bf16_t*)(p.ws + OFF_Q); const bf16_t* K = (const bf16_t*)(p.ws + OFF_K); const bf16_t* V = (const bf16_t*)(p.ws + OFF_V); float* LSE = (float*)(p.ws + OFF_LSE);
    const size_t base = (size_t)b * SEQ + rho;
    const size_t trow = base + (size_t)isub * dil;
    const float slope2 = exp2f(-8.0f * (float)(hh + 1) / 12.0f) * (float)dil * LOG2E, c2 = 0.08838834764831845f * LOG2E;
    bf16x8 qf[8];
#pragma unroll
    for (int d0 = 0; d0 < 8; ++d0) qf[d0] = *(const bf16x8*)(Q + trow * 1536 + hh * 128 + d0 * 16 + hi * 8);
    f32x16 o[4]; float m = -1e30f, l = 0.f;
#pragma unroll
    for (int dt = 0; dt < 4; ++dt)
#pragma unroll
        for (int r = 0; r < 16; ++r) o[dt][r] = 0.f;
    LAS unsigned char* kl = wl; LAS unsigned char* vl = wl + 8192;
    const LAS unsigned char* vp = vl + ((lane >> 4) & 1) * 32 + (lane & 3) * 8 + (4 * hi + ((lane & 15) >> 2)) * 64;
    const int jt0 = qi - 4 > 0 ? qi - 4 : 0;
    v4u kr[8], vr[8];
    const int ekey = lane >> 4, ech = lane & 15;
#define DIL_LOAD(jt_) do { _Pragma("unroll") for (int it = 0; it < 8; ++it) { const size_t go = (base + (size_t)(32 * (jt_) + 4 * it + ekey) * dil) * 1536 + hh * 128 + ech * 8; \
        kr[it] = *(const v4u*)(K + go); vr[it] = *(const v4u*)(V + go); } } while (0)
    DIL_LOAD(jt0);
    for (int jt = jt0; jt <= qi; ++jt) {
        asm volatile("s_waitcnt lgkmcnt(0)" ::: "memory");
#pragma unroll
        for (int it = 0; it < 8; ++it) { const int key = 4 * it + ekey;
            *(LAS v4u*)(kl + key * 256 + ((ech ^ (key & 15)) * 16)) = kr[it];
            *(LAS v4u*)(vl + (ech >> 2) * 2048 + key * 64 + (ech & 3) * 16) = vr[it]; }
        if (jt < qi) DIL_LOAD(jt + 1);
        asm volatile("s_waitcnt lgkmcnt(0)" ::: "memory");
        f32x16 sc;
#pragma unroll
        for (int r = 0; r < 16; ++r) sc[r] = 0.f;
#pragma unroll
        for (int d0 = 0; d0 < 8; ++d0) { const bf16x8 kf = *(const LAS bf16x8*)(kl + r32 * 256 + (((2 * d0 + hi) ^ (r32 & 15)) * 16)); sc = MFMA32(kf, qf[d0], sc); }
        float mx = -INFINITY;
#pragma unroll
        for (int r = 0; r < 16; ++r) { const int dist = isub - (32 * jt + crow(r, hi));
            const float v = (dist >= 0 && dist <= 128) ? fmaf(sc[r], c2, -slope2 * (float)dist) : -INFINITY; sc[r] = v; mx = fmaxf(mx, v); }
        mx = xmax32(mx);
        const float mn = fmaxf(m, mx), al = ex2(m - mn);
        float sum = 0.f;
#pragma unroll
        for (int r = 0; r < 16; ++r) { sc[r] = ex2(sc[r] - mn); sum += sc[r]; }
        sum = xsum32(sum); l = l * al + sum; m = mn;
#pragma unroll
        for (int dt = 0; dt < 4; ++dt)
#pragma unroll
            for (int r = 0; r < 16; ++r) o[dt][r] *= al;
        const bf16x8 pf0 = pack8(sc, 0), pf1 = pack8(sc, 8);
#pragma unroll
        for (int dt = 0; dt < 4; ++dt) { o[dt] = MFMA32(vfrag(vp + dt * 2048), pf0, o[dt]); o[dt] = MFMA32(vfrag(vp + dt * 2048 + 1024), pf1, o[dt]); }
    }
#undef DIL_LOAD
    const float inv = 1.0f / l;
#pragma unroll
    for (int dt = 0; dt < 4; ++dt)
#pragma unroll
        for (int c = 0; c < 4; ++c) { const int d = 32 * dt + 8 * c + 4 * hi;
            v2u o2; o2.x = pg8::cvt_pk_bf16(o[dt][4 * c] * inv, o[dt][4 * c + 1] * inv); o2.y = pg8::cvt_pk_bf16(o[dt][4 * c + 2] * inv, o[dt][4 * c + 3] * inv);
            if (!dry) *(v2u*)(Q + trow * 1536 + hh * 128 + d) = o2; else asm volatile("" :: "v"(o2.x), "v"(o2.y)); }
    if (hi == 0 && !dry) LSE[((size_t)grp * T_ + trow) * 4 + h] = (m + __builtin_amdgcn_logf(l)) * LN2;
}

__device__ __forceinline__ void lru_unit(const Params& p, LAS unsigned char* lds, int unit) {
    const int tid = fresh_tid(), lane = tid & 63, r32 = lane & 31, hi = lane >> 5, w = __builtin_amdgcn_readfirstlane(tid >> 6);
    const int hh = unit & 1, blk = (unit >> 1) & 15, b = unit >> 5;
    const int cj = blk * 64 + hh * 32 + r32;
    const bf16_t* xaza = (const bf16_t*)p.out; bf16_t* Y0 = (bf16_t*)(p.ws + OFF_Y0);
    LAS float* cw = (LAS float*)lds; LAS float* tot = (LAS float*)(lds + 2048); LAS float* xcs = (LAS float*)(lds + 8192 + w * 8704);
    LAS unsigned char* xst = lds + 77824; LAS unsigned char* zst = lds + 115200 + w * 2048;
    if (tid < 256) cw[tid] = p.conv_w[(tid >> 6) * 1024 + blk * 64 + (tid & 63)]; else if (tid < 320) cw[tid] = p.conv_b[blk * 64 + tid - 256];
    bf16x8 wa[4], wx[4];
#pragma unroll
    for (int ks = 0; ks < 4; ++ks) { float fa[8], fx[8];
#pragma unroll
        for (int jj = 0; jj < 8; ++jj) { const size_t wi = (size_t)blk * 4096 + (size_t)(16 * ks + 8 * hi + jj) * 64 + hh * 32 + r32; fa[jj] = p.ga_w[wi]; fx[jj] = p.gx_w[wi]; }
        v4u a4, x4; a4.x = pg8::cvt_pk_bf16(fa[0], fa[1]); a4.y = pg8::cvt_pk_bf16(fa[2], fa[3]); a4.z = pg8::cvt_pk_bf16(fa[4], fa[5]); a4.w = pg8::cvt_pk_bf16(fa[6], fa[7]);
        x4.x = pg8::cvt_pk_bf16(fx[0], fx[1]); x4.y = pg8::cvt_pk_bf16(fx[2], fx[3]); x4.z = pg8::cvt_pk_bf16(fx[4], fx[5]); x4.w = pg8::cvt_pk_bf16(fx[6], fx[7]);
        wa[ks] = __builtin_bit_cast(bf16x8, a4); wx[ks] = __builtin_bit_cast(bf16x8, x4); }
    const float ba = p.ga_b[cj], bx = p.gx_b[cj], sp8 = -8.0f * log1pf(expf(-p.lam[cj]));
    v4u xr[5], zr[2];
#define LRU_LOAD(c_) do { const int t0c_ = (c_) * 256; \
        _Pragma("unroll") for (int i = 0; i < 5; ++i) { const int e = tid + 512 * i, row = e >> 3, tt = t0c_ - 3 + row; xr[i] = (v4u){0u, 0u, 0u, 0u}; \
            if (e < 2072 && tt >= 0) xr[i] = *(const v4u*)(xaza + ((size_t)b * SEQ + tt) * 2048 + blk * 64 + (e & 7) * 8); } \
        _Pragma("unroll") for (int i = 0; i < 2; ++i) { const int e = lane + 64 * i; zr[i] = *(const v4u*)(xaza + ((size_t)b * SEQ + t0c_ + w * 32 + (e >> 2)) * 2048 + 1024 + blk * 64 + hh * 32 + (e & 3) * 8); } } while (0)
    LRU_LOAD(0);
    float hchunk = 0.f;
#pragma unroll 1
    for (int c = 0; c < 8; ++c) {
        const int t0 = c * 256 + w * 32;
        const size_t rowb = (size_t)b * SEQ + t0;
#pragma unroll
        for (int i = 0; i < 5; ++i) { const int e = tid + 512 * i; if (e < 2072) *(LAS v4u*)(xst + (e >> 3) * 144 + (e & 7) * 16) = xr[i]; }
#pragma unroll
        for (int i = 0; i < 2; ++i) { const int e = lane + 64 * i; *(LAS v4u*)(zst + (e >> 2) * 64 + (e & 3) * 16) = zr[i]; }
        __syncthreads();
        if (c < 7) LRU_LOAD(c + 1);
        bf16x8 af[4];
#pragma unroll
        for (int ks = 0; ks < 4; ++ks) { const int i0 = 16 * ks + 8 * hi; float acc[8];
            { const f32x4 b0 = *(const LAS f32x4*)(cw + 256 + i0), b1 = *(const LAS f32x4*)(cw + 256 + i0 + 4); acc[0] = b0[0]; acc[1] = b0[1]; acc[2] = b0[2]; acc[3] = b0[3]; acc[4] = b1[0]; acc[5] = b1[1]; acc[6] = b1[2]; acc[7] = b1[3]; }
#pragma unroll
            for (int k = 0; k < 4; ++k) { const v4u v = *(const LAS v4u*)(xst + (w * 32 + r32 + k) * 144 + i0 * 2);
                const f32x4 w0 = *(const LAS f32x4*)(cw + k * 64 + i0), w1 = *(const LAS f32x4*)(cw + k * 64 + i0 + 4);
                acc[0] += w0[0] * lo16(v.x); acc[1] += w0[1] * hi16(v.x); acc[2] += w0[2] * lo16(v.y); acc[3] += w0[3] * hi16(v.y);
                acc[4] += w1[0] * lo16(v.z); acc[5] += w1[1] * hi16(v.z); acc[6] += w1[2] * lo16(v.w); acc[7] += w1[3] * hi16(v.w); }
            *(LAS f32x4*)(xcs + r32 * 68 + i0) = (f32x4){acc[0], acc[1], acc[2], acc[3]}; *(LAS f32x4*)(xcs + r32 * 68 + i0 + 4) = (f32x4){acc[4], acc[5], acc[6], acc[7]};
            v4u pk; pk.x = pg8::cvt_pk_bf16(acc[0], acc[1]); pk.y = pg8::cvt_pk_bf16(acc[2], acc[3]); pk.z = pg8::cvt_pk_bf16(acc[4], acc[5]); pk.w = pg8::cvt_pk_bf16(acc[6], acc[7]);
            af[ks] = __builtin_bit_cast(bf16x8, pk); }
        f32x16 ra, rx;
#pragma unroll
        for (int r = 0; r < 16; ++r) { ra[r] = 0.f; rx[r] = 0.f; }
#pragma unroll
        for (int ks = 0; ks < 4; ++ks) { ra = MFMA32(af[ks], wa[ks], ra); rx = MFMA32(af[ks], wx[ks], rx); }
        asm volatile("s_waitcnt lgkmcnt(0)" ::: "memory");
        float a[16], u[16];
#pragma unroll
        for (int r = 0; r < 16; ++r) { const int tl = crow(r, hi); const float xc = xcs[tl * 68 + hh * 32 + r32];
            const float rg = sigm_(ra[r] + ba), ig = sigm_(rx[r] + bx), la = sp8 * rg;
            a[r] = ex2(la * LOG2E);
            const float om = fmaf(-a[r], a[r], 1.0f);
            const float mult = (t0 + tl == 0) ? 1.0f : __builtin_amdgcn_sqrtf(om);
            u[r] = xc * ig * mult; }
        float EA[8], EU[8];
#pragma unroll
        for (int cg = 0; cg < 4; ++cg) { const int r0 = 4 * cg;
            const float GA = (a[r0] * a[r0 + 1]) * (a[r0 + 2] * a[r0 + 3]), GU = ((u[r0] * a[r0 + 1] + u[r0 + 1]) * a[r0 + 2] + u[r0 + 2]) * a[r0 + 3] + u[r0 + 3];
            const float PA = __shfl_xor(GA, 32), PU = __shfl_xor(GU, 32);
            EA[2 * cg] = hi ? PA : GA; EU[2 * cg] = hi ? PU : GU; EA[2 * cg + 1] = hi ? GA : PA; EU[2 * cg + 1] = hi ? GU : PU; }
        float TA = 1.f, TU = 0.f;
#pragma unroll
        for (int g = 0; g < 8; ++g) { TU = EA[g] * TU + EU[g]; TA *= EA[g]; }
        LAS float* tt2 = tot + (c & 1) * 512;
        if (hi == 0) { tt2[(w * 32 + r32) * 2] = TA; tt2[(w * 32 + r32) * 2 + 1] = TU; }
        __syncthreads();
        float h = hchunk, hin = 0.f;
#pragma unroll
        for (int ww = 0; ww < 8; ++ww) { if (ww == w) hin = h; h = tt2[(ww * 32 + r32) * 2] * h + tt2[(ww * 32 + r32) * 2 + 1]; }
        hchunk = h;
        float hown[4], hg = hin;
#pragma unroll
        for (int g = 0; g < 8; ++g) { if ((g & 1) == hi) hown[g >> 1] = hg; hg = EA[g] * hg + EU[g]; }
        LAS bf16_t* zy = (LAS bf16_t*)zst;
#pragma unroll
        for (int cg = 0; cg < 4; ++cg) { float hc = hown[cg];
#pragma unroll
            for (int q = 0; q < 4; ++q) { const int r = 4 * cg + q; hc = a[r] * hc + u[r];
                const int tl = crow(r, hi); const float z = bf2f(zy[tl * 32 + r32]); zy[tl * 32 + r32] = f2bf(hc * z * sigm_(z)); } }
        asm volatile("s_waitcnt lgkmcnt(0)" ::: "memory");
#pragma unroll
        for (int i = 0; i < 2; ++i) { const int e = lane + 64 * i; const v4u yv = *(const LAS v4u*)(zst + (e >> 2) * 64 + (e & 3) * 16);
            *(v4u*)(Y0 + (rowb + (e >> 2)) * 1792 + blk * 64 + hh * 32 + (e & 3) * 8) = yv; }
        asm volatile("s_waitcnt lgkmcnt(0)" ::: "memory");
    }
#undef LRU_LOAD
    __syncthreads();
}

__device__ __forceinline__ void cmp1_task(const Params& p, int task, int lane) {
    const int r32 = lane & 31, hi = lane >> 5;
    const int ct = task & 7, rt = (task >> 3) & 3, g = (task >> 5) & 1, b = (task >> 6) & 7, kv = task >> 9;
    const bf16_t* KV = (const bf16_t*)(p.ws + OFF_KV1); const bf16_t* w1 = (const bf16_t*)(p.ws + OFF_PHIW1) + (size_t)kv * 256 * 2048; bf16_t* hid = (bf16_t*)(p.ws + OFF_CMPH);
    const float* peb = (const float*)(p.ws + OFF_PEB) + kv * 256;
    const int n = rt * 32 + r32;
    const bf16_t* ar = KV + ((size_t)b * SEQ + 16 * n) * 768 + kv * 128 + g * 64 + hi * 8;
    const bf16_t* br = w1 + (size_t)(ct * 32 + r32) * 2048 + hi * 8;
    f32x16 acc;
#pragma unroll
    for (int r = 0; r < 16; ++r) acc[r] = 0.f;
#pragma unroll 4
    for (int i = 0; i < 32; ++i) {
#pragma unroll
        for (int q = 0; q < 4; ++q) { const bf16x8 af = *(const bf16x8*)(ar + (size_t)i * 768 + 16 * q), bf = *(const bf16x8*)(br + i * 64 + 16 * q); acc = MFMA32(af, bf, acc); }
    }
    float pb = 0.f;
#pragma unroll 8
    for (int c = 0; c < 64; ++c) pb += peb[c * 512 + ct * 32 + r32];
    const size_t rowbase = (((size_t)kv * NB + b) * 2 + g) * 128 + rt * 32;
#pragma unroll
    for (int r = 0; r < 16; ++r) { const float v = acc[r] + pb; hid[(rowbase + crow(r, hi)) * 256 + ct * 32 + r32] = f2bf(v * sigm_(v)); }
}
__device__ __forceinline__ void cmp2_task(const Params& p, int task, int lane) {
    const int r32 = lane & 31, hi = lane >> 5;
    const int dtile = task & 1, rt = (task >> 1) & 63, kv = task >> 7;
    const bf16_t* hid = (const bf16_t*)(p.ws + OFF_CMPH) + ((size_t)kv * 2048 + rt * 32 + r32) * 256 + hi * 8;
    const bf16_t* w2 = (const bf16_t*)(p.ws + OFF_PHIW2) + ((size_t)kv * 64 + dtile * 32 + r32) * 256 + hi * 8;
    bf16_t* ckv = (bf16_t*)(p.ws + OFF_CMPKV) + ((size_t)kv * 2048 + rt * 32) * 64 + dtile * 32 + r32;
    f32x16 acc;
#pragma unroll
    for (int r = 0; r < 16; ++r) acc[r] = 0.f;
#pragma unroll
    for (int ks = 0; ks < 16; ++ks) acc = MFMA32(*(const bf16x8*)(hid + 16 * ks), *(const bf16x8*)(w2 + 16 * ks), acc);
#pragma unroll
    for (int r = 0; r < 16; ++r) { const int row = rt * 32 + crow(r, hi); ckv[(size_t)crow(r, hi) * 64] = f2bf((row & 127) == 127 ? 0.f : acc[r]); }
}

__device__ __forceinline__ void memkv_task(const Params& p, int task, int lane) {
    const int r32 = lane & 31, hi = lane >> 5;
    const int ct = task & 15, rt = (task >> 4) & 63, l = task >> 10;
    const float* ar = p.mem + (size_t)(rt * 32 + r32) * DM + hi * 8;
    const bf16_t* br = (const bf16_t*)(p.ws + OFF_WMKV) + ((size_t)l * 512 + ct * 32 + r32) * DM + hi * 8;
    bf16_t* mkv = (bf16_t*)(p.ws + OFF_MEMKV) + (size_t)l * NB * NMEM * 512;
    f32x16 acc; float ss = 0.f;
#pragma unroll
    for (int r = 0; r < 16; ++r) acc[r] = 0.f;
#pragma unroll 4
    for (int ks = 0; ks < DM / 16; ++ks) { const f32x4 x0 = *(const f32x4*)(ar + 16 * ks), x1 = *(const f32x4*)(ar + 16 * ks + 4);
        ss += (x0[0] * x0[0] + x0[1] * x0[1]) + (x0[2] * x0[2] + x0[3] * x0[3]) + (x1[0] * x1[0] + x1[1] * x1[1]) + (x1[2] * x1[2] + x1[3] * x1[3]);
        v4u pk; pk.x = pg8::cvt_pk_bf16(x0[0], x0[1]); pk.y = pg8::cvt_pk_bf16(x0[2], x0[3]); pk.z = pg8::cvt_pk_bf16(x1[0], x1[1]); pk.w = pg8::cvt_pk_bf16(x1[2], x1[3]);
        acc = MFMA32(__builtin_bit_cast(bf16x8, pk), *(const bf16x8*)(br + 16 * ks), acc); }
    ss = xsum32(ss);
    const float rs = 1.0f / sqrtf(ss * (1.0f / DM) + EPS);
#pragma unroll
    for (int r = 0; r < 16; ++r) { const float rr = __shfl(rs, crow(r, hi)); mkv[(size_t)(rt * 32 + crow(r, hi)) * 512 + ct * 32 + r32] = f2bf(acc[r] * rr); }
}

#define XB_TMO      128
#define XB_XCNT(j)  (256  + 64 * (j))
#define XB_XSUB(j)  (1280 + 64 * (j))
#define XB_XGEN(j)  (2304 + 64 * (j))
#define XB_TOP      3328
#define XB_TOPGEN   3392
#define XCD_BAR_WORDS 3456
#define XB_SPIN_CAP (1u << 18)
__device__ __forceinline__ unsigned xb_ld(unsigned* p)              { return __hip_atomic_load(p, __ATOMIC_RELAXED, __HIP_MEMORY_SCOPE_AGENT); }
__device__ __forceinline__ unsigned xb_add(unsigned* p, unsigned v) { return __hip_atomic_fetch_add(p, v, __ATOMIC_RELAXED, __HIP_MEMORY_SCOPE_AGENT); }
__device__ __forceinline__ unsigned xb_xcc_id() { return (unsigned)__builtin_amdgcn_s_getreg((3 << 11) | 20) & 0xFu; }
#define XB_SPIN(cond, bar) do { unsigned _sp = 0; while (cond) { __builtin_amdgcn_s_sleep(1); \
    if ((++_sp & 255u) == 0u) { if (xb_ld(&(bar)[XB_TMO])) break; if (_sp > XB_SPIN_CAP) { atomicAdd(&(bar)[XB_TMO], 1u); break; } } } } while (0)
struct XcdBarrier { unsigned* bar; unsigned x; volatile LAS unsigned* st; };
__device__ __forceinline__ XcdBarrier xcd_barrier_post(unsigned* bar, volatile LAS unsigned* st) {
    XcdBarrier b; b.bar = bar; b.x = xb_xcc_id(); b.st = st;
    if (threadIdx.x == 0) (void)xb_add(&bar[XB_XCNT(b.x)], 1u);
    return b;
}
__device__ __forceinline__ void xcd_barrier_complete(unsigned* bar, unsigned x, unsigned& nloc, unsigned& nx) {
    const unsigned G = gridDim.x * gridDim.y * gridDim.z;
    unsigned sum, cnt, mine, sp = 0u;
    for (;;) {
        sum = 0u; cnt = 0u; mine = 0u;
#pragma unroll
        for (unsigned j = 0; j < 16; ++j) { const unsigned c = xb_ld(&bar[XB_XCNT(j)]); sum += c; cnt += (c > 0u) ? 1u : 0u; mine = (j == x) ? c : mine; }
        if (sum == G) break;
        __builtin_amdgcn_s_sleep(1);
        if ((++sp & 255u) == 0u) { if (xb_ld(&bar[XB_TMO])) break; if (sp > XB_SPIN_CAP) { atomicAdd(&bar[XB_TMO], 1u); break; } }
    }
    nloc = mine > 0u ? mine : 1u; nx = cnt > 0u ? cnt : 1u;
}
__device__ __forceinline__ void xcd_barrier(const XcdBarrier& b) {
    asm volatile("s_waitcnt vmcnt(0)" ::: "memory");
    __syncthreads();
    if (threadIdx.x == 0) {
        unsigned* bar = b.bar;
        __builtin_amdgcn_s_waitcnt(0);
        unsigned nloc = b.st[0], nx = b.st[1];
        if (nloc == 0u) { xcd_barrier_complete(bar, b.x, nloc, nx); b.st[0] = nloc; b.st[1] = nx; }
        const unsigned old = xb_add(&bar[XB_XSUB(b.x)], 1u);
        const unsigned gen = old / nloc;
        if (old + 1u == (gen + 1u) * nloc) {
            __builtin_amdgcn_fence(__ATOMIC_RELEASE, "agent");
            asm volatile("s_waitcnt vmcnt(0)" ::: "memory");
            const unsigned og = xb_add(&bar[XB_TOP], 1u);
            const unsigned tg = og / nx;
            if (og + 1u == (tg + 1u) * nx) xb_add(&bar[XB_TOPGEN], 1u);
            else XB_SPIN(xb_ld(&bar[XB_TOPGEN]) == tg, bar);
            __builtin_amdgcn_fence(__ATOMIC_ACQUIRE, "agent");
            xb_add(&bar[XB_XGEN(b.x)], 1u);
            asm volatile("s_waitcnt vmcnt(0)" ::: "memory");
        } else {
            XB_SPIN(xb_ld(&bar[XB_XGEN(b.x)]) == gen, bar);
            __builtin_amdgcn_fence(__ATOMIC_ACQUIRE, "agent");
            asm volatile("s_waitcnt vmcnt(0)" ::: "memory");
        }
    }
    __syncthreads();
}
#define GSYNC() xcd_barrier(bar)

__device__ __forceinline__ int fresh_tid() { int t = threadIdx.x; asm volatile("" : "+v"(t)); return t; }
#ifndef PROBE_REP
#define PROBE_REP -1
#endif
#define REP(k) for (int rep_ = 0; rep_ < ((PROBE_REP == (k)) ? 2 : 1); ++rep_)
#define PH_IDS() const int tid = fresh_tid(), lane = tid & 63, wave = __builtin_amdgcn_readfirstlane(tid >> 6); const long gt = (long)blockIdx.x * 512 + tid, nt = (long)G * 512; \
    const int gw = blockIdx.x * NWAVES + wave, NGW = G * NWAVES; (void)lane; (void)gt; (void)nt; (void)gw; (void)NGW
__device__ __forceinline__ Params load_params() {
    Params p{};
#if defined(__HIP_DEVICE_COMPILE__)
    typedef const __attribute__((address_space(4))) unsigned long long* kq_t;
    kq_t k = (kq_t)__builtin_amdgcn_kernarg_segment_ptr(); asm volatile("" : "+s"(k));
    unsigned long long* d = (unsigned long long*)&p;
#pragma unroll
    for (int i = 0; i < (int)(sizeof(Params) / 8); ++i) d[i] = k[i];
#endif
    return p;
}
#define PP() const Params p = load_params()
#ifndef PROBE_SKIP
#define PROBE_SKIP 0
#endif
#ifndef PROBE_TWICE
#define PROBE_TWICE 0
#endif
template <unsigned SKIP>
__global__ void __launch_bounds__(NWAVES * 64, 2) mega(Params p_unused_arg) {
    extern __shared__ __attribute__((aligned(16))) unsigned char lds_raw[];
    LAS unsigned char* lds = (LAS unsigned char*)lds_raw;
    const int G = gridDim.x;
    if (threadIdx.x < 4) ((LAS unsigned*)(lds + LDS_BYTES - 64))[threadIdx.x] = 0u;
    __syncthreads();
    XcdBarrier bar; { PP(); bar.bar = (unsigned*)(p.ws + OFF_CTRL); } bar.x = xb_xcc_id(); bar.st = (volatile LAS unsigned*)(lds + LDS_BYTES - 64);
    if (threadIdx.x == 0) bar.st[2] = xb_add(&bar.bar[XB_XCNT(bar.x)], 1u);

#define RUN(k) if constexpr (!((SKIP >> (k)) & 1u))
    {
    RUN(0) {
        PP(); PH_IDS();
        LAS float* scr = (LAS float*)(lds + wave * 16384);
        constexpr int I0 = (DM / 64) * (HAWK_IN / 32), I1 = (HAWK_OUT / 64) * (DM / 32), I2 = (DM / 64) * (NSA_INP / 32), I3 = (NSA_OUT / 64) * (DM / 32), I4 = (2048 / 64) * (256 / 32), I5 = (DM / 64) * (512 / 32), I6 = (256 / 64) * (64 / 32);
        for (int it = gw; it < I0 + I1 + I2 + I3 + 2 * I4 + 2 * I5 + 2 * I6; it += NGW) {
            int r = it;
            if (r < I0) { p0_transpose_item<false>(p.hawk_w_in, DM, HAWK_IN, HAWK_IN, (bf16_t*)(p.ws + OFF_W0IN), scr, r, lane); continue; } r -= I0;
            if (r < I1) { p0_transpose_item<false>(p.hawk_w_out, HAWK_OUT, DM, DM, (bf16_t*)(p.ws + OFF_W0OUT), scr, r, lane); continue; } r -= I1;
            if (r < I2) { p0_transpose_item<true>(p.nsa_w_in, DM, NSA_IN, NSA_INP, (bf16_t*)(p.ws + OFF_W1IN), scr, r, lane); continue; } r -= I2;
            if (r < I3) { p0_transpose_item<false>(p.nsa_w_out, NSA_OUT, DM, DM, (bf16_t*)(p.ws + OFF_W1OUT), scr, r, lane); continue; } r -= I3;
            if (r < I4) { p0_transpose_item<false>(p.phik_w1, 2048, 256, 256, (bf16_t*)(p.ws + OFF_PHIW1), scr, r, lane); continue; } r -= I4;
            if (r < I4) { p0_transpose_item<false>(p.phiv_w1, 2048, 256, 256, (bf16_t*)(p.ws + OFF_PHIW1) + 256 * 2048, scr, r, lane); continue; } r -= I4;
            if (r < I5) { p0_transpose_item<false>(p.hawk_w_mem_kv, DM, 512, 512, (bf16_t*)(p.ws + OFF_WMKV), scr, r, lane, p.hawk_mem_norm); continue; } r -= I5;
            if (r < I5) { p0_transpose_item<false>(p.nsa_w_mem_kv, DM, 512, 512, (bf16_t*)(p.ws + OFF_WMKV) + 512 * DM, scr, r, lane, p.nsa_mem_norm); continue; } r -= I5;
            if (r < I6) { p0_transpose_item<false>(p.phik_w2, 256, 64, 64, (bf16_t*)(p.ws + OFF_PHIW2), scr, r, lane); continue; } r -= I6;
            p0_transpose_item<false>(p.phiv_w2, 256, 64, 64, (bf16_t*)(p.ws + OFF_PHIW2) + 64 * 256, scr, r, lane);
        }
        for (int m = gw; m < T_; m += 4 * NGW) rms_rows4_to_bf16(p.x, p.hawk_norm, (bf16_t*)(p.ws + OFF_XN), m, NGW, T_, lane);
        for (int m = gw; m < NB * NMEM; m += NGW) rms_row_to_bf16(p.mem + (size_t)m * DM, nullptr, (bf16_t*)(p.ws + OFF_MEMN) + (size_t)m * DM, lane);
        if (gt < 32768) { const int o = (int)gt & 511, kv = o >> 8, j = o & 255, k0 = ((int)gt >> 9) * 32; const float* pe = kv ? p.pe_v : p.pe_k; const float* w1 = kv ? p.phiv_w1 : p.phik_w1; float a = 0.f;
#pragma unroll 8
            for (int k = 0; k < 32; ++k) a += pe[k0 + k] * w1[(size_t)(k0 + k) * 256 + j];
            ((float*)(p.ws + OFF_PEB))[gt] = a; }
    }
    GSYNC();
    if (threadIdx.x == 0) { bool even = (G % 8) == 0;
        for (unsigned j = 0; j < 16; ++j) { const unsigned c = xb_ld(&bar.bar[XB_XCNT(j)]); even = even && (c == (j < 8 ? (unsigned)G / 8u : 0u)); }
        bar.st[3] = even ? bar.st[2] * 8u + bar.x : blockIdx.x; }
    __syncthreads();
    const int vcu = (int)bar.st[3];
    RUN(2) { PP(); pg8::Gemm g{DM, DM, DM, 128, 128}; pg8::StaticOrder S; S.init((const bf16_t*)(p.ws + OFF_XN), (const bf16_t*)(p.ws + OFF_W0IN), T_, HAWK_IN, DM, G, vcu);
      S.extra((const bf16_t*)(p.ws + OFF_MEMN), (const bf16_t*)(p.ws + OFF_WMKV), NB * NMEM, 1024);
      pg8::EpiRoute E{p.ws, (bf16_t*)p.out, 0};
      pg8::gemm_phase<pg8::EpiRoute, pg8::StaticOrder, true, true>(lds, g, S, E); }
    GSYNC();
    {
        PP(); PH_IDS();
        if (gw < 512) { float v = ((const float*)(p.ws + OFF_PEB))[lane * 512 + gw]; v = wave_sum(v); if (lane == 0) ((float*)(p.ws + OFF_PEBS))[gw] = v; }
        RUN(3) for (int u = blockIdx.x; u < 256; u += G) lru_unit(p, lds, u);
        RUN(4) for (int task = gw; task < 6144; task += NGW) dil_task(p, lds + wave * 16384, task, lane);
        __syncthreads();
        RUN(5) for (int u = blockIdx.x; u < 256; u += G) mem_unit((const bf16_t*)(p.ws + OFF_MEMKV), (const bf16_t*)(p.ws + OFF_QM), (const bf16_t*)(p.ws + OFF_ZM), (bf16_t*)(p.ws + OFF_Y0) + 1536, 1792, lds, u);
    }
    GSYNC();
    RUN(6) { PP(); PH_IDS();
        const bf16_t* Q = (const bf16_t*)(p.ws + OFF_Q); const bf16_t* ZB = (const bf16_t*)(p.ws + OFF_ZB); const float* LSE = (const float*)(p.ws + OFF_LSE); bf16_t* Y0 = (bf16_t*)(p.ws + OFF_Y0);
        for (long i = gt; i < (long)T_ * 64; i += nt) { const int t = (int)(i >> 6), c8 = ((int)i & 63) * 8, h = c8 >> 7;
            const float l0 = LSE[((size_t)0 * T_ + t) * 4 + h], l1 = LSE[((size_t)1 * T_ + t) * 4 + h], l2 = LSE[((size_t)2 * T_ + t) * 4 + h];
            const float mx = fmaxf(l0, fmaxf(l1, l2)), e0 = __expf(l0 - mx), e1 = __expf(l1 - mx), e2 = __expf(l2 - mx), inv = 1.0f / (e0 + e1 + e2), w0 = e0 * inv, w1 = e1 * inv, w2 = e2 * inv;
            const v4u a = *(const v4u*)(Q + (size_t)t * 1536 + c8), b = *(const v4u*)(Q + (size_t)t * 1536 + 512 + c8), c = *(const v4u*)(Q + (size_t)t * 1536 + 1024 + c8), z = *(const v4u*)(ZB + (size_t)t * 512 + c8);
            v4u o;
#define CMB(f) { const float zl = lo16(z.f), zh = hi16(z.f); o.f = pg8::cvt_pk_bf16((w0 * lo16(a.f) + w1 * lo16(b.f) + w2 * lo16(c.f)) * zl * sigm_(zl), (w0 * hi16(a.f) + w1 * hi16(b.f) + w2 * hi16(c.f)) * zh * sigm_(zh)); }
            CMB(x) CMB(y) CMB(z) CMB(w)
#undef CMB
            *(v4u*)(Y0 + (size_t)t * 1792 + 1024 + c8) = o; } }
    GSYNC();
    if (G == 256) {
    RUN(7) { PP(); pg8::Gemm g{HAWK_OUT, HAWK_OUT, HAWK_OUT, 128, 128}; pg8::StaticOrder S; S.init((const bf16_t*)(p.ws + OFF_Y0), (const bf16_t*)(p.ws + OFF_W0OUT), T_, DM, HAWK_OUT, G, vcu);
      pg8::EpiResidNorm E{p.x, (float*)(p.ws + OFF_X1), nullptr, (bf16_t*)p.out, p.nsa_norm, DM, (float*)(p.ws + OFF_LSE), (unsigned*)(p.ws + OFF_CTRL + 16384)};
      pg8::gemm_phase<pg8::EpiResidNorm, pg8::StaticOrder, false, true>(lds, g, S, E); }
    GSYNC();
    } else {
    RUN(7) { PP(); pg8::Gemm g{HAWK_OUT, HAWK_OUT, HAWK_OUT, 128, 128}; pg8::StaticOrder S; S.init((const bf16_t*)(p.ws + OFF_Y0), (const bf16_t*)(p.ws + OFF_W0OUT), T_, DM, HAWK_OUT, G, vcu);
      pg8::EpiResid E{p.x, (float*)(p.ws + OFF_X1), DM};
      pg8::gemm_phase<pg8::EpiResid, pg8::StaticOrder, true, true>(lds, g, S, E); }
    GSYNC();
    RUN(8) { PP(); PH_IDS(); for (int m = gw; m < T_; m += 4 * NGW) rms_rows4_to_bf16((const float*)(p.ws + OFF_X1), p.nsa_norm, (bf16_t*)p.out, m, NGW, T_, lane); }
    GSYNC();
    }
    RUN(9) { PP(); pg8::Gemm g{DM, DM, DM, 128, 128}; pg8::StaticOrder S; S.init((const bf16_t*)p.out, (const bf16_t*)(p.ws + OFF_W1IN), T_, NSA_INP, DM, G, vcu);
      pg8::EpiRoute E{p.ws, (bf16_t*)p.out, 1};
      pg8::gemm_phase<pg8::EpiRoute, pg8::StaticOrder, true, true>(lds, g, S, E); }
    GSYNC();
    {
        PP();
        if (vcu < 16) {
            RUN(10) { const int kv = vcu >> 3, g = (vcu >> 2) & 1, rt = vcu & 3;
                pg8::Gemm gm{2048, 16 * 768, 2048, 768 * 2, 128}; pg8::OneUnit S; S.have = true; S.u.pm = rt; S.u.pn = 0; S.u.tag = kv * 2 + g;
                S.u.A = (const char*)((const bf16_t*)(p.ws + OFF_KV1) + kv * 128 + g * 64) + (size_t)rt * 256 * (16 * 768) * 2; S.u.B = (const char*)((const bf16_t*)(p.ws + OFF_PHIW1) + (size_t)kv * 256 * 2048);
                pg8::EpiCmp1 E{(bf16_t*)(p.ws + OFF_CMPH), (const float*)(p.ws + OFF_PEBS)};
                pg8::gemm_phase<pg8::EpiCmp1, pg8::OneUnit, true, true>(lds, gm, S, E); }
        } else {
            RUN(11) for (int u = vcu - 16; u < 256; u += G - 16) mem_unit((const bf16_t*)(p.ws + OFF_MEMKV) + (size_t)NB * NMEM * 512, (const bf16_t*)(p.ws + OFF_QM1), (const bf16_t*)(p.ws + OFF_ZM1), (bf16_t*)(p.ws + OFF_Y1) + 1024, 1280, lds, u);
        }
    }
    GSYNC();
    RUN(12) { PP(); PH_IDS(); for (int task = gw; task < 256; task += NGW) cmp2_task(p, task, lane); }
    GSYNC();
    RUN(13) { PP(); for (int u = blockIdx.x; u < 1024; u += G) nsa_unit<(SKIP >> 16)>(p, lds, u); }
    GSYNC();
    if (G == 256) {
    RUN(14) { PP(); pg8::Gemm g{NSA_OUT, NSA_OUT, NSA_OUT, 128, 128}; pg8::StaticOrder S; S.init((const bf16_t*)(p.ws + OFF_Y1), (const bf16_t*)(p.ws + OFF_W1OUT), T_, DM, NSA_OUT, G, vcu);
      pg8::EpiResidNorm E{(const float*)(p.ws + OFF_X1), nullptr, p.out, nullptr, p.final_norm, DM, (float*)(p.ws + OFF_LSE) + (size_t)T_ * 4, (unsigned*)(p.ws + OFF_CTRL + 16384 + 16384)};
      pg8::gemm_phase<pg8::EpiResidNorm, pg8::StaticOrder, false, true>(lds, g, S, E); }
    } else {
    RUN(14) { PP(); pg8::Gemm g{NSA_OUT, NSA_OUT, NSA_OUT, 128, 128}; pg8::StaticOrder S; S.init((const bf16_t*)(p.ws + OFF_Y1), (const bf16_t*)(p.ws + OFF_W1OUT), T_, DM, NSA_OUT, G, vcu);
      pg8::EpiResid E{(const float*)(p.ws + OFF_X1), p.out, DM};
      pg8::gemm_phase<pg8::EpiResid, pg8::StaticOrder, true, true>(lds, g, S, E); }
    GSYNC();
    RUN(15) { PP(); PH_IDS(); for (int m = gw; m < T_; m += NGW) rms_row_inplace(p.out + (size_t)m * DM, p.final_norm, lane); }
    }
    }
}

extern "C" void kernel_launch(void* const* d_in, const int* in_sizes, int n_in, void* d_out, int out_size, void* d_ws, size_t ws_size, hipStream_t stream) {
    static int grid_blocks = 0;
    if (!grid_blocks) {
        int dev = 0, cus = 0, per_cu = 0;
        (void)hipGetDevice(&dev);
        (void)hipDeviceGetAttribute(&cus, hipDeviceAttributeMultiprocessorCount, dev);
        if (hipFuncSetAttribute((const void*)mega<0u>, hipFuncAttributeMaxDynamicSharedMemorySize, LDS_BYTES) != hipSuccess) fprintf(stderr, "hipFuncSetAttribute failed\n");
#if PROBE_TWICE
        (void)hipFuncSetAttribute((const void*)mega<(unsigned)PROBE_SKIP>, hipFuncAttributeMaxDynamicSharedMemorySize, LDS_BYTES);
#endif
        (void)hipOccupancyMaxActiveBlocksPerMultiprocessor(&per_cu, (const void*)mega<0u>, NWAVES * 64, LDS_BYTES);
        if (per_cu < 1) fprintf(stderr, "occupancy query reports %d blocks per CU\n", per_cu);
        grid_blocks = cus;
        if (ws_size < WS_END) fprintf(stderr, "workspace too small: %zu < %zu\n", ws_size, (size_t)WS_END);
    }
    Params p{};
    const float** f = (const float**)&p;
    for (int i = 0; i < 26; ++i) f[i] = (const float*)d_in[i];
    p.out = (float*)d_out; p.ws = (unsigned char*)d_ws;
    void* args[] = {&p};
#if PROBE_TWICE
    (void)hipMemsetAsync((unsigned char*)d_ws + OFF_CTRL, 0, 16384 + 32768, stream);
    (void)hipLaunchCooperativeKernel((void*)mega<(unsigned)PROBE_SKIP>, dim3(grid_blocks), dim3(NWAVES * 64), args, LDS_BYTES, stream);
#endif
    (void)hipMemsetAsync((unsigned char*)d_ws + OFF_CTRL, 0, 16384 + 32768, stream);
    hipError_t e = hipLaunchCooperativeKernel((void*)mega<0u>, dim3(grid_blocks), dim3(NWAVES * 64), args, LDS_BYTES, stream);
    if (e != hipSuccess) fprintf(stderr, "cooperative launch failed: %s (grid %d)\n", hipGetErrorString(e), grid_blocks);
}
#endif
```

```cpp
#ifndef HOST_EMU
#include <hip/hip_runtime.h>
#include <hip/hip_cooperative_groups.h>
namespace cg = cooperative_groups;
#define DEVFN __device__ __forceinline__
#define DEVNI __device__ __forceinline__
#else
#include <cmath>
#include <cstdint>
#include <cstring>
#define DEVFN static inline
#define DEVNI static
#endif
#include <cstdio>
#include <cstdint>

#ifndef BATCH_
#define BATCH_ 8
#endif
#ifndef DM_
#define DM_ 1024
#endif

typedef unsigned short bf16_t;
constexpr int SEQ = 2048, NB = BATCH_, T_ = NB * SEQ, DM = DM_, NMEM = 256;
constexpr int HAWK_IN = 7680, HAWK_OUT = 1792, NSA_IN = 3376, NSA_INP = 3584, NSA_OUT = 1280;
constexpr float EPS = 1e-6f;

DEVFN float bf2f(bf16_t h) { union { unsigned u; float f; } c; c.u = (unsigned)h << 16; return c.f; }
DEVFN bf16_t f2bf(float f) { union { unsigned u; float f; } c; c.f = f; unsigned u = c.u; u += 0x7fffu + ((u >> 16) & 1u); return (bf16_t)(u >> 16); }
DEVFN float sigmoidf_(float x) { return 1.0f / (1.0f + expf(-x)); }
DEVFN float siluf_(float x) { return x / (1.0f + expf(-x)); }

constexpr size_t al256(size_t x) { return (x + 255) & ~(size_t)255; }
constexpr size_t OFF_CTRL = 0;
constexpr size_t OFF_W0OUT = 65536;
constexpr size_t OFF_W1IN = OFF_W0OUT + al256((size_t)DM * HAWK_OUT * 2);
constexpr size_t OFF_W1OUT = OFF_W1IN + al256((size_t)NSA_INP * DM * 2);
constexpr size_t OFF_PHIW1 = OFF_W1OUT + al256((size_t)DM * NSA_OUT * 2);
constexpr size_t OFF_MEMKV = OFF_PHIW1 + al256((size_t)2 * 256 * 2048 * 2);
constexpr size_t OFF_LSE = OFF_MEMKV + al256((size_t)2 * NB * NMEM * 512 * 2);
constexpr size_t OFF_PEB = OFF_LSE + al256((size_t)3 * T_ * 4 * 4) + 65536;
constexpr size_t OFF_PHIW2 = OFF_LSE + al256((size_t)3 * T_ * 4 * 4);
constexpr size_t OFF_PEBS = OFF_PHIW2 + 65536 + 131072;
constexpr size_t OFF_WMKV = OFF_PEBS + 4096;
constexpr size_t OFF_RA = OFF_WMKV + al256((size_t)2 * 512 * DM * 2);
constexpr size_t RA_BYTES = (size_t)T_ * 1792 * 2;
constexpr size_t OFF_XN = OFF_RA;
constexpr size_t OFF_W0IN = OFF_RA + (size_t)T_ * 1024 * 2;
constexpr size_t OFF_MEMN = OFF_W0IN + (size_t)HAWK_IN * DM * 2;
static_assert(OFF_MEMN + (size_t)NB * NMEM * DM * 2 <= OFF_RA + RA_BYTES, "region A: MEMN");
constexpr size_t OFF_Y0 = OFF_RA;
constexpr size_t OFF_Y1 = OFF_RA;
constexpr size_t OFF_CMPH = OFF_RA + (size_t)T_ * 1280 * 2;
constexpr size_t OFF_CMPKV = OFF_CMPH + al256((size_t)2 * NB * 2 * 128 * 256 * 4);
constexpr size_t OFF_SEL = OFF_CMPKV + al256((size_t)2 * NB * 2 * 128 * 64 * 4);
constexpr size_t OFF_IMP = OFF_SEL + al256((size_t)NB * 2 * SEQ * 4);
static_assert(OFF_W0IN + (size_t)HAWK_IN * DM * 2 <= OFF_RA + RA_BYTES, "region A: XN0 | W0IN");
static_assert(OFF_IMP + (size_t)NB * 2 * SEQ * 32 * 4 <= OFF_RA + RA_BYTES, "region A: layer-1 temporaries");
constexpr size_t OFF_Q = OFF_RA + RA_BYTES;
constexpr size_t OFF_K = OFF_Q + (size_t)T_ * 1536 * 2;
constexpr size_t OFF_V = OFF_K + (size_t)T_ * 1536 * 2;
constexpr size_t OFF_ZB = OFF_V + (size_t)T_ * 1536 * 2;
constexpr size_t OFF_QM = OFF_ZB + (size_t)T_ * 512 * 2;
constexpr size_t OFF_ZM = OFF_QM + (size_t)T_ * 256 * 2;
constexpr size_t WS_END = OFF_ZM + (size_t)T_ * 256 * 2;
constexpr size_t OFF_X1 = OFF_K;
constexpr size_t OFF_Z1 = OFF_K + (size_t)T_ * 1024 * 4;
constexpr size_t OFF_Q1 = OFF_Q;
constexpr size_t OFF_QM1 = OFF_Q + (size_t)T_ * 1024 * 2;
constexpr size_t OFF_ZM1 = OFF_QM1 + (size_t)T_ * 256 * 2;
constexpr size_t OFF_KV1 = OFF_ZB;
constexpr size_t OFF_GATE = OFF_ZM;
static_assert(OFF_Z1 + (size_t)T_ * 1024 * 2 <= OFF_ZB, "Z1 overlay");
static_assert(BATCH_ != 8 || DM_ != 1024 || WS_END <= (size_t)256 * 1024 * 1024, "workspace too big");

struct Params {
    const float *x, *mem, *hawk_norm, *hawk_w_in, *conv_w, *conv_b, *ga_w, *ga_b, *gx_w, *gx_b, *lam, *hawk_mem_norm, *hawk_w_mem_kv, *hawk_w_out;
    const float *nsa_norm, *nsa_w_in, *pe_k, *pe_v, *phik_w1, *phik_w2, *phiv_w1, *phiv_w2, *nsa_mem_norm, *nsa_w_mem_kv, *nsa_w_out, *final_norm;
    float* out; unsigned char* ws;
};

DEVFN int nsa_col_orig(int n) {
    if (n < 1792) return n;
    if (n < 2816) return n - 1792 + 1840;
    if (n < 3072) return n - 2816 + 2864;
    if (n < 3328) return n - 3072 + 3120;
    if (n < 3376) return n - 3328 + 1792;
    return -1;
}

DEVFN void p0_convert(const Params& p, long gt, long nt) {
    bf16_t* w0in = (bf16_t*)(p.ws + OFF_W0IN); bf16_t* w0out = (bf16_t*)(p.ws + OFF_W0OUT);
    bf16_t* w1in = (bf16_t*)(p.ws + OFF_W1IN); bf16_t* w1out = (bf16_t*)(p.ws + OFF_W1OUT); bf16_t* phiw1 = (bf16_t*)(p.ws + OFF_PHIW1);
    for (long i = gt; i < (long)DM * HAWK_IN; i += nt) { const int k = (int)(i / HAWK_IN), n = (int)(i % HAWK_IN); w0in[(size_t)n * DM + k] = f2bf(p.hawk_w_in[i]); }
    for (long i = gt; i < (long)HAWK_OUT * DM; i += nt) { const int k = (int)(i / DM), n = (int)(i % DM); w0out[(size_t)n * HAWK_OUT + k] = f2bf(p.hawk_w_out[i]); }
    for (long i = gt; i < (long)DM * NSA_INP; i += nt) { const int k = (int)(i / NSA_INP), n = (int)(i % NSA_INP); const int no = nsa_col_orig(n);
        w1in[(size_t)n * DM + k] = no >= 0 ? f2bf(p.nsa_w_in[(size_t)k * NSA_IN + no]) : (bf16_t)0; }
    for (long i = gt; i < (long)NSA_OUT * DM; i += nt) { const int k = (int)(i / DM), n = (int)(i % DM); w1out[(size_t)n * NSA_OUT + k] = f2bf(p.nsa_w_out[i]); }
    for (long i = gt; i < (long)2 * 2048 * 256; i += nt) { const int kv = (int)(i / (2048 * 256)), r = (int)(i % (2048 * 256)), k = r / 256, n = r % 256;
        phiw1[(size_t)kv * 256 * 2048 + (size_t)n * 2048 + k] = f2bf((kv ? p.phiv_w1 : p.phik_w1)[r]); }
}
DEVFN void rows_rmsnorm(const float* x, const float* g, bf16_t* xn, long gt, long nt) {
    for (long r = gt; r < T_; r += nt) {
        const float* xr = x + (size_t)r * DM; float ss = 0.f;
        for (int k = 0; k < DM; ++k) ss += xr[k] * xr[k];
        const float rs = 1.0f / sqrtf(ss / DM + EPS);
        for (int k = 0; k < DM; ++k) xn[(size_t)r * DM + k] = f2bf(xr[k] * rs * g[k]);
    }
}
DEVFN void p0_memkv(const Params& p, long gt, long nt) {
    bf16_t* mkv = (bf16_t*)(p.ws + OFF_MEMKV);
    for (long i = gt; i < (long)2 * NB * NMEM * 512; i += nt) {
        const int l = (int)(i / ((long)NB * NMEM * 512)), r = (int)((i / 512) % (NB * NMEM)), c = (int)(i % 512);
        const float* mr = p.mem + (size_t)r * DM; const float* g = l ? p.nsa_mem_norm : p.hawk_mem_norm; const float* w = l ? p.nsa_w_mem_kv : p.hawk_w_mem_kv;
        float ss = 0.f, acc = 0.f;
        for (int k = 0; k < DM; ++k) { const float v = mr[k]; ss += v * v; acc += v * g[k] * w[(size_t)k * 512 + c]; }
        mkv[i] = f2bf(acc / sqrtf(ss / DM + EPS));
    }
}

struct __attribute__((aligned(16))) U4 { unsigned x, y, z, w; };
DEVFN float lo16(unsigned u) { union { unsigned u; float f; } c; c.u = u << 16; return c.f; }
DEVFN float hi16(unsigned u) { union { unsigned u; float f; } c; c.u = u & 0xffff0000u; return c.f; }
DEVFN float dot_bf16(const bf16_t* a, const bf16_t* b, int n) {
    float s0 = 0.f, s1 = 0.f, s2 = 0.f, s3 = 0.f;
    for (int k = 0; k < n; k += 8) { const U4 va = *(const U4*)(a + k), vb = *(const U4*)(b + k);
        s0 += lo16(va.x) * lo16(vb.x) + hi16(va.x) * hi16(vb.x); s1 += lo16(va.y) * lo16(vb.y) + hi16(va.y) * hi16(vb.y);
        s2 += lo16(va.z) * lo16(vb.z) + hi16(va.z) * hi16(vb.z); s3 += lo16(va.w) * lo16(vb.w) + hi16(va.w) * hi16(vb.w); }
    return (s0 + s1) + (s2 + s3);
}

DEVFN void p1_gemm(const Params& p, long gt, long nt) {
    const bf16_t* xn = (const bf16_t*)(p.ws + OFF_XN); const bf16_t* w = (const bf16_t*)(p.ws + OFF_W0IN);
    bf16_t* xaza = (bf16_t*)p.out;
    for (long i = gt; i < (long)T_ * HAWK_IN; i += nt) {
        const int t = (int)(i / HAWK_IN), n = (int)(i % HAWK_IN);
        const bf16_t v = f2bf(dot_bf16(xn + (size_t)t * DM, w + (size_t)n * DM, DM));
        if (n < 2048) xaza[(size_t)t * 2048 + n] = v;
        else if (n < 3584) ((bf16_t*)(p.ws + OFF_Q))[(size_t)t * 1536 + n - 2048] = v;
        else if (n < 5120) ((bf16_t*)(p.ws + OFF_K))[(size_t)t * 1536 + n - 3584] = v;
        else if (n < 6656) ((bf16_t*)(p.ws + OFF_V))[(size_t)t * 1536 + n - 5120] = v;
        else if (n < 7168) ((bf16_t*)(p.ws + OFF_ZB))[(size_t)t * 512 + n - 6656] = v;
        else if (n < 7424) ((bf16_t*)(p.ws + OFF_QM))[(size_t)t * 256 + n - 7168] = v;
        else ((bf16_t*)(p.ws + OFF_ZM))[(size_t)t * 256 + n - 7424] = v;
    }
}

DEVFN void p2_lru(const Params& p, long gt, long nt) {
    const bf16_t* xaza = (const bf16_t*)p.out; bf16_t* Y0 = (bf16_t*)(p.ws + OFF_Y0);
    for (long i = gt; i < (long)NB * 1024; i += nt) {
        const int b = (int)(i / 1024), c = (int)(i % 1024), blk = c >> 6, j = c & 63;
        const float sp = log1pf(expf(-p.lam[c]));
        const float* gaw = p.ga_w + (size_t)blk * 4096; const float* gxw = p.gx_w + (size_t)blk * 4096;
        float h = 0.f;
        for (int t = 0; t < SEQ; ++t) {
            float ra = p.ga_b[c], ri = p.gx_b[c], xcj = 0.f;
            for (int ii = 0; ii < 64; ++ii) {
                const int cc = blk * 64 + ii; float xc = p.conv_b[cc];
                for (int k = 0; k < 4; ++k) { const int tt = t - 3 + k; if (tt >= 0) xc += p.conv_w[k * 1024 + cc] * bf2f(xaza[((size_t)b * SEQ + tt) * 2048 + cc]); }
                ra += xc * gaw[ii * 64 + j]; ri += xc * gxw[ii * 64 + j];
                if (ii == j) xcj = xc;
            }
            const float r = sigmoidf_(ra), ig = sigmoidf_(ri);
            const float log_a = -8.0f * r * sp, a = expf(log_a);
            const float mult = t == 0 ? 1.0f : sqrtf(-expm1f(2.0f * log_a));
            h = a * h + xcj * ig * mult;
            const size_t tt0 = (size_t)b * SEQ + t;
            Y0[tt0 * 1792 + c] = f2bf(h * siluf_(bf2f(xaza[tt0 * 2048 + 1024 + c])));
        }
    }
}
DEVNI void p2_dilated(const Params& p, long gt, long nt) {
    bf16_t* Q = (bf16_t*)(p.ws + OFF_Q); const bf16_t* K = (const bf16_t*)(p.ws + OFF_K); const bf16_t* V = (const bf16_t*)(p.ws + OFF_V);
    float* LSE = (float*)(p.ws + OFF_LSE);
    for (long i = gt; i < (long)T_ * 12; i += nt) {
        const int t = (int)(i / 12), hh = (int)(i % 12), g = hh >> 2, h = hh & 3, s = t % SEQ;
        const int dil = g == 0 ? 1 : (g == 1 ? 4 : 16);
        const float slope = exp2f(-8.0f * (float)(hh + 1) / 12.0f), scale = 0.08838834764831845f;
        bf16_t* qp = Q + (size_t)t * 1536 + hh * 128;
        float o[128], m = -1e30f, l = 0.f;
#pragma unroll
        for (int d = 0; d < 128; ++d) o[d] = 0.f;
        for (int jj = 0; jj <= 128; ++jj) {
            const int sk = s - jj * dil; if (sk < 0) break;
            const bf16_t* kp = K + (size_t)(t - jj * dil) * 1536 + hh * 128; const bf16_t* vp = V + (size_t)(t - jj * dil) * 1536 + hh * 128;
            float sc = 0.f;
#pragma nounroll
            for (int d = 0; d < 128; ++d) sc += bf2f(qp[d]) * bf2f(kp[d]);
            sc = sc * scale - slope * (float)(jj * dil);
            const float mn = fmaxf(m, sc), al = expf(m - mn), pe = expf(sc - mn);
            l = l * al + pe; m = mn;
#pragma unroll
            for (int d = 0; d < 128; ++d) o[d] = o[d] * al + pe * bf2f(vp[d]);
        }
        const float inv = 1.0f / l;
#pragma unroll
        for (int d = 0; d < 128; ++d) qp[d] = f2bf(o[d] * inv);
        LSE[((size_t)g * T_ + t) * 4 + h] = m + logf(l);
    }
}
DEVFN void p2_combine(const Params& p, long gt, long nt) {
    const bf16_t* Q = (const bf16_t*)(p.ws + OFF_Q); const bf16_t* ZB = (const bf16_t*)(p.ws + OFF_ZB); const float* LSE = (const float*)(p.ws + OFF_LSE); bf16_t* Y0 = (bf16_t*)(p.ws + OFF_Y0);
    for (long i = gt; i < (long)T_ * 512; i += nt) {
        const int t = (int)(i / 512), c = (int)(i % 512), h = c >> 7;
        const float l0 = LSE[((size_t)0 * T_ + t) * 4 + h], l1 = LSE[((size_t)1 * T_ + t) * 4 + h], l2 = LSE[((size_t)2 * T_ + t) * 4 + h];
        const float mx = fmaxf(l0, fmaxf(l1, l2)), e0 = expf(l0 - mx), e1 = expf(l1 - mx), e2 = expf(l2 - mx), inv = 1.0f / (e0 + e1 + e2);
        const float o = (e0 * bf2f(Q[(size_t)t * 1536 + c]) + e1 * bf2f(Q[(size_t)t * 1536 + 512 + c]) + e2 * bf2f(Q[(size_t)t * 1536 + 1024 + c])) * inv;
        Y0[(size_t)t * 1792 + 1024 + c] = f2bf(o * siluf_(bf2f(ZB[i])));
    }
}
DEVNI void mem_attn(const bf16_t* mkv, const bf16_t* QMb, const bf16_t* ZMb, bf16_t* Y, int ldy, long gt, long nt) {
    for (long i = gt; i < (long)T_ * 4; i += nt) {
        const int t = (int)(i / 4), h = (int)(i % 4), b = t / SEQ;
        const bf16_t* qp = QMb + (size_t)t * 256 + h * 64;
        float o[64], m = -1e30f, l = 0.f;
#pragma unroll
        for (int d = 0; d < 64; ++d) o[d] = 0.f;
        for (int j = 0; j < NMEM; ++j) {
            const bf16_t* kp = mkv + ((size_t)b * NMEM + j) * 512 + h * 64; const bf16_t* vp = kp + 256;
            float sc = 0.f;
#pragma nounroll
            for (int d = 0; d < 64; ++d) sc += bf2f(qp[d]) * bf2f(kp[d]);
            sc *= 0.125f;
            const float mn = fmaxf(m, sc), al = expf(m - mn), pe = expf(sc - mn);
            l = l * al + pe; m = mn;
#pragma unroll
            for (int d = 0; d < 64; ++d) o[d] = o[d] * al + pe * bf2f(vp[d]);
        }
        const float inv = 1.0f / l;
#pragma unroll
        for (int d = 0; d < 64; ++d) Y[(size_t)t * ldy + h * 64 + d] = f2bf(o[d] * inv * siluf_(bf2f(ZMb[(size_t)t * 256 + h * 64 + d])));
    }
}

DEVFN void p3_gemm(const Params& p, long gt, long nt) {
    const bf16_t* y = (const bf16_t*)(p.ws + OFF_Y0); const bf16_t* w = (const bf16_t*)(p.ws + OFF_W0OUT); float* x1 = (float*)(p.ws + OFF_X1);
    for (long i = gt; i < (long)T_ * DM; i += nt) {
        const int t = (int)(i / DM), n = (int)(i % DM);
        x1[i] = p.x[i] + dot_bf16(y + (size_t)t * HAWK_OUT, w + (size_t)n * HAWK_OUT, HAWK_OUT);
    }
}
DEVFN void p4_gemm(const Params& p, long gt, long nt) {
    const bf16_t* xn = (const bf16_t*)(p.ws + OFF_XN); const bf16_t* w = (const bf16_t*)(p.ws + OFF_W1IN);
    for (long i = gt; i < (long)T_ * NSA_IN; i += nt) {
        const int t = (int)(i / NSA_IN), n = (int)(i % NSA_IN);
        const float a = dot_bf16(xn + (size_t)t * DM, w + (size_t)n * DM, DM); const bf16_t v = f2bf(a);
        if (n < 1024) ((bf16_t*)(p.ws + OFF_Q1))[(size_t)t * 1024 + n] = v;
        else if (n < 1792) ((bf16_t*)(p.ws + OFF_KV1))[(size_t)t * 768 + n - 1024] = v;
        else if (n < 2816) ((bf16_t*)(p.ws + OFF_Z1))[(size_t)t * 1024 + n - 1792] = v;
        else if (n < 3072) ((bf16_t*)(p.ws + OFF_QM1))[(size_t)t * 256 + n - 2816] = v;
        else if (n < 3328) ((bf16_t*)(p.ws + OFF_ZM1))[(size_t)t * 256 + n - 3072] = v;
        else ((bf16_t*)(p.ws + OFF_GATE))[(size_t)t * 256 + n - 3328] = v;
    }
}
DEVFN void p5_cmp1(const Params& p, long gt, long nt) {
    const bf16_t* KV = (const bf16_t*)(p.ws + OFF_KV1); const bf16_t* w1 = (const bf16_t*)(p.ws + OFF_PHIW1); float* hid = (float*)(p.ws + OFF_CMPH);
    for (long i = gt; i < (long)2 * NB * 2 * 127 * 256; i += nt) {
        const int j = (int)(i % 256); long r = i / 256; const int n = (int)(r % 127); r /= 127; const int g = (int)(r % 2); r /= 2; const int b = (int)(r % NB), kv = (int)(r / NB);
        const float* pe = kv ? p.pe_v : p.pe_k; const bf16_t* wj = w1 + ((size_t)kv * 256 + j) * 2048;
        float acc = 0.f;
        for (int ii = 0; ii < 32; ++ii) { const bf16_t* tp = KV + ((size_t)b * SEQ + 16 * n + ii) * 768 + kv * 128 + g * 64;
            for (int d = 0; d < 64; ++d) acc += (bf2f(tp[d]) + pe[ii * 64 + d]) * bf2f(wj[ii * 64 + d]); }
        hid[((((size_t)kv * NB + b) * 2 + g) * 128 + n) * 256 + j] = siluf_(acc);
    }
}
DEVFN void p5_cmp2(const Params& p, long gt, long nt) {
    const float* hid = (const float*)(p.ws + OFF_CMPH); bf16_t* ckv = (bf16_t*)(p.ws + OFF_CMPKV);
    for (long i = gt; i < (long)2 * NB * 2 * 128 * 64; i += nt) {
        const int d = (int)(i % 64); long r = i / 64; const int n = (int)(r % 128); r /= 128; const int g = (int)(r % 2); r /= 2; const int b = (int)(r % NB), kv = (int)(r / NB);
        const float* w2 = kv ? p.phiv_w2 : p.phik_w2; const size_t row = (((size_t)kv * NB + b) * 2 + g) * 128 + n;
        float acc = 0.f;
        if (n < 127) for (int j = 0; j < 256; ++j) acc += hid[row * 256 + j] * w2[j * 64 + d];
        ckv[row * 64 + d] = f2bf(acc);
    }
}
DEVNI void p5_cmp_attn(const Params& p, long gt, long nt) {
    const bf16_t* Q1 = (const bf16_t*)(p.ws + OFF_Q1); const bf16_t* ckv = (const bf16_t*)(p.ws + OFF_CMPKV); const bf16_t* gate = (const bf16_t*)(p.ws + OFF_GATE);
    unsigned* SEL = (unsigned*)(p.ws + OFF_SEL); float* ocmp = p.out; float* IMP = (float*)(p.ws + OFF_IMP);
    for (long i = gt; i < (long)NB * 2 * SEQ; i += nt) {
        const int s = (int)(i % SEQ), g = (int)((i / SEQ) % 2), b = (int)(i / (2 * SEQ)); const int t = b * SEQ + s;
        const bf16_t* kc = ckv + (((size_t)0 * NB + b) * 2 + g) * 128 * 64; const bf16_t* vc = ckv + (((size_t)1 * NB + b) * 2 + g) * 128 * 64;
        const int nvis = s >= 31 ? (s - 31) / 16 + 1 : 0;
        float* imp = IMP + (size_t)i * 32;
        for (int r = 0; r < 8; ++r) {
            const int hidx = g * 8 + r; const float slope = exp2f(-0.5f * (float)(hidx + 1));
            const bf16_t* qp = Q1 + (size_t)t * 1024 + hidx * 64;
            float m = -1e30f;
            for (int n = 0; n < nvis; ++n) { float sc = 0.f;
_Pragma("nounroll") for (int d = 0; d < 64; ++d) sc += bf2f(qp[d]) * bf2f(kc[n * 64 + d]);
                sc = sc * 0.125f - slope * (float)(s - (16 * n + 31)); m = fmaxf(m, sc); }
            float l = 0.f;
            for (int n = 0; n < nvis; ++n) { float sc = 0.f;
_Pragma("nounroll") for (int d = 0; d < 64; ++d) sc += bf2f(qp[d]) * bf2f(kc[n * 64 + d]);
                sc = sc * 0.125f - slope * (float)(s - (16 * n + 31)); l += expf(sc - m); }
            const float inv = nvis > 0 ? 1.0f / l : 0.f;
            float o[64];
#pragma unroll
            for (int d = 0; d < 64; ++d) o[d] = 0.f;
            float carry = 0.f;
            for (int j = 0; j < 32; ++j) {
                float acc = carry; carry = 0.f;
                for (int q4 = 0; q4 < 4; ++q4) { const int n = 4 * j + q4;
                    if (n < nvis) { float sc = 0.f;
_Pragma("nounroll") for (int d = 0; d < 64; ++d) sc += bf2f(qp[d]) * bf2f(kc[n * 64 + d]);
                        sc = sc * 0.125f - slope * (float)(s - (16 * n + 31)); const float pr = expf(sc - m) * inv;
                        acc += pr; if (q4 == 3) carry = pr;
#pragma unroll
                        for (int d = 0; d < 64; ++d) o[d] += pr * bf2f(vc[n * 64 + d]); } }
                imp[j] = (r == 0 ? 0.f : imp[j]) + acc;
            }
            const float g0 = sigmoidf_(bf2f(gate[(size_t)t * 256 + hidx * 3 + 0]));
#pragma unroll
            for (int d = 0; d < 64; ++d) ocmp[(size_t)t * 1024 + hidx * 64 + d] = g0 * o[d];
        }
        const int cur = s >> 6; unsigned mask = 1u | (1u << cur) | (cur > 0 ? (1u << (cur - 1)) : 0u);
        const int nf = cur == 0 ? 1 : (cur == 1 ? 2 : 3), need = 8 - nf;
        for (int j = 1; j < 30; ++j) {
            if (j <= cur - 2) { int rank = 0;
                for (int j2 = 1; j2 < 30; ++j2) if (j2 <= cur - 2 && j2 != j) rank += (imp[j2] > imp[j] || (imp[j2] == imp[j] && j2 < j)) ? 1 : 0;
                if (rank < need) mask |= 1u << j; }
        }
        SEL[i] = mask;
    }
}
DEVNI void p5_slc_win(const Params& p, long gt, long nt) {
    const bf16_t* Q1 = (const bf16_t*)(p.ws + OFF_Q1); const bf16_t* KV = (const bf16_t*)(p.ws + OFF_KV1); const bf16_t* gate = (const bf16_t*)(p.ws + OFF_GATE);
    const unsigned* SEL = (const unsigned*)(p.ws + OFF_SEL); const float* ocmp = p.out; const bf16_t* Z1 = (const bf16_t*)(p.ws + OFF_Z1); bf16_t* Y1 = (bf16_t*)(p.ws + OFF_Y1);
    for (long i = gt; i < (long)T_ * 16; i += nt) {
        const int t = (int)(i / 16), hidx = (int)(i % 16), g = hidx >> 3, b = t / SEQ, s = t % SEQ;
        const float slope = exp2f(-0.5f * (float)(hidx + 1));
        const bf16_t* qp = Q1 + (size_t)t * 1024 + hidx * 64;
        const unsigned mask = SEL[((size_t)b * 2 + g) * SEQ + s];
        float res[64];
        {
            float o[64], m = -1e30f, l = 0.f;
#pragma unroll
            for (int d = 0; d < 64; ++d) o[d] = 0.f;
            for (int j = 0; j < 32; ++j) { if (!((mask >> j) & 1u)) continue;
                for (int kk = 0; kk < 64; ++kk) { const int kpos = j * 64 + kk; if (kpos > s) break;
                    const bf16_t* kp = KV + ((size_t)b * SEQ + kpos) * 768 + 2 * 128 + g * 64; const bf16_t* vp = kp + 128;
                    float sc = 0.f;
#pragma nounroll
                    for (int d = 0; d < 64; ++d) sc += bf2f(qp[d]) * bf2f(kp[d]);
                    sc = sc * 0.125f - slope * (float)(s - kpos);
                    const float mn = fmaxf(m, sc), al = expf(m - mn), pe = expf(sc - mn); l = l * al + pe; m = mn;
#pragma unroll
                    for (int d = 0; d < 64; ++d) o[d] = o[d] * al + pe * bf2f(vp[d]); } }
            const float g1 = sigmoidf_(bf2f(gate[(size_t)t * 256 + hidx * 3 + 1])) / l;
#pragma unroll
            for (int d = 0; d < 64; ++d) res[d] = ocmp[(size_t)t * 1024 + hidx * 64 + d] + g1 * o[d];
        }
        {
            float o[64], m = -1e30f, l = 0.f;
#pragma unroll
            for (int d = 0; d < 64; ++d) o[d] = 0.f;
            for (int kpos = (s - 511 > 0 ? s - 511 : 0); kpos <= s; ++kpos) {
                const bf16_t* kp = KV + ((size_t)b * SEQ + kpos) * 768 + 4 * 128 + g * 64; const bf16_t* vp = kp + 128;
                float sc = 0.f;
#pragma nounroll
                for (int d = 0; d < 64; ++d) sc += bf2f(qp[d]) * bf2f(kp[d]);
                sc = sc * 0.125f - slope * (float)(s - kpos);
                const float mn = fmaxf(m, sc), al = expf(m - mn), pe = expf(sc - mn); l = l * al + pe; m = mn;
#pragma unroll
                for (int d = 0; d < 64; ++d) o[d] = o[d] * al + pe * bf2f(vp[d]); }
            const float g2 = sigmoidf_(bf2f(gate[(size_t)t * 256 + hidx * 3 + 2])) / l;
#pragma unroll
            for (int d = 0; d < 64; ++d) res[d] += g2 * o[d];
        }
#pragma unroll
        for (int d = 0; d < 64; ++d) Y1[(size_t)t * 1280 + hidx * 64 + d] = f2bf(res[d] * siluf_(bf2f(Z1[(size_t)t * 1024 + hidx * 64 + d])));
    }
}
DEVFN void p6_gemm(const Params& p, long gt, long nt) {
    const bf16_t* y = (const bf16_t*)(p.ws + OFF_Y1); const bf16_t* w = (const bf16_t*)(p.ws + OFF_W1OUT); const float* x1 = (const float*)(p.ws + OFF_X1);
    for (long i = gt; i < (long)T_ * DM; i += nt) {
        const int t = (int)(i / DM), n = (int)(i % DM);
        p.out[i] = x1[i] + dot_bf16(y + (size_t)t * NSA_OUT, w + (size_t)n * NSA_OUT, NSA_OUT);
    }
}
DEVFN void p7_final(const Params& p, long gt, long nt) {
    for (long r = gt; r < T_; r += nt) {
        float* xr = p.out + (size_t)r * DM; float ss = 0.f;
        for (int k = 0; k < DM; ++k) ss += xr[k] * xr[k];
        const float rs = 1.0f / sqrtf(ss / DM + EPS);
        for (int k = 0; k < DM; ++k) xr[k] = xr[k] * rs * p.final_norm[k];
    }
}

#ifndef HOST_EMU
static_assert(DM == 1024 && NB == 8, "device build is for the real shapes");
#define LAS __attribute__((address_space(3)))
#define GAS __attribute__((address_space(1)))
typedef unsigned v4u __attribute__((ext_vector_type(4)));
typedef float f32x4 __attribute__((ext_vector_type(4)));
typedef short bf16x8 __attribute__((ext_vector_type(8)));
typedef unsigned v2u __attribute__((ext_vector_type(2)));
#define LDS_WAIT() asm volatile("s_waitcnt lgkmcnt(0)" ::: "memory")
#define VM_WAIT() asm volatile("s_waitcnt vmcnt(0)" ::: "memory")
__device__ __forceinline__ unsigned pk2(float lo, float hi) { return (unsigned)f2bf(lo) | ((unsigned)f2bf(hi) << 16); }

__device__ __forceinline__ int fresh_tid();
namespace pg8 {
constexpr int BM = 256, BK = 64, HALF = 128, HTB = HALF * BK * 2  , STAGE_BYTES = 8 * HTB, NXCD = 8, WGM = 8;
__host__ __device__ __forceinline__ int lds_byte(int r, int c) { const int st = (r >> 4) * 2 + (c >> 5), rr = r & 15, cc = c & 31, ob = rr * 64 + cc * 2; return st * 1024 + (ob ^ (((ob >> 9) & 1) << 5)); }
__host__ __device__ __forceinline__ void stage_rc(int b, int& R, int& C) { const int st = b / 1024, sb = b % 1024, swz = sb ^ (((sb >> 9) & 1) << 5); R = (st >> 1) * 16 + swz / 64; C = (st & 1) * 32 + (swz % 64) / 2; }
__host__ __device__ __forceinline__ int perm32(int rho) { const int n = rho >> 4, i = rho & 15; return 8 * (i >> 2) + 4 * n + (i & 3); }
struct Unit { int pm, pn, tag; const char* A; const char* B; };
struct Gemm { int K, lda, ldb, kstepA, kstepB; };
struct StaticOrder {
    int nM, nN, nwg, G, c, K; const char* A; const char* B; int nE, nNe; const char* Ae; const char* Be;
    __host__ __device__ void init(const bf16_t* A_, const bf16_t* B_, int M, int N, int K_, int G_, int c_) { A = (const char*)A_; B = (const char*)B_; K = K_; nM = M / BM; nN = N / BM; nwg = nM * nN; G = G_; c = c_; nE = 0; nNe = 1; Ae = Be = nullptr; }
    __host__ __device__ void extra(const bf16_t* A_, const bf16_t* B_, int M, int N) { Ae = (const char*)A_; Be = (const char*)B_; nNe = N / BM; nE = (M / BM) * nNe; }
    __host__ __device__ bool next(int i, Unit& u) const {
        const long L = (long)i * G + c; const size_t tstep = (size_t)BM * K * 2;
        if (L >= nwg) { const long e = L - nwg; if (e >= nE) return false; u.pm = (int)(e / nNe); u.pn = (int)(e % nNe); u.tag = 1; u.A = Ae + (size_t)u.pm * tstep; u.B = Be + (size_t)u.pn * tstep; return true; }
        int wgid = (int)L; { const int q = nwg / NXCD, r = nwg % NXCD, xcd = wgid % NXCD, off = wgid / NXCD; wgid = (xcd < r ? xcd * (q + 1) : r * (q + 1) + (xcd - r) * q) + off; }
        const int nig = WGM * nN, gid = wgid / nig, fm = gid * WGM, gsz = (nM - fm) < WGM ? (nM - fm) : WGM;
        u.pm = fm + ((wgid % nig) % gsz); u.pn = (wgid % nig) / gsz; u.tag = 0; u.A = A + (size_t)u.pm * tstep; u.B = B + (size_t)u.pn * tstep; return true;
    }
    __device__ __forceinline__ void a_ready(const Unit&) const {}
    __device__ __forceinline__ void done(const Unit&) const {}
};
struct OneUnit {
    Unit u; bool have;
    __host__ __device__ bool next(int i, Unit& o) const { if (i != 0 || !have) return false; o = u; return true; }
    __device__ __forceinline__ void a_ready(const Unit&) const {}
    __device__ __forceinline__ void done(const Unit&) const {}
};
typedef __bf16 bf16x2_t __attribute__((ext_vector_type(2)));
__device__ __forceinline__ unsigned cvt_pk_bf16(float lo, float hi) { const bf16x2_t v = {(__bf16)lo, (__bf16)hi}; return __builtin_bit_cast(unsigned, v); }

struct EpiRoute {
    static constexpr bool PERM = true, AFTER_DRAIN = false;
    unsigned char* ws; bf16_t* xaza; int layer;
    __device__ __forceinline__ void operator()(const f32x4 (&acc)[2][2][4][2], const Unit& u, int wr, int wc, int fr, int fq) const {
        bf16_t* base; int ldc, colt; const int pn = u.pn;
        if (u.tag == 1) { base = (bf16_t*)(ws + OFF_MEMKV) + (size_t)(pn >> 1) * NB * NMEM * 512; ldc = 512; colt = (pn & 1) * 256; }
        else if (layer == 0) {
            if (pn < 8) { base = xaza; ldc = 2048; colt = pn * 256; }
            else if (pn < 14) { base = (bf16_t*)(ws + OFF_Q); ldc = 1536; colt = (pn - 8) * 256; }
            else if (pn < 20) { base = (bf16_t*)(ws + OFF_K); ldc = 1536; colt = (pn - 14) * 256; }
            else if (pn < 26) { base = (bf16_t*)(ws + OFF_V); ldc = 1536; colt = (pn - 20) * 256; }
            else if (pn < 28) { base = (bf16_t*)(ws + OFF_ZB); ldc = 512; colt = (pn - 26) * 256; }
            else if (pn < 29) { base = (bf16_t*)(ws + OFF_QM); ldc = 256; colt = 0; }
            else { base = (bf16_t*)(ws + OFF_ZM); ldc = 256; colt = 0; }
        } else {
            if (pn < 4) { base = (bf16_t*)(ws + OFF_Q1); ldc = 1024; colt = pn * 256; }
            else if (pn < 7) { base = (bf16_t*)(ws + OFF_KV1); ldc = 768; colt = (pn - 4) * 256; }
            else if (pn < 11) { base = (bf16_t*)(ws + OFF_Z1); ldc = 1024; colt = (pn - 7) * 256; }
            else if (pn < 12) { base = (bf16_t*)(ws + OFF_QM1); ldc = 256; colt = 0; }
            else if (pn < 13) { base = (bf16_t*)(ws + OFF_ZM1); ldc = 256; colt = 0; }
            else { base = (bf16_t*)(ws + OFF_GATE); ldc = 256; colt = 0; }
        }
        const int row0 = u.pm * BM + wr * 64 + fr, col0 = colt + wc * 32 + 8 * fq;
        const bool act = u.tag == 0 && (layer == 0 ? ((pn >= 4 && pn < 8) || pn == 26 || pn == 27 || pn == 29) : ((pn >= 7 && pn < 11) || pn == 12));
#pragma unroll
        for (int ai = 0; ai < 2; ++ai)
#pragma unroll
            for (int m = 0; m < 4; ++m) { bf16_t* rowp = base + (size_t)(row0 + ai * HALF + m * 16) * ldc + col0;
#pragma unroll
                for (int bj = 0; bj < 2; ++bj) { f32x4 v0 = acc[ai][bj][m][0], v1 = acc[ai][bj][m][1];
                    if (act) {
#pragma unroll
                        for (int e = 0; e < 4; ++e) { v0[e] = v0[e] * __builtin_amdgcn_rcpf(1.0f + __builtin_amdgcn_exp2f(-v0[e] * 1.4426950408889634f)); v1[e] = v1[e] * __builtin_amdgcn_rcpf(1.0f + __builtin_amdgcn_exp2f(-v1[e] * 1.4426950408889634f)); } }
                    v4u w; w.x = cvt_pk_bf16(v0[0], v0[1]); w.y = cvt_pk_bf16(v0[2], v0[3]); w.z = cvt_pk_bf16(v1[0], v1[1]); w.w = cvt_pk_bf16(v1[2], v1[3]);
                    *(v4u*)(rowp + bj * HALF) = w; } }
    }
};
struct EpiResid {
    static constexpr bool PERM = false, AFTER_DRAIN = false;
    const float* base; float* out; int ldc;
    __device__ __forceinline__ void operator()(const f32x4 (&acc)[2][2][4][2], const Unit& u, int wr, int wc, int fr, int fq) const {
        const int col0 = u.pn * BM + wc * 32 + 4 * fq;
#pragma unroll
        for (int ai = 0; ai < 2; ++ai)
#pragma unroll
            for (int m = 0; m < 4; ++m) { const size_t off = (size_t)(u.pm * BM + ai * HALF + wr * 64 + m * 16 + fr) * ldc + col0;
#pragma unroll
                for (int bj = 0; bj < 2; ++bj)
#pragma unroll
                    for (int n = 0; n < 2; ++n) { const f32x4 bs = *(const f32x4*)(base + off + bj * HALF + n * 16); *(f32x4*)(out + off + bj * HALF + n * 16) = bs + acc[ai][bj][m][n]; } }
    }
};

struct EpiResidNorm {
    static constexpr bool PERM = false, AFTER_DRAIN = true;
    const float* base; float* outx; float* outn; bf16_t* xn; const float* gain; int ldc; float* xb; unsigned* cnt;
    __device__ __forceinline__ void fused(f32x4 (&acc)[2][2][4][2], const Unit& u, int wr, int wc, int fr, int fq, LAS unsigned char* lds, int wid, int lane) const {
        LAS float* P = (LAS float*)lds; LAS float* S = (LAS float*)(lds + 4096);
        const int col0 = u.pn * BM + wc * 32 + 4 * fq, tid = wid * 64 + lane;
#pragma unroll
        for (int ai = 0; ai < 2; ++ai)
#pragma unroll
            for (int m = 0; m < 4; ++m) { const int rl = ai * HALF + wr * 64 + m * 16 + fr; const size_t off = (size_t)(u.pm * BM + rl) * ldc + col0; float ss = 0.f;
#pragma unroll
                for (int bj = 0; bj < 2; ++bj)
#pragma unroll
                    for (int n = 0; n < 2; ++n) { const f32x4 v = *(const f32x4*)(base + off + bj * HALF + n * 16) + acc[ai][bj][m][n]; acc[ai][bj][m][n] = v;
                        if (outx) *(f32x4*)(outx + off + bj * HALF + n * 16) = v;
                        ss += (v[0] * v[0] + v[1] * v[1]) + (v[2] * v[2] + v[3] * v[3]); }
                ss += __shfl_xor(ss, 16); ss += __shfl_xor(ss, 32);
                if (fq == 0) P[rl * 4 + wc] = ss; }
        asm volatile("s_waitcnt lgkmcnt(0)" ::: "memory"); __builtin_amdgcn_s_barrier(); asm volatile("" ::: "memory");
        if (tid < 256) { const float t = (P[tid * 4] + P[tid * 4 + 1]) + (P[tid * 4 + 2] + P[tid * 4 + 3]);
            __hip_atomic_store((unsigned*)xb + ((size_t)(u.pm * BM + tid) * 4 + u.pn), __float_as_uint(t), __ATOMIC_RELAXED, __HIP_MEMORY_SCOPE_AGENT); }
        asm volatile("s_waitcnt vmcnt(0)" ::: "memory");
        if (tid < 256 && lane == 0) __hip_atomic_fetch_add(cnt + 64 * u.pm, 1u, __ATOMIC_RELAXED, __HIP_MEMORY_SCOPE_AGENT);
        if (wid == 0) { unsigned sp = 0;
            while ((unsigned)__builtin_amdgcn_readfirstlane(__hip_atomic_load(cnt + 64 * u.pm, __ATOMIC_RELAXED, __HIP_MEMORY_SCOPE_AGENT)) < 16u) { __builtin_amdgcn_s_sleep(2); if (++sp > (1u << 20)) break; }
            __builtin_amdgcn_fence(__ATOMIC_ACQUIRE, "agent"); }
        asm volatile("s_waitcnt vmcnt(0) lgkmcnt(0)" ::: "memory"); __builtin_amdgcn_s_barrier(); asm volatile("" ::: "memory");
        if (tid < 256) { const unsigned* q = (const unsigned*)xb + (size_t)(u.pm * BM + tid) * 4; float t = 0.f;
#pragma unroll
            for (int k = 0; k < 4; ++k) t += __uint_as_float(__hip_atomic_load(q + k, __ATOMIC_RELAXED, __HIP_MEMORY_SCOPE_AGENT));
            S[tid] = 1.0f / sqrtf(t * (1.0f / 1024.0f) + 1e-6f); }
        asm volatile("s_waitcnt vmcnt(0) lgkmcnt(0)" ::: "memory"); __builtin_amdgcn_s_barrier(); asm volatile("" ::: "memory");
        f32x4 gv[2][2];
#pragma unroll
        for (int bj = 0; bj < 2; ++bj)
#pragma unroll
            for (int n = 0; n < 2; ++n) gv[bj][n] = *(const f32x4*)(gain + col0 + bj * HALF + n * 16);
#pragma unroll
        for (int ai = 0; ai < 2; ++ai)
#pragma unroll
            for (int m = 0; m < 4; ++m) { const int rl = ai * HALF + wr * 64 + m * 16 + fr; const size_t off = (size_t)(u.pm * BM + rl) * ldc + col0; const float rs = S[rl];
#pragma unroll
                for (int bj = 0; bj < 2; ++bj)
#pragma unroll
                    for (int n = 0; n < 2; ++n) { const f32x4 o = acc[ai][bj][m][n] * rs * gv[bj][n];
                        if (outn) *(f32x4*)(outn + off + bj * HALF + n * 16) = o;
                        if (xn) { v2u w; w.x = cvt_pk_bf16(o[0], o[1]); w.y = cvt_pk_bf16(o[2], o[3]); *(v2u*)(xn + off + bj * HALF + n * 16) = w; } } }
    }
};
struct EpiCmp {
    static constexpr bool PERM = true, AFTER_DRAIN = true;
    const float* peb; const bf16_t* w2t; bf16_t* ckv;
    __device__ __forceinline__ void fused(f32x4 (&acc)[2][2][4][2], const Unit& u, int wr, int wc, int fr, int fq, LAS unsigned char* lds, int wid, int lane) const {
        const int kv = u.tag >> 1, g = u.tag & 1, col0 = wc * 32 + 8 * fq;
#pragma unroll
        for (int bj = 0; bj < 2; ++bj) { float pb[8];
#pragma unroll
            for (int e = 0; e < 8; ++e) pb[e] = peb[kv * 256 + bj * HALF + col0 + e];
#pragma unroll
            for (int ai = 0; ai < 2; ++ai)
#pragma unroll
                for (int m = 0; m < 4; ++m) { const int row = ai * HALF + wr * 64 + m * 16 + fr, chunk = bj * 16 + wc * 4 + fq; float v[8];
#pragma unroll
                    for (int e = 0; e < 4; ++e) { v[e] = acc[ai][bj][m][0][e] + pb[e]; v[4 + e] = acc[ai][bj][m][1][e] + pb[4 + e]; }
#pragma unroll
                    for (int e = 0; e < 8; ++e) v[e] = v[e] * __builtin_amdgcn_rcpf(1.0f + __builtin_amdgcn_exp2f(-v[e] * 1.4426950408889634f));
                    v4u w; w.x = cvt_pk_bf16(v[0], v[1]); w.y = cvt_pk_bf16(v[2], v[3]); w.z = cvt_pk_bf16(v[4], v[5]); w.w = cvt_pk_bf16(v[6], v[7]);
                    *(LAS v4u*)(lds + row * 512 + ((chunk ^ (row & 15)) * 16)) = w; } }
        asm volatile("s_waitcnt lgkmcnt(0)" ::: "memory"); __builtin_amdgcn_s_barrier(); asm volatile("" ::: "memory");
        typedef float f32x16_t __attribute__((ext_vector_type(16)));
        const int r32 = lane & 31, hi = lane >> 5, row = wid * 32 + r32;
        f32x16_t o0, o1;
#pragma unroll
        for (int r = 0; r < 16; ++r) { o0[r] = 0.f; o1[r] = 0.f; }
        const bf16_t* wb = w2t + ((size_t)kv * 64 + r32) * 256 + hi * 8;
#pragma unroll
        for (int ks = 0; ks < 16; ++ks) { const bf16x8 af = *(const LAS bf16x8*)(lds + row * 512 + (((2 * ks + hi) ^ (row & 15)) * 16));
            o0 = __builtin_amdgcn_mfma_f32_32x32x16_bf16(af, *(const bf16x8*)(wb + 16 * ks), o0, 0, 0, 0);
            o1 = __builtin_amdgcn_mfma_f32_32x32x16_bf16(af, *(const bf16x8*)(wb + 32 * 256 + 16 * ks), o1, 0, 0, 0); }
#pragma unroll
        for (int r = 0; r < 16; ++r) { const int rp = u.pm * BM + wid * 32 + (r & 3) + 8 * (r >> 2) + 4 * hi, b = rp >> 7, n = rp & 127;
            bf16_t* o = ckv + ((((size_t)kv * NB + b) * 2 + g) * 128 + n) * 64 + r32;
            o[0] = f2bf(n == 127 ? 0.f : o0[r]); o[32] = f2bf(n == 127 ? 0.f : o1[r]); }
    }
};

template <class Epi, class Sched, bool ALIGN_EPI = false, bool SP2 = false>
__device__ __forceinline__ void gemm_phase(LAS unsigned char* lds, const Gemm g, const Sched& S, const Epi& E) {
    const int tid = fresh_tid(), wid = __builtin_amdgcn_readfirstlane(tid >> 6), lane = tid & 63, wr = wid >> 2, wc = wid & 3, fr = lane & 15, fq = lane >> 4;
    const int K = g.K, nt = K / BK;
    unsigned voffA[2], voffB[2];
#pragma unroll
    for (int i = 0; i < 2; ++i) { int R, C; stage_rc(tid * 16 + i * 8192, R, C); const int Rb = Epi::PERM ? ((R & ~31) + perm32(R & 31)) : R;
        voffA[i] = (unsigned)(R * g.lda + C) * 2u; voffB[i] = (unsigned)(Rb * g.ldb + C) * 2u; }
    const size_t kstepA = (size_t)g.kstepA, kstepB = (size_t)g.kstepB;
    const size_t hstepA = (size_t)HALF * g.lda * 2, hstepB = (size_t)HALF * g.ldb * 2;
    const unsigned ldsw = (unsigned)wid * 1024u;
    const int aoff = lds_byte(wr * 64 + fr, fq * 8), boff = lds_byte(wc * 32 + fr, fq * 8);
#define PG8_SA(b, h) (((b) * 2 + (h)) * HTB)
#define PG8_SB(b, h) ((4 + (b) * 2 + (h)) * HTB)
#define PG8_STAGE(bufoff, gbase, voff) do { _Pragma("unroll") for (int _i = 0; _i < 2; ++_i) \
        __builtin_amdgcn_global_load_lds((const unsigned*)((const char*)(gbase) + (voff)[_i]), (LAS unsigned*)(lds + (bufoff) + ldsw + _i * 8192), 16, 0, 0); } while (0)
#define PG8_LDA(dst, b, h) do { _Pragma("unroll") for (int m = 0; m < 4; ++m) _Pragma("unroll") for (int k = 0; k < 2; ++k) dst[m][k] = *(const LAS bf16x8*)(lds + PG8_SA(b, h) + aoff + m * 2048 + k * 1024); } while (0)
#define PG8_LDB(dst, b, h) do { _Pragma("unroll") for (int n = 0; n < 2; ++n) _Pragma("unroll") for (int k = 0; k < 2; ++k) dst[n][k] = *(const LAS bf16x8*)(lds + PG8_SB(b, h) + boff + n * 2048 + k * 1024); } while (0)
#define PG8_MMA(ai, bj, At, Bt) do { __builtin_amdgcn_s_setprio(1); _Pragma("unroll") for (int m = 0; m < 4; ++m) _Pragma("unroll") for (int n = 0; n < 2; ++n) _Pragma("unroll") for (int k = 0; k < 2; ++k) \
        acc[ai][bj][m][n] = __builtin_amdgcn_mfma_f32_16x16x32_bf16(Bt[n][k], At[m][k], acc[ai][bj][m][n], 0, 0, 0); __builtin_amdgcn_s_setprio(0); } while (0)
#define PG8_WAIT_V(n) asm volatile("s_waitcnt vmcnt(" #n ")" ::: "memory")
#define PG8_WAIT_L(n) asm volatile("s_waitcnt lgkmcnt(" #n ")" ::: "memory")
#define PG8_BAR __builtin_amdgcn_s_barrier()
#define PG8_SCHED __builtin_amdgcn_sched_barrier(0)
    Unit cur, nxt; int ui = 0;
    if (!S.next(0, cur)) return;
    f32x4 acc[2][2][4][2];
#pragma unroll
    for (int a = 0; a < 2; ++a)
#pragma unroll
        for (int b = 0; b < 2; ++b)
#pragma unroll
            for (int m = 0; m < 4; ++m)
#pragma unroll
                for (int n = 0; n < 2; ++n) acc[a][b][m][n] = (f32x4){0.f, 0.f, 0.f, 0.f};
    bf16x8 At[4][2], B0[2][2], B1[2][2];
    const char* cA = cur.A; const char* cB = cur.B;
    S.a_ready(cur);
    static_assert(SP2, "only the two-super-phase loop is kept in this file");
    {
        PG8_STAGE(PG8_SB(0, 0), cB, voffB); PG8_STAGE(PG8_SB(0, 1), cB + hstepB, voffB); PG8_STAGE(PG8_SA(0, 0), cA, voffA); PG8_STAGE(PG8_SA(0, 1), cA + hstepA, voffA);
        if (wr == 1) PG8_BAR;
        PG8_WAIT_V(2); PG8_BAR;
        PG8_STAGE(PG8_SB(1, 0), cB + kstepB, voffB); PG8_STAGE(PG8_SA(1, 0), cA + kstepA, voffA); PG8_STAGE(PG8_SB(1, 1), cB + hstepB + kstepB, voffB);
        PG8_WAIT_V(6); PG8_BAR;
    }
    for (;;) {
        const bool has_next = S.next(ui + 1, nxt);
        const char* nA = has_next ? nxt.A : cA; const char* nB = has_next ? nxt.B : cB;
        for (int t = 0; t < nt; t += 2) {
            const bool last = (t == nt - 2);
            const char* a1 = cA + (size_t)(t + 1) * kstepA;
            const char* a2 = last ? nA : cA + (size_t)(t + 2) * kstepA; const char* b2 = last ? nB : cB + (size_t)(t + 2) * kstepB;
            const char* a3 = a2 + kstepA; const char* b3 = b2 + kstepB;
            if (last && has_next) S.a_ready(nxt);
            PG8_LDB(B0, 0, 0); PG8_LDB(B1, 0, 1); PG8_SCHED; PG8_LDA(At, 0, 0); PG8_STAGE(PG8_SA(1, 1), a1 + hstepA, voffA);
            PG8_WAIT_V(8); PG8_WAIT_L(0); PG8_BAR; PG8_MMA(0, 0, At, B0); PG8_MMA(0, 1, At, B1); PG8_BAR; PG8_SCHED;
            PG8_LDA(At, 0, 1); PG8_STAGE(PG8_SB(0, 0), b2, voffB); PG8_STAGE(PG8_SB(0, 1), b2 + hstepB, voffB); PG8_STAGE(PG8_SA(0, 0), a2, voffA);
            PG8_WAIT_V(8); PG8_WAIT_L(0); PG8_BAR; PG8_MMA(1, 0, At, B0); PG8_MMA(1, 1, At, B1); PG8_BAR; PG8_SCHED;
            PG8_LDB(B0, 1, 0); PG8_LDB(B1, 1, 1); PG8_SCHED; PG8_LDA(At, 1, 0); PG8_STAGE(PG8_SA(0, 1), a2 + hstepA, voffA);
            PG8_WAIT_V(8); PG8_WAIT_L(0); PG8_BAR; PG8_MMA(0, 0, At, B0); PG8_MMA(0, 1, At, B1); PG8_BAR; PG8_SCHED;
            PG8_LDA(At, 1, 1); PG8_STAGE(PG8_SB(1, 0), b3, voffB); PG8_STAGE(PG8_SB(1, 1), b3 + hstepB, voffB); PG8_STAGE(PG8_SA(1, 0), a3, voffA);
            PG8_WAIT_V(8); PG8_WAIT_L(0); PG8_BAR; PG8_MMA(1, 0, At, B0); PG8_MMA(1, 1, At, B1); PG8_BAR; PG8_SCHED;
        }
        if constexpr (ALIGN_EPI) { if (wr == 0) PG8_BAR; }
        if constexpr (!Epi::AFTER_DRAIN) { E(acc, cur, wr, wc, fr, fq); S.done(cur); }
        if (!has_next) break;
#pragma unroll
        for (int a = 0; a < 2; ++a)
#pragma unroll
            for (int b = 0; b < 2; ++b)
#pragma unroll
                for (int m = 0; m < 4; ++m)
#pragma unroll
                    for (int n = 0; n < 2; ++n) acc[a][b][m][n] = (f32x4){0.f, 0.f, 0.f, 0.f};
        cur = nxt; cA = nA; cB = nB; ++ui;
        if constexpr (ALIGN_EPI) { if (wr == 1) PG8_BAR; }
    }
    PG8_WAIT_V(0);
    if constexpr (!ALIGN_EPI) { if (wr == 0) PG8_BAR; }
    PG8_BAR;
    if constexpr (Epi::AFTER_DRAIN) { E.fused(acc, cur, wr, wc, fr, fq, lds, wid, lane); S.done(cur); }
#undef PG8_SA
#undef PG8_SB
#undef PG8_STAGE
#undef PG8_LDA
#undef PG8_LDB
#undef PG8_MMA
#undef PG8_WAIT_V
#undef PG8_WAIT_L
#undef PG8_BAR
#undef PG8_SCHED
}
}

constexpr int NWAVES = 8, LDS_BYTES = 147456;
__device__ __forceinline__ float wave_sum(float v) {
#pragma unroll
    for (int o = 1; o < 64; o <<= 1) v += __shfl_xor(v, o);
    return v;
}
template <bool PERM>
__device__ __forceinline__ void p0_transpose_item(const float* W, int K, int N, int NP, bf16_t* WT, LAS float* scr, int item, int lane, const float* ksc = nullptr) {
    const int nblk = NP / 32, kb = item / nblk, nb = item % nblk, k0 = 64 * kb, n0 = 32 * nb;
    int ncol = n0 + (lane & 7) * 4; if (PERM) ncol = nsa_col_orig(ncol);
    f32x4 v[8];
#pragma unroll
    for (int i = 0; i < 8; ++i) { const int kk = 8 * i + (lane >> 3); v[i] = ncol >= 0 ? *(const f32x4*)(W + (size_t)(k0 + kk) * N + ncol) : (f32x4){0.f, 0.f, 0.f, 0.f}; if (ksc) v[i] = v[i] * ksc[k0 + kk]; }
#pragma unroll
    for (int i = 0; i < 8; ++i) { const int kk = 8 * i + (lane >> 3); LAS float* d = scr + kk * 33 + (lane & 7) * 4; d[0] = v[i][0]; d[1] = v[i][1]; d[2] = v[i][2]; d[3] = v[i][3]; }
    LDS_WAIT(); asm volatile("" ::: "memory");
    const int c = lane & 7;
#pragma unroll
    for (int j = 0; j < 4; ++j) { const int n = (lane >> 3) + 8 * j; const LAS float* s = scr + (8 * c) * 33 + n;
        v4u o; o.x = pk2(s[0 * 33], s[1 * 33]); o.y = pk2(s[2 * 33], s[3 * 33]); o.z = pk2(s[4 * 33], s[5 * 33]); o.w = pk2(s[6 * 33], s[7 * 33]);
        *(v4u*)(WT + (size_t)(n0 + n) * K + k0 + 8 * c) = o; }
    LDS_WAIT(); asm volatile("" ::: "memory");
}
__device__ __forceinline__ void rms_row_to_bf16(const float* xrow, const float* g, bf16_t* orow, int lane) {
    const f32x4* xr = (const f32x4*)xrow + lane; const f32x4* gr = (const f32x4*)g + lane;
    f32x4 v[4]; float s = 0.f;
#pragma unroll
    for (int j = 0; j < 4; ++j) { v[j] = xr[64 * j]; s += (v[j].x * v[j].x + v[j].y * v[j].y) + (v[j].z * v[j].z + v[j].w * v[j].w); }
    const float rs = 1.f / sqrtf(wave_sum(s) * (1.f / 1024.f) + EPS);
    unsigned long long* o8 = (unsigned long long*)orow + lane;
#pragma unroll
    for (int j = 0; j < 4; ++j) { const f32x4 gg = g ? gr[64 * j] : (f32x4){1.f, 1.f, 1.f, 1.f};
        o8[64 * j] = (unsigned long long)pk2(v[j].x * rs * gg.x, v[j].y * rs * gg.y) | ((unsigned long long)pk2(v[j].z * rs * gg.z, v[j].w * rs * gg.w) << 32); }
}
__device__ __forceinline__ void rms_rows4_to_bf16(const float* x, const float* g, bf16_t* o, int m0, int stride, int nrows, int lane) {
    f32x4 v[4][4];
#pragma unroll
    for (int k = 0; k < 4; ++k) { const int m = m0 + k * stride; if (m < nrows) {
#pragma unroll
        for (int j = 0; j < 4; ++j) v[k][j] = ((const f32x4*)(x + (size_t)m * 1024) + lane)[64 * j]; } }
    f32x4 gg[4];
#pragma unroll
    for (int j = 0; j < 4; ++j) gg[j] = g ? ((const f32x4*)g + lane)[64 * j] : (f32x4){1.f, 1.f, 1.f, 1.f};
#pragma unroll
    for (int k = 0; k < 4; ++k) { const int m = m0 + k * stride; if (m < nrows) { float s = 0.f;
#pragma unroll
        for (int j = 0; j < 4; ++j) s += (v[k][j].x * v[k][j].x + v[k][j].y * v[k][j].y) + (v[k][j].z * v[k][j].z + v[k][j].w * v[k][j].w);
        const float rs = 1.f / sqrtf(wave_sum(s) * (1.f / 1024.f) + EPS);
        unsigned long long* o8 = (unsigned long long*)(o + (size_t)m * 1024) + lane;
#pragma unroll
        for (int j = 0; j < 4; ++j) o8[64 * j] = (unsigned long long)pk2(v[k][j].x * rs * gg[j].x, v[k][j].y * rs * gg[j].y) | ((unsigned long long)pk2(v[k][j].z * rs * gg[j].z, v[k][j].w * rs * gg[j].w) << 32); } }
}
__device__ __forceinline__ void rms_row_inplace(float* xrow, const float* g, int lane) {
    f32x4* xr = (f32x4*)xrow + lane; const f32x4* gr = (const f32x4*)g + lane;
    f32x4 v[4]; float s = 0.f;
#pragma unroll
    for (int j = 0; j < 4; ++j) { v[j] = xr[64 * j]; s += (v[j].x * v[j].x + v[j].y * v[j].y) + (v[j].z * v[j].z + v[j].w * v[j].w); }
    const float rs = 1.f / sqrtf(wave_sum(s) * (1.f / 1024.f) + EPS);
#pragma unroll
    for (int j = 0; j < 4; ++j) xr[64 * j] = v[j] * rs * gr[64 * j];
}

typedef float f32x16 __attribute__((ext_vector_type(16)));
typedef short s16x4 __attribute__((ext_vector_type(4)));
typedef short v4i16_t __attribute__((ext_vector_type(4)));
#define MFMA32(a, b, c) __builtin_amdgcn_mfma_f32_32x32x16_bf16(a, b, c, 0, 0, 0)
constexpr float LOG2E = 1.4426950408889634f, LN2 = 0.6931471805599453f;
__device__ __forceinline__ int crow(int r, int hi) { return (r & 3) + 8 * (r >> 2) + 4 * hi; }
__device__ __forceinline__ s16x4 vtr(const LAS unsigned char* p) { return __builtin_bit_cast(s16x4, __builtin_amdgcn_ds_read_tr16_b64_v4i16((LAS v4i16_t*)p)); }
__device__ __forceinline__ float xmax32(float v) { auto rr = __builtin_amdgcn_permlane32_swap(__float_as_uint(v), __float_as_uint(v), false, false); return fmaxf(__uint_as_float(rr[0]), __uint_as_float(rr[1])); }
__device__ __forceinline__ float xsum32(float v) { auto rr = __builtin_amdgcn_permlane32_swap(__float_as_uint(v), __float_as_uint(v), false, false); return __uint_as_float(rr[0]) + __uint_as_float(rr[1]); }
__device__ __forceinline__ float ex2(float x) { return __builtin_amdgcn_exp2f(x); }
__device__ __forceinline__ float sigm_(float x) { return __builtin_amdgcn_rcpf(1.0f + ex2(-x * LOG2E)); }
__device__ __forceinline__ bf16x8 pack8(const f32x16& v, int r0) {
    v4u w; w.x = pg8::cvt_pk_bf16(v[r0], v[r0 + 1]); w.y = pg8::cvt_pk_bf16(v[r0 + 2], v[r0 + 3]); w.z = pg8::cvt_pk_bf16(v[r0 + 4], v[r0 + 5]); w.w = pg8::cvt_pk_bf16(v[r0 + 6], v[r0 + 7]);
    return __builtin_bit_cast(bf16x8, w);
}
__device__ __forceinline__ bf16x8 vfrag(const LAS unsigned char* p) { const s16x4 a = vtr(p), b = vtr(p + 512); return (bf16x8){a[0], a[1], a[2], a[3], b[0], b[1], b[2], b[3]}; }

struct KVRegs { v4u k, v; };
__device__ __forceinline__ KVRegs kv_load(const bf16_t* Kg, const bf16_t* Vg, int ld, int tid) {
    const int key = (tid & 7) + 8 * (tid >> 6), ch = (tid >> 3) & 7;
    KVRegs r; r.k = *(const v4u*)(Kg + (size_t)key * ld + ch * 8); r.v = *(const v4u*)(Vg + (size_t)key * ld + ch * 8); return r;
}
__device__ __forceinline__ void kv_store(LAS unsigned char* buf, const KVRegs& r, int tid) {
    const int key = (tid & 7) + 8 * (tid >> 6), ch = (tid >> 3) & 7;
    *(LAS v4u*)(buf + ch * 1024 + key * 16) = r.k;
    *(LAS v4u*)(buf + 8192 + (ch >> 2) * 4096 + key * 64 + (ch & 3) * 16) = r.v;
}
struct Sm64 { f32x16 o[2]; float m, l; };
__device__ __forceinline__ void sm64_init(Sm64& st) {
#pragma unroll
    for (int r = 0; r < 16; ++r) { st.o[0][r] = 0.f; st.o[1][r] = 0.f; }
    st.m = -1e30f; st.l = 0.f;
}
__device__ __forceinline__ void qk64(f32x16& s0, f32x16& s1, const bf16x8 (&qf)[4], const LAS unsigned char* buf, int r32, int hi, float kbs = 0.f) {
    const LAS unsigned char* kp = buf + hi * 1024 + r32 * 16;
    const float kbh = kbs * (float)(4 * hi);
#pragma unroll
    for (int r = 0; r < 16; ++r) { s0[r] = fmaf(kbs, (float)((r & 3) + 8 * (r >> 2)), kbh); s1[r] = s0[r]; }
#pragma unroll
    for (int d0 = 0; d0 < 4; ++d0) { const bf16x8 k0 = *(const LAS bf16x8*)(kp + d0 * 2048), k1 = *(const LAS bf16x8*)(kp + d0 * 2048 + 512);
        s0 = MFMA32(k0, qf[d0], s0); s1 = MFMA32(k1, qf[d0], s1); }
}
__device__ __forceinline__ void pv64(f32x16 (&o)[2], const f32x16& p0, const f32x16& p1, const LAS unsigned char* buf, int lane, int hi) {
    const bf16x8 pf0 = pack8(p0, 0), pf1 = pack8(p0, 8), pf2 = pack8(p1, 0), pf3 = pack8(p1, 8);
    const LAS unsigned char* vp = buf + 8192 + ((lane >> 4) & 1) * 32 + (lane & 3) * 8 + (4 * hi + ((lane & 15) >> 2)) * 64;
#pragma unroll
    for (int dt = 0; dt < 2; ++dt) {
        o[dt] = MFMA32(vfrag(vp + dt * 4096), pf0, o[dt]); o[dt] = MFMA32(vfrag(vp + dt * 4096 + 1024), pf1, o[dt]);
        o[dt] = MFMA32(vfrag(vp + dt * 4096 + 2048), pf2, o[dt]); o[dt] = MFMA32(vfrag(vp + dt * 4096 + 3072), pf3, o[dt]);
    }
}
typedef float f32x2 __attribute__((ext_vector_type(2)));
template <int MODE>
__device__ __forceinline__ void tile64(Sm64& st, const bf16x8 (&qf)[4], const LAS unsigned char* buf, int lane, float c2, float kbs, float off, float off32, int lim, int lo) {
    const int r32 = lane & 31, hi = lane >> 5;
    f32x16 s0, s1; qk64(s0, s1, qf, buf, r32, hi, kbs);
    if (MODE != 0) {
        const int l0 = lim - 4 * hi, l1 = lim - 32 - 4 * hi, g0 = lo - 4 * hi, g1 = lo - 32 - 4 * hi;
#pragma unroll
        for (int r = 0; r < 16; ++r) { const int kc = (r & 3) + 8 * (r >> 2);
            const bool v0 = (kc <= l0) && (MODE == 1 || kc >= g0), v1 = (kc <= l1) && (MODE == 1 || kc >= g1);
            s0[r] = v0 ? s0[r] : -INFINITY; s1[r] = v1 ? s1[r] : -INFINITY; }
    }
    float m0 = fmaxf(s0[0], s0[1]), m1 = fmaxf(s1[0], s1[1]);
#pragma unroll
    for (int r = 2; r < 16; r += 2) { m0 = fmaxf(fmaxf(m0, s0[r]), s0[r + 1]); m1 = fmaxf(fmaxf(m1, s1[r]), s1[r + 1]); }
    const float mx = xmax32(fmaxf(fmaf(m0, c2, off), fmaf(m1, c2, off32)));
    const float mn = fmaxf(st.m, mx), al = ex2(st.m - mn);
    const f32x2 c2v = {c2, c2}, d0 = {off - mn, off - mn}, d1 = {off32 - mn, off32 - mn};
    f32x2 sum2 = {0.f, 0.f};
#pragma unroll
    for (int r = 0; r < 16; r += 2) { f32x2 a = {s0[r], s0[r + 1]}, b = {s1[r], s1[r + 1]};
        a = __builtin_elementwise_fma(a, c2v, d0); b = __builtin_elementwise_fma(b, c2v, d1);
        a.x = ex2(a.x); a.y = ex2(a.y); b.x = ex2(b.x); b.y = ex2(b.y);
        sum2 = sum2 + a; sum2 = sum2 + b;
        s0[r] = a.x; s0[r + 1] = a.y; s1[r] = b.x; s1[r + 1] = b.y; }
    const float sum = xsum32(sum2.x + sum2.y);
    st.l = st.l * al + sum; st.m = mn;
    const f32x2 alv = {al, al};
#pragma unroll
    for (int r = 0; r < 16; r += 2) { f32x2 a = {st.o[0][r], st.o[0][r + 1]}, b = {st.o[1][r], st.o[1][r + 1]}; a = a * alv; b = b * alv;
        st.o[0][r] = a.x; st.o[0][r + 1] = a.y; st.o[1][r] = b.x; st.o[1][r + 1] = b.y; }
    pv64(st.o, s0, s1, buf, lane, hi);
}

template <unsigned NOPT>
__device__ __forceinline__ void nsa_unit(const Params& p, LAS unsigned char* lds, int unit) {
    const int tid = fresh_tid(), lane = tid & 63, r32 = lane & 31, hi = lane >> 5, w = __builtin_amdgcn_readfirstlane(tid >> 6);
    const int q32 = unit & 63, g = (unit >> 6) & 1, b = unit >> 7;
    const int q0 = q32 * 32, cur = q0 >> 6, hidx = g * 8 + w, s = q0 + r32;
    const size_t trow = (size_t)b * SEQ + s;
    const bf16_t* Q1 = (const bf16_t*)(p.ws + OFF_Q1); const bf16_t* KV = (const bf16_t*)(p.ws + OFF_KV1); const bf16_t* gate = (const bf16_t*)(p.ws + OFF_GATE);
    const bf16_t* ckv = (const bf16_t*)(p.ws + OFF_CMPKV); const bf16_t* Z1 = (const bf16_t*)(p.ws + OFF_Z1); bf16_t* Y1 = (bf16_t*)(p.ws + OFF_Y1);
    const float slope2 = exp2f(-0.5f * (float)(hidx + 1)) * LOG2E, c2 = 0.125f * LOG2E;
    const float kbs = slope2 / c2;
    LAS unsigned char* buf0 = lds; LAS unsigned char* buf1 = lds + 16384;
    LAS float* impw = (LAS float*)(lds + 32768) + w * 1056; LAS float* impt = (LAS float*)(lds + 66560); LAS unsigned* msk = (LAS unsigned*)(lds + 66560 + 4224);
    bf16x8 qf[4];
#pragma unroll
    for (int d0 = 0; d0 < 4; ++d0) qf[d0] = *(const bf16x8*)(Q1 + trow * 1024 + hidx * 64 + d0 * 16 + hi * 8);
    const float g0 = sigm_(bf2f(gate[trow * 256 + hidx * 3 + 0])), g1 = sigm_(bf2f(gate[trow * 256 + hidx * 3 + 1])), g2 = sigm_(bf2f(gate[trow * 256 + hidx * 3 + 2]));
    LAS float* otl = (LAS float*)(lds + 73728);
    {
        const bf16_t* kc = ckv + (((size_t)0 * NB + b) * 2 + g) * 128 * 64; const bf16_t* vc = ckv + (((size_t)1 * NB + b) * 2 + g) * 128 * 64;
        { const KVRegs r0 = kv_load(kc, vc, 64, tid), r1 = kv_load(kc + 64 * 64, vc + 64 * 64, 64, tid); kv_store(buf0, r0, tid); kv_store(buf1, r1, tid); }
        __syncthreads();
        if (!(NOPT & 4u)) {
        f32x16 sc[4]; qk64(sc[0], sc[1], qf, buf0, r32, hi); qk64(sc[2], sc[3], qf, buf1, r32, hi);
        float mx = -INFINITY;
#pragma unroll
        for (int T = 0; T < 4; ++T)
#pragma unroll
            for (int r = 0; r < 16; ++r) { const int n = 32 * T + crow(r, hi), dist = s - (16 * n + 31);
                const float v = dist >= 0 ? fmaf(sc[T][r], c2, -slope2 * (float)dist) : -INFINITY; sc[T][r] = v; mx = fmaxf(mx, v); }
        mx = fmaxf(xmax32(mx), -1e30f);
        float sum = 0.f;
#pragma unroll
        for (int T = 0; T < 4; ++T)
#pragma unroll
            for (int r = 0; r < 16; ++r) { sc[T][r] = ex2(sc[T][r] - mx); sum += sc[T][r]; }
        sum = xsum32(sum);
        const float inv = sum > 0.f ? 1.0f / sum : 0.f;
        float prev_y = 0.f;
#pragma unroll
        for (int T = 0; T < 4; ++T)
#pragma unroll
            for (int c = 0; c < 4; ++c) { const float x3 = sc[T][4 * c + 3], y = __shfl_xor(x3, 32);
                const float sum4 = (sc[T][4 * c] + sc[T][4 * c + 1]) + (sc[T][4 * c + 2] + x3);
                impw[r32 * 33 + 8 * T + 2 * c + hi] = (sum4 + (hi ? y : prev_y)) * inv; prev_y = y; }
        f32x16 oc[2];
#pragma unroll
        for (int r = 0; r < 16; ++r) { oc[0][r] = 0.f; oc[1][r] = 0.f; }
        pv64(oc, sc[0], sc[1], buf0, lane, hi); pv64(oc, sc[2], sc[3], buf1, lane, hi);
        const float f0 = g0 * inv;
#pragma unroll
        for (int r = 0; r < 16; ++r) { otl[r * 512 + tid] = oc[0][r] * f0; otl[(16 + r) * 512 + tid] = oc[1][r] * f0; }
        }
    }
    __syncthreads();
    if (!(NOPT & 8u))
    for (int idx = tid; idx < 1024; idx += 512) { float a = 0.f;
#pragma unroll
        for (int ww = 0; ww < 8; ++ww) a += ((LAS float*)(lds + 32768))[ww * 1056 + (idx >> 5) * 33 + (idx & 31)];
        impt[(idx >> 5) * 33 + (idx & 31)] = a; }
    __syncthreads();
    {
        const int nf = cur == 0 ? 1 : (cur == 1 ? 2 : 3), need = 8 - nf;
#pragma unroll
        for (int pi = 0; pi < 2; ++pi) {
            const int q = pi * 16 + 2 * w + hi, j = r32; bool sel;
            if (j == 0 || j == cur || j == cur - 1) sel = true;
            else if ((NOPT & 8u) == 0 && j <= cur - 2) { const float v = impt[q * 33 + j]; int rank = 0;
#pragma unroll
                for (int j2 = 1; j2 < 30; ++j2) { const float v2 = impt[q * 33 + j2]; rank += (j2 <= cur - 2 && j2 != j && (v2 > v || (v2 == v && j2 < j))) ? 1 : 0; }
                sel = rank < need; }
            else sel = false;
            const unsigned long long bal = __ballot(sel);
            if (lane == 0) msk[pi * 16 + 2 * w] = (unsigned)bal;
            if (lane == 32) msk[pi * 16 + 2 * w + 1] = (unsigned)(bal >> 32);
        }
    }
    __syncthreads();
    const unsigned mymask = msk[r32];
    unsigned uni = mymask;
#pragma unroll
    for (int o = 1; o < 32; o <<= 1) uni |= (unsigned)__shfl_xor((int)uni, o);
    uni = (unsigned)__builtin_amdgcn_readfirstlane((int)uni);
    const int nslc = __builtin_popcount(uni), wlo = (q0 - 511 > 0 ? q0 - 511 : 0) >> 6, nwin = cur - wlo + 1, ntile = nslc + nwin;
    const bf16_t* kvb = KV + (size_t)b * SEQ * 768 + g * 64;
    unsigned rem_l = uni, rem_c = uni;
    auto tile_j = [&](int i, unsigned& rem) { int j; if (i < nslc) { j = __builtin_ctz(rem); rem &= rem - 1; } else j = wlo + (i - nslc); return j; };
    auto kvl = [&](int i, unsigned& rem) { const int j = tile_j(i, rem); const int col = i < nslc ? 256 : 512; return kv_load(kvb + (size_t)64 * j * 768 + col, kvb + (size_t)64 * j * 768 + col + 128, 768, tid); };
    KVRegs ra0, ra1;
    { const KVRegs r0 = kvl(0, rem_l); kv_store(lds, r0, tid); if (1 < ntile) { const KVRegs r1 = kvl(1, rem_l); kv_store(lds + 16384, r1, tid); } }
    __syncthreads();
    Sm64 st; sm64_init(st);
    auto do_tile = [&](int i) {
        const int j = tile_j(i, rem_c); const LAS unsigned char* buf = lds + (i & 3) * 16384;
        if (NOPT & 1u) return;
        const float off = slope2 * (float)(64 * j - s), off32 = off + 32.0f * slope2;
        if (i < nslc) { const bool has = (mymask >> j) & 1u; const float offh = has ? off : -INFINITY, offh32 = has ? off32 : -INFINITY;
            if (j < cur) tile64<0>(st, qf, buf, lane, c2, kbs, offh, offh32, 0, 0);
            else tile64<1>(st, qf, buf, lane, c2, kbs, offh, offh32, s - 64 * j, 0);
            if (i == nslc - 1) { const float f1 = g1 / st.l;
#pragma unroll
                for (int r = 0; r < 16; ++r) { otl[r * 512 + tid] += st.o[0][r] * f1; otl[(16 + r) * 512 + tid] += st.o[1][r] * f1; }
                sm64_init(st); }
        } else {
            if (64 * j + 63 <= q0 && 64 * j >= q0 - 480) tile64<0>(st, qf, buf, lane, c2, kbs, off, off32, 0, 0);
            else tile64<2>(st, qf, buf, lane, c2, kbs, off, off32, s - 64 * j, s - 511 - 64 * j);
        }
    };
    for (int i = 0; i < ((NOPT & 2u) ? 0 : ntile); i += 2) {
        if (i + 2 < ntile) ra0 = kvl(i + 2, rem_l);
        if (i + 3 < ntile) ra1 = kvl(i + 3, rem_l);
        do_tile(i);
        if (i + 1 < ntile) do_tile(i + 1);
        if (i + 2 < ntile) kv_store(lds + ((i + 2) & 3) * 16384, ra0, tid);
        if (i + 3 < ntile) kv_store(lds + ((i + 3) & 3) * 16384, ra1, tid);
        __syncthreads();
    }
    f32x16 ot[2];
    { const float f2 = g2 / st.l;
#pragma unroll
      for (int r = 0; r < 16; ++r) { ot[0][r] = otl[r * 512 + tid] + st.o[0][r] * f2; ot[1][r] = otl[(16 + r) * 512 + tid] + st.o[1][r] * f2; } }
#pragma unroll
    for (int dt = 0; dt < 2; ++dt)
#pragma unroll
        for (int c = 0; c < 4; ++c) { const int d = 32 * dt + 8 * c + 4 * hi;
            const v2u zz = *(const v2u*)(Z1 + trow * 1024 + hidx * 64 + d);
            const float z0 = lo16(zz.x), z1 = hi16(zz.x), z2 = lo16(zz.y), z3 = hi16(zz.y);
            const float y0 = ot[dt][4 * c] * z0, y1 = ot[dt][4 * c + 1] * z1, y2 = ot[dt][4 * c + 2] * z2, y3 = ot[dt][4 * c + 3] * z3;
            v2u o2; o2.x = pg8::cvt_pk_bf16(y0, y1); o2.y = pg8::cvt_pk_bf16(y2, y3);
            *(v2u*)(Y1 + trow * 1280 + hidx * 64 + d) = o2; }
}

__device__ __forceinline__ void mem_unit(const bf16_t* mkv, const bf16_t* QMb, const bf16_t* ZMb, bf16_t* Y, int ldy, LAS unsigned char* lds, int unit) {
    const int tid = fresh_tid(), lane = tid & 63, r32 = lane & 31, hi = lane >> 5, w = __builtin_amdgcn_readfirstlane(tid >> 6);
    const int qc = unit & 7, h = (unit >> 3) & 3, b = unit >> 5;
    const size_t trow = (size_t)b * SEQ + qc * 256 + w * 32 + r32;
    const bf16_t* kb = mkv + (size_t)b * NMEM * 512 + h * 64;
#pragma unroll
    for (int t = 0; t < 4; ++t) { const KVRegs r = kv_load(kb + (size_t)t * 64 * 512, kb + (size_t)t * 64 * 512 + 256, 512, tid); kv_store(lds + t * 16384, r, tid); }
    bf16x8 qf[4];
#pragma unroll
    for (int d0 = 0; d0 < 4; ++d0) qf[d0] = *(const bf16x8*)(QMb + trow * 256 + h * 64 + d0 * 16 + hi * 8);
    __syncthreads();
    Sm64 st; sm64_init(st);
#pragma unroll 1
    for (int t = 0; t < 4; ++t) tile64<0>(st, qf, lds + t * 16384, lane, 0.125f * LOG2E, 0.f, 0.f, 0.f, 0, 0);
    const float inv = 1.0f / st.l;
#pragma unroll
    for (int dt = 0; dt < 2; ++dt)
#pragma unroll
        for (int c = 0; c < 4; ++c) { const int d = 32 * dt + 8 * c + 4 * hi;
            const v2u zz = *(const v2u*)(ZMb + trow * 256 + h * 64 + d);
            const float z0 = lo16(zz.x), z1 = hi16(zz.x), z2 = lo16(zz.y), z3 = hi16(zz.y);
            const float y0 = st.o[dt][4 * c] * inv * z0, y1 = st.o[dt][4 * c + 1] * inv * z1, y2 = st.o[dt][4 * c + 2] * inv * z2, y3 = st.o[dt][4 * c + 3] * inv * z3;
            v2u o2; o2.x = pg8::cvt_pk_bf16(y0, y1); o2.y = pg8::cvt_pk_bf16(y2, y3);
            *(v2u*)(Y + trow * ldy + h * 64 + d) = o2; }
    __syncthreads();
}

__device__ __forceinline__ void dil_task(const Params& p, LAS unsigned char* wl  , int task, int lane, bool dry = false) {
    const int r32 = lane & 31, hi = lane >> 5;
    const int grp = task >> 11, idx = task & 2047, dil = grp == 0 ? 1 : (grp == 1 ? 4 : 16), lg = grp * 2, nq = 64 >> lg;
    const int qi = idx & (nq - 1), rest = idx >> (6 - lg), h = rest & 3, brho = rest >> 2, b = brho >> lg, rho = brho & (dil - 1);
    const int hh = grp * 4 + h, i0 = 32 * qi, isub = i0 + r32;
    bf16_t* Q = (bf16_t*)(p.ws + OFF_Q); const bf16_t* K = (const bf16_t*)(p.ws + OFF_K); const bf16_t* V = (const bf16_t*)(p.ws + OFF_V); float* LSE = (float*)(p.ws + OFF_LSE);
    const size_t base = (size_t)b * SEQ + rho;
    const size_t trow = base + (size_t)isub * dil;
    const float slope2 = exp2f(-8.0f * (float)(hh + 1) / 12.0f) * (float)dil * LOG2E, c2 = 0.08838834764831845f * LOG2E;
    bf16x8 qf[8];
#pragma unroll
    for (int d0 = 0; d0 < 8; ++d0) qf[d0] = *(const bf16x8*)(Q + trow * 1536 + hh * 128 + d0 * 16 + hi * 8);
    f32x16 o[4]; float m = -1e30f, l = 0.f;
#pragma unroll
    for (int dt = 0; dt < 4; ++dt)
#pragma unroll
        for (int r = 0; r < 16; ++r) o[dt][r] = 0.f;
    LAS unsigned char* kl = wl; LAS unsigned char* vl = wl + 8192;
    const LAS unsigned char* vp = vl + ((lane >> 4) & 1) * 32 + (lane & 3) * 8 + (4 * hi + ((lane & 15) >> 2)) * 64;
    const int jt0 = qi - 4 > 0 ? qi - 4 : 0;
    v4u kr[8], vr[8];
    const int ekey = lane >> 4, ech = lane & 15;
#define DIL_LOAD(jt_) do { _Pragma("unroll") for (int it = 0; it < 8; ++it) { const size_t go = (base + (size_t)(32 * (jt_) + 4 * it + ekey) * dil) * 1536 + hh * 128 + ech * 8; \
        kr[it] = *(const v4u*)(K + go); vr[it] = *(const v4u*)(V + go); } } while (0)
    DIL_LOAD(jt0);
    for (int jt = jt0; jt <= qi; ++jt) {
        asm volatile("s_waitcnt lgkmcnt(0)" ::: "memory");
#pragma unroll
        for (int it = 0; it < 8; ++it) { const int key = 4 * it + ekey;
            *(LAS v4u*)(kl + key * 256 + ((ech ^ (key & 15)) * 16)) = kr[it];
            *(LAS v4u*)(vl + (ech >> 2) * 2048 + key * 64 + (ech & 3) * 16) = vr[it]; }
        if (jt < qi) DIL_LOAD(jt + 1);
        asm volatile("s_waitcnt lgkmcnt(0)" ::: "memory");
        f32x16 sc;
#pragma unroll
        for (int r = 0; r < 16; ++r) sc[r] = 0.f;
#pragma unroll
        for (int d0 = 0; d0 < 8; ++d0) { const bf16x8 kf = *(const LAS bf16x8*)(kl + r32 * 256 + (((2 * d0 + hi) ^ (r32 & 15)) * 16)); sc = MFMA32(kf, qf[d0], sc); }
        float mx = -INFINITY;
#pragma unroll
        for (int r = 0; r < 16; ++r) { const int dist = isub - (32 * jt + crow(r, hi));
            const float v = (dist >= 0 && dist <= 128) ? fmaf(sc[r], c2, -slope2 * (float)dist) : -INFINITY; sc[r] = v; mx = fmaxf(mx, v); }
        mx = xmax32(mx);
        const float mn = fmaxf(m, mx), al = ex2(m - mn);
        float sum = 0.f;
#pragma unroll
        for (int r = 0; r < 16; ++r) { sc[r] = ex2(sc[r] - mn); sum += sc[r]; }
        sum = xsum32(sum); l = l * al + sum; m = mn;
#pragma unroll
        for (int dt = 0; dt < 4; ++dt)
#pragma unroll
            for (int r = 0; r < 16; ++r) o[dt][r] *= al;
        const bf16x8 pf0 = pack8(sc, 0), pf1 = pack8(sc, 8);
#pragma unroll
        for (int dt = 0; dt < 4; ++dt) { o[dt] = MFMA32(vfrag(vp + dt * 2048), pf0, o[dt]); o[dt] = MFMA32(vfrag(vp + dt * 2048 + 1024), pf1, o[dt]); }
    }
#undef DIL_LOAD
    const float inv = 1.0f / l;
#pragma unroll
    for (int dt = 0; dt < 4; ++dt)
#pragma unroll
        for (int c = 0; c < 4; ++c) { const int d = 32 * dt + 8 * c + 4 * hi;
            v2u o2; o2.x = pg8::cvt_pk_bf16(o[dt][4 * c] * inv, o[dt][4 * c + 1] * inv); o2.y = pg8::cvt_pk_bf16(o[dt][4 * c + 2] * inv, o[dt][4 * c + 3] * inv);
            if (!dry) *(v2u*)(Q + trow * 1536 + hh * 128 + d) = o2; else asm volatile("" :: "v"(o2.x), "v"(o2.y)); }
    if (hi == 0 && !dry) LSE[((size_t)grp * T_ + trow) * 4 + h] = (m + __builtin_amdgcn_logf(l)) * LN2;
}

__device__ __forceinline__ void lru_unit(const Params& p, LAS unsigned char* lds, int unit) {
    const int tid = fresh_tid(), lane = tid & 63, r32 = lane & 31, hi = lane >> 5, w = __builtin_amdgcn_readfirstlane(tid >> 6);
    const int hh = unit & 1, blk = (unit >> 1) & 15, b = unit >> 5;
    const int cj = blk * 64 + hh * 32 + r32;
    const bf16_t* xaza = (const bf16_t*)p.out; bf16_t* Y0 = (bf16_t*)(p.ws + OFF_Y0);
    LAS float* cw = (LAS float*)lds; LAS float* tot = (LAS float*)(lds + 2048); LAS float* xcs = (LAS float*)(lds + 8192 + w * 8704);
    LAS unsigned char* xst = lds + 77824; LAS unsigned char* zst = lds + 115200 + w * 2048;
    if (tid < 256) cw[tid] = p.conv_w[(tid >> 6) * 1024 + blk * 64 + (tid & 63)]; else if (tid < 320) cw[tid] = p.conv_b[blk * 64 + tid - 256];
    bf16x8 wa[4], wx[4];
#pragma unroll
    for (int ks = 0; ks < 4; ++ks) { float fa[8], fx[8];
#pragma unroll
        for (int jj = 0; jj < 8; ++jj) { const size_t wi = (size_t)blk * 4096 + (size_t)(16 * ks + 8 * hi + jj) * 64 + hh * 32 + r32; fa[jj] = p.ga_w[wi]; fx[jj] = p.gx_w[wi]; }
        v4u a4, x4; a4.x = pg8::cvt_pk_bf16(fa[0], fa[1]); a4.y = pg8::cvt_pk_bf16(fa[2], fa[3]); a4.z = pg8::cvt_pk_bf16(fa[4], fa[5]); a4.w = pg8::cvt_pk_bf16(fa[6], fa[7]);
        x4.x = pg8::cvt_pk_bf16(fx[0], fx[1]); x4.y = pg8::cvt_pk_bf16(fx[2], fx[3]); x4.z = pg8::cvt_pk_bf16(fx[4], fx[5]); x4.w = pg8::cvt_pk_bf16(fx[6], fx[7]);
        wa[ks] = __builtin_bit_cast(bf16x8, a4); wx[ks] = __builtin_bit_cast(bf16x8, x4); }
    const float ba = p.ga_b[cj], bx = p.gx_b[cj], sp8 = -8.0f * log1pf(expf(-p.lam[cj]));
    v4u xr[5], zr[2];
#define LRU_LOAD(c_) do { const int t0c_ = (c_) * 256; \
        _Pragma("unroll") for (int i = 0; i < 5; ++i) { const int e = tid + 512 * i, row = e >> 3, tt = t0c_ - 3 + row; xr[i] = (v4u){0u, 0u, 0u, 0u}; \
            if (e < 2072 && tt >= 0) xr[i] = *(const v4u*)(xaza + ((size_t)b * SEQ + tt) * 2048 + blk * 64 + (e & 7) * 8); } \
        _Pragma("unroll") for (int i = 0; i < 2; ++i) { const int e = lane + 64 * i; zr[i] = *(const v4u*)(xaza + ((size_t)b * SEQ + t0c_ + w * 32 + (e >> 2)) * 2048 + 1024 + blk * 64 + hh * 32 + (e & 3) * 8); } } while (0)
    LRU_LOAD(0);
    float hchunk = 0.f;
#pragma unroll 1
    for (int c = 0; c < 8; ++c) {
        const int t0 = c * 256 + w * 32;
        const size_t rowb = (size_t)b * SEQ + t0;
#pragma unroll
        for (int i = 0; i < 5; ++i) { const int e = tid + 512 * i; if (e < 2072) *(LAS v4u*)(xst + (e >> 3) * 144 + (e & 7) * 16) = xr[i]; }
#pragma unroll
        for (int i = 0; i < 2; ++i) { const int e = lane + 64 * i; *(LAS v4u*)(zst + (e >> 2) * 64 + (e & 3) * 16) = zr[i]; }
        __syncthreads();
        if (c < 7) LRU_LOAD(c + 1);
        bf16x8 af[4];
#pragma unroll
        for (int ks = 0; ks < 4; ++ks) { const int i0 = 16 * ks + 8 * hi; float acc[8];
            { const f32x4 b0 = *(const LAS f32x4*)(cw + 256 + i0), b1 = *(const LAS f32x4*)(cw + 256 + i0 + 4); acc[0] = b0[0]; acc[1] = b0[1]; acc[2] = b0[2]; acc[3] = b0[3]; acc[4] = b1[0]; acc[5] = b1[1]; acc[6] = b1[2]; acc[7] = b1[3]; }
#pragma unroll
            for (int k = 0; k < 4; ++k) { const v4u v = *(const LAS v4u*)(xst + (w * 32 + r32 + k) * 144 + i0 * 2);
                const f32x4 w0 = *(const LAS f32x4*)(cw + k * 64 + i0), w1 = *(const LAS f32x4*)(cw + k * 64 + i0 + 4);
                acc[0] += w0[0] * lo16(v.x); acc[1] += w0[1] * hi16(v.x); acc[2] += w0[2] * lo16(v.y); acc[3] += w0[3] * hi16(v.y);
                acc[4] += w1[0] * lo16(v.z); acc[5] += w1[1] * hi16(v.z); acc[6] += w1[2] * lo16(v.w); acc[7] += w1[3] * hi16(v.w); }
            *(LAS f32x4*)(xcs + r32 * 68 + i0) = (f32x4){acc[0], acc[1], acc[2], acc[3]}; *(LAS f32x4*)(xcs + r32 * 68 + i0 + 4) = (f32x4){acc[4], acc[5], acc[6], acc[7]};
            v4u pk; pk.x = pg8::cvt_pk_bf16(acc[0], acc[1]); pk.y = pg8::cvt_pk_bf16(acc[2], acc[3]); pk.z = pg8::cvt_pk_bf16(acc[4], acc[5]); pk.w = pg8::cvt_pk_bf16(acc[6], acc[7]);
            af[ks] = __builtin_bit_cast(bf16x8, pk); }
        f32x16 ra, rx;
#pragma unroll
        for (int r = 0; r < 16; ++r) { ra[r] = 0.f; rx[r] = 0.f; }
#pragma unroll
        for (int ks = 0; ks < 4; ++ks) { ra = MFMA32(af[ks], wa[ks], ra); rx = MFMA32(af[ks], wx[ks], rx); }
        asm volatile("s_waitcnt lgkmcnt(0)" ::: "memory");
        float a[16], u[16];
#pragma unroll
        for (int r = 0; r < 16; ++r) { const int tl = crow(r, hi); const float xc = xcs[tl * 68 + hh * 32 + r32];
            const float rg = sigm_(ra[r] + ba), ig = sigm_(rx[r] + bx), la = sp8 * rg;
            a[r] = ex2(la * LOG2E);
            const float om = fmaf(-a[r], a[r], 1.0f);
            const float mult = (t0 + tl == 0) ? 1.0f : __builtin_amdgcn_sqrtf(om);
            u[r] = xc * ig * mult; }
        float EA[8], EU[8];
#pragma unroll
        for (int cg = 0; cg < 4; ++cg) { const int r0 = 4 * cg;
            const float GA = (a[r0] * a[r0 + 1]) * (a[r0 + 2] * a[r0 + 3]), GU = ((u[r0] * a[r0 + 1] + u[r0 + 1]) * a[r0 + 2] + u[r0 + 2]) * a[r0 + 3] + u[r0 + 3];
            const float PA = __shfl_xor(GA, 32), PU = __shfl_xor(GU, 32);
            EA[2 * cg] = hi ? PA : GA; EU[2 * cg] = hi ? PU : GU; EA[2 * cg + 1] = hi ? GA : PA; EU[2 * cg + 1] = hi ? GU : PU; }
        float TA = 1.f, TU = 0.f;
#pragma unroll
        for (int g = 0; g < 8; ++g) { TU = EA[g] * TU + EU[g]; TA *= EA[g]; }
        LAS float* tt2 = tot + (c & 1) * 512;
        if (hi == 0) { tt2[(w * 32 + r32) * 2] = TA; tt2[(w * 32 + r32) * 2 + 1] = TU; }
        __syncthreads();
        float h = hchunk, hin = 0.f;
#pragma unroll
        for (int ww = 0; ww < 8; ++ww) { if (ww == w) hin = h; h = tt2[(ww * 32 + r32) * 2] * h + tt2[(ww * 32 + r32) * 2 + 1]; }
        hchunk = h;
        float hown[4], hg = hin;
#pragma unroll
        for (int g = 0; g < 8; ++g) { if ((g & 1) == hi) hown[g >> 1] = hg; hg = EA[g] * hg + EU[g]; }
        LAS bf16_t* zy = (LAS bf16_t*)zst;
#pragma unroll
        for (int cg = 0; cg < 4; ++cg) { float hc = hown[cg];
#pragma unroll
            for (int q = 0; q < 4; ++q) { const int r = 4 * cg + q; hc = a[r] * hc + u[r];
                const int tl = crow(r, hi); const float z = bf2f(zy[tl * 32 + r32]); zy[tl * 32 + r32] = f2bf(hc * z); } }
        asm volatile("s_waitcnt lgkmcnt(0)" ::: "memory");
#pragma unroll
        for (int i = 0; i < 2; ++i) { const int e = lane + 64 * i; const v4u yv = *(const LAS v4u*)(zst + (e >> 2) * 64 + (e & 3) * 16);
            *(v4u*)(Y0 + (rowb + (e >> 2)) * 1792 + blk * 64 + hh * 32 + (e & 3) * 8) = yv; }
        asm volatile("s_waitcnt lgkmcnt(0)" ::: "memory");
    }
#undef LRU_LOAD
    __syncthreads();
}

__device__ __forceinline__ void cmp1_task(const Params& p, int task, int lane) {
    const int r32 = lane & 31, hi = lane >> 5;
    const int ct = task & 7, rt = (task >> 3) & 3, g = (task >> 5) & 1, b = (task >> 6) & 7, kv = task >> 9;
    const bf16_t* KV = (const bf16_t*)(p.ws + OFF_KV1); const bf16_t* w1 = (const bf16_t*)(p.ws + OFF_PHIW1) + (size_t)kv * 256 * 2048; bf16_t* hid = (bf16_t*)(p.ws + OFF_CMPH);
    const float* peb = (const float*)(p.ws + OFF_PEB) + kv * 256;
    const int n = rt * 32 + r32;
    const bf16_t* ar = KV + ((size_t)b * SEQ + 16 * n) * 768 + kv * 128 + g * 64 + hi * 8;
    const bf16_t* br = w1 + (size_t)(ct * 32 + r32) * 2048 + hi * 8;
    f32x16 acc;
#pragma unroll
    for (int r = 0; r < 16; ++r) acc[r] = 0.f;
#pragma unroll 4
    for (int i = 0; i < 32; ++i) {
#pragma unroll
        for (int q = 0; q < 4; ++q) { const bf16x8 af = *(const bf16x8*)(ar + (size_t)i * 768 + 16 * q), bf = *(const bf16x8*)(br + i * 64 + 16 * q); acc = MFMA32(af, bf, acc); }
    }
    float pb = 0.f;
#pragma unroll 8
    for (int c = 0; c < 64; ++c) pb += peb[c * 512 + ct * 32 + r32];
    const size_t rowbase = (((size_t)kv * NB + b) * 2 + g) * 128 + rt * 32;
#pragma unroll
    for (int r = 0; r < 16; ++r) { const float v = acc[r] + pb; hid[(rowbase + crow(r, hi)) * 256 + ct * 32 + r32] = f2bf(v * sigm_(v)); }
}
__device__ __forceinline__ void cmp2_task(const Params& p, int task, int lane) {
    const int r32 = lane & 31, hi = lane >> 5;
    const int dtile = task & 1, rt = (task >> 1) & 63, kv = task >> 7;
    const bf16_t* hid = (const bf16_t*)(p.ws + OFF_CMPH) + ((size_t)kv * 2048 + rt * 32 + r32) * 256 + hi * 8;
    const bf16_t* w2 = (const bf16_t*)(p.ws + OFF_PHIW2) + ((size_t)kv * 64 + dtile * 32 + r32) * 256 + hi * 8;
    bf16_t* ckv = (bf16_t*)(p.ws + OFF_CMPKV) + ((size_t)kv * 2048 + rt * 32) * 64 + dtile * 32 + r32;
    f32x16 acc;
#pragma unroll
    for (int r = 0; r < 16; ++r) acc[r] = 0.f;
#pragma unroll
    for (int ks = 0; ks < 16; ++ks) acc = MFMA32(*(const bf16x8*)(hid + 16 * ks), *(const bf16x8*)(w2 + 16 * ks), acc);
#pragma unroll
    for (int r = 0; r < 16; ++r) { const int row = rt * 32 + crow(r, hi); ckv[(size_t)crow(r, hi) * 64] = f2bf((row & 127) == 127 ? 0.f : acc[r]); }
}

__device__ __forceinline__ void memkv_task(const Params& p, int task, int lane) {
    const int r32 = lane & 31, hi = lane >> 5;
    const int ct = task & 15, rt = (task >> 4) & 63, l = task >> 10;
    const float* ar = p.mem + (size_t)(rt * 32 + r32) * DM + hi * 8;
    const bf16_t* br = (const bf16_t*)(p.ws + OFF_WMKV) + ((size_t)l * 512 + ct * 32 + r32) * DM + hi * 8;
    bf16_t* mkv = (bf16_t*)(p.ws + OFF_MEMKV) + (size_t)l * NB * NMEM * 512;
    f32x16 acc; float ss = 0.f;
#pragma unroll
    for (int r = 0; r < 16; ++r) acc[r] = 0.f;
#pragma unroll 4
    for (int ks = 0; ks < DM / 16; ++ks) { const f32x4 x0 = *(const f32x4*)(ar + 16 * ks), x1 = *(const f32x4*)(ar + 16 * ks + 4);
        ss += (x0[0] * x0[0] + x0[1] * x0[1]) + (x0[2] * x0[2] + x0[3] * x0[3]) + (x1[0] * x1[0] + x1[1] * x1[1]) + (x1[2] * x1[2] + x1[3] * x1[3]);
        v4u pk; pk.x = pg8::cvt_pk_bf16(x0[0], x0[1]); pk.y = pg8::cvt_pk_bf16(x0[2], x0[3]); pk.z = pg8::cvt_pk_bf16(x1[0], x1[1]); pk.w = pg8::cvt_pk_bf16(x1[2], x1[3]);
        acc = MFMA32(__builtin_bit_cast(bf16x8, pk), *(const bf16x8*)(br + 16 * ks), acc); }
    ss = xsum32(ss);
    const float rs = 1.0f / sqrtf(ss * (1.0f / DM) + EPS);
#pragma unroll
    for (int r = 0; r < 16; ++r) { const float rr = __shfl(rs, crow(r, hi)); mkv[(size_t)(rt * 32 + crow(r, hi)) * 512 + ct * 32 + r32] = f2bf(acc[r] * rr); }
}

#define XB_TMO      128
#define XB_XCNT(j)  (256  + 64 * (j))
#define XB_XSUB(j)  (1280 + 64 * (j))
#define XB_XGEN(j)  (2304 + 64 * (j))
#define XB_TOP      3328
#define XB_TOPGEN   3392
#define XCD_BAR_WORDS 3456
#define XB_SPIN_CAP (1u << 18)
__device__ __forceinline__ unsigned xb_ld(unsigned* p)              { return __hip_atomic_load(p, __ATOMIC_RELAXED, __HIP_MEMORY_SCOPE_AGENT); }
__device__ __forceinline__ unsigned xb_add(unsigned* p, unsigned v) { return __hip_atomic_fetch_add(p, v, __ATOMIC_RELAXED, __HIP_MEMORY_SCOPE_AGENT); }
__device__ __forceinline__ unsigned xb_xcc_id() { return (unsigned)__builtin_amdgcn_s_getreg((3 << 11) | 20) & 0xFu; }
#define XB_SPIN(cond, bar) do { unsigned _sp = 0; while (cond) { __builtin_amdgcn_s_sleep(1); \
    if ((++_sp & 255u) == 0u) { if (xb_ld(&(bar)[XB_TMO])) break; if (_sp > XB_SPIN_CAP) { atomicAdd(&(bar)[XB_TMO], 1u); break; } } } } while (0)
struct XcdBarrier { unsigned* bar; unsigned x; volatile LAS unsigned* st; };
__device__ __forceinline__ XcdBarrier xcd_barrier_post(unsigned* bar, volatile LAS unsigned* st) {
    XcdBarrier b; b.bar = bar; b.x = xb_xcc_id(); b.st = st;
    if (threadIdx.x == 0) (void)xb_add(&bar[XB_XCNT(b.x)], 1u);
    return b;
}
__device__ __forceinline__ void xcd_barrier_complete(unsigned* bar, unsigned x, unsigned& nloc, unsigned& nx) {
    const unsigned G = gridDim.x * gridDim.y * gridDim.z;
    unsigned sum, cnt, mine, sp = 0u;
    for (;;) {
        sum = 0u; cnt = 0u; mine = 0u;
#pragma unroll
        for (unsigned j = 0; j < 16; ++j) { const unsigned c = xb_ld(&bar[XB_XCNT(j)]); sum += c; cnt += (c > 0u) ? 1u : 0u; mine = (j == x) ? c : mine; }
        if (sum == G) break;
        __builtin_amdgcn_s_sleep(1);
        if ((++sp & 255u) == 0u) { if (xb_ld(&bar[XB_TMO])) break; if (sp > XB_SPIN_CAP) { atomicAdd(&bar[XB_TMO], 1u); break; } }
    }
    nloc = mine > 0u ? mine : 1u; nx = cnt > 0u ? cnt : 1u;
}
__device__ __forceinline__ void xcd_barrier(const XcdBarrier& b) {
    asm volatile("s_waitcnt vmcnt(0)" ::: "memory");
    __syncthreads();
    if (threadIdx.x == 0) {
        unsigned* bar = b.bar;
        __builtin_amdgcn_s_waitcnt(0);
        unsigned nloc = b.st[0], nx = b.st[1];
        if (nloc == 0u) { xcd_barrier_complete(bar, b.x, nloc, nx); b.st[0] = nloc; b.st[1] = nx; }
        const unsigned old = xb_add(&bar[XB_XSUB(b.x)], 1u);
        const unsigned gen = old / nloc;
        if (old + 1u == (gen + 1u) * nloc) {
            __builtin_amdgcn_fence(__ATOMIC_RELEASE, "agent");
            asm volatile("s_waitcnt vmcnt(0)" ::: "memory");
            const unsigned og = xb_add(&bar[XB_TOP], 1u);
            const unsigned tg = og / nx;
            if (og + 1u == (tg + 1u) * nx) xb_add(&bar[XB_TOPGEN], 1u);
            else XB_SPIN(xb_ld(&bar[XB_TOPGEN]) == tg, bar);
            __builtin_amdgcn_fence(__ATOMIC_ACQUIRE, "agent");
            xb_add(&bar[XB_XGEN(b.x)], 1u);
            asm volatile("s_waitcnt vmcnt(0)" ::: "memory");
        } else {
            XB_SPIN(xb_ld(&bar[XB_XGEN(b.x)]) == gen, bar);
            __builtin_amdgcn_fence(__ATOMIC_ACQUIRE, "agent");
            asm volatile("s_waitcnt vmcnt(0)" ::: "memory");
        }
    }
    __syncthreads();
}
#define GSYNC() xcd_barrier(bar)

__device__ __forceinline__ int fresh_tid() { int t = threadIdx.x; asm volatile("" : "+v"(t)); return t; }
#ifndef PROBE_REP
#define PROBE_REP -1
#endif
#define REP(k) for (int rep_ = 0; rep_ < ((PROBE_REP == (k)) ? 2 : 1); ++rep_)
#define PH_IDS() const int tid = fresh_tid(), lane = tid & 63, wave = __builtin_amdgcn_readfirstlane(tid >> 6); const long gt = (long)blockIdx.x * 512 + tid, nt = (long)G * 512; \
    const int gw = blockIdx.x * NWAVES + wave, NGW = G * NWAVES; (void)lane; (void)gt; (void)nt; (void)gw; (void)NGW
__device__ __forceinline__ Params load_params() {
    Params p{};
#if defined(__HIP_DEVICE_COMPILE__)
    typedef const __attribute__((address_space(4))) unsigned long long* kq_t;
    kq_t k = (kq_t)__builtin_amdgcn_kernarg_segment_ptr(); asm volatile("" : "+s"(k));
    unsigned long long* d = (unsigned long long*)&p;
#pragma unroll
    for (int i = 0; i < (int)(sizeof(Params) / 8); ++i) d[i] = k[i];
#endif
    return p;
}
#define PP() const Params p = load_params()
#ifndef PROBE_SKIP
#define PROBE_SKIP 0
#endif
#ifndef PROBE_TWICE
#define PROBE_TWICE 0
#endif
template <unsigned SKIP>
__global__ void __launch_bounds__(NWAVES * 64, 2) mega(Params p_unused_arg) {
    extern __shared__ __attribute__((aligned(16))) unsigned char lds_raw[];
    LAS unsigned char* lds = (LAS unsigned char*)lds_raw;
    const int G = gridDim.x;
    if (threadIdx.x < 4) ((LAS unsigned*)(lds + LDS_BYTES - 64))[threadIdx.x] = 0u;
    __syncthreads();
    XcdBarrier bar; { PP(); bar.bar = (unsigned*)(p.ws + OFF_CTRL); } bar.x = xb_xcc_id(); bar.st = (volatile LAS unsigned*)(lds + LDS_BYTES - 64);
    if (threadIdx.x == 0) bar.st[2] = xb_add(&bar.bar[XB_XCNT(bar.x)], 1u);

#define RUN(k) if constexpr (!((SKIP >> (k)) & 1u))
    {
    RUN(0) {
        PP(); PH_IDS();
        LAS float* scr = (LAS float*)(lds + wave * 16384);
        constexpr int I0 = (DM / 64) * (HAWK_IN / 32), I5 = (DM / 64) * (512 / 32);
        for (int it = gw; it < I0 + 2 * I5; it += NGW) {
            int r = it;
            if (r < I0) { p0_transpose_item<false>(p.hawk_w_in, DM, HAWK_IN, HAWK_IN, (bf16_t*)(p.ws + OFF_W0IN), scr, r, lane); continue; } r -= I0;
            if (r < I5) { p0_transpose_item<false>(p.hawk_w_mem_kv, DM, 512, 512, (bf16_t*)(p.ws + OFF_WMKV), scr, r, lane, p.hawk_mem_norm); continue; } r -= I5;
            p0_transpose_item<false>(p.nsa_w_mem_kv, DM, 512, 512, (bf16_t*)(p.ws + OFF_WMKV) + 512 * DM, scr, r, lane, p.nsa_mem_norm);
        }
        for (int m = gw; m < T_; m += 4 * NGW) rms_rows4_to_bf16(p.x, p.hawk_norm, (bf16_t*)(p.ws + OFF_XN), m, NGW, T_, lane);
        for (int m = gw; m < NB * NMEM; m += NGW) rms_row_to_bf16(p.mem + (size_t)m * DM, nullptr, (bf16_t*)(p.ws + OFF_MEMN) + (size_t)m * DM, lane);
    }
    GSYNC();
    if (threadIdx.x == 0) { bool even = (G % 8) == 0;
        for (unsigned j = 0; j < 16; ++j) { const unsigned c = xb_ld(&bar.bar[XB_XCNT(j)]); even = even && (c == (j < 8 ? (unsigned)G / 8u : 0u)); }
        bar.st[3] = even ? bar.st[2] * 8u + bar.x : blockIdx.x; }
    __syncthreads();
    const int vcu = (int)bar.st[3];
    RUN(2) { PP(); pg8::Gemm g{DM, DM, DM, 128, 128}; pg8::StaticOrder S; S.init((const bf16_t*)(p.ws + OFF_XN), (const bf16_t*)(p.ws + OFF_W0IN), T_, HAWK_IN, DM, G, vcu);
      S.extra((const bf16_t*)(p.ws + OFF_MEMN), (const bf16_t*)(p.ws + OFF_WMKV), NB * NMEM, 1024);
      pg8::EpiRoute E{p.ws, (bf16_t*)p.out, 0};
      pg8::gemm_phase<pg8::EpiRoute, pg8::StaticOrder, true, true>(lds, g, S, E); }
    RUN(1) {
        PP(); PH_IDS();
        constexpr int NU = (T_ / 256) * (HAWK_IN / 256) + 32;
        const int first_idle = (G > 0 && (NU % G) != 0) ? (NU % G) : 0, nidle = G - first_idle;
        const int me = vcu - first_idle;
        if (me >= 0) {
            LAS float* scr = (LAS float*)(lds + wave * 16384);
            constexpr int I1 = (HAWK_OUT / 64) * (DM / 32), I2 = (DM / 64) * (NSA_INP / 32), I3 = (NSA_OUT / 64) * (DM / 32), I4 = (2048 / 64) * (256 / 32), I6 = (256 / 64) * (64 / 32);
            for (int it = me * NWAVES + wave; it < I1 + I2 + I3 + 2 * I4 + 2 * I6; it += nidle * NWAVES) {
                int r = it;
                if (r < I1) { p0_transpose_item<false>(p.hawk_w_out, HAWK_OUT, DM, DM, (bf16_t*)(p.ws + OFF_W0OUT), scr, r, lane); continue; } r -= I1;
                if (r < I2) { p0_transpose_item<true>(p.nsa_w_in, DM, NSA_IN, NSA_INP, (bf16_t*)(p.ws + OFF_W1IN), scr, r, lane); continue; } r -= I2;
                if (r < I3) { p0_transpose_item<false>(p.nsa_w_out, NSA_OUT, DM, DM, (bf16_t*)(p.ws + OFF_W1OUT), scr, r, lane); continue; } r -= I3;
                if (r < I4) { p0_transpose_item<false>(p.phik_w1, 2048, 256, 256, (bf16_t*)(p.ws + OFF_PHIW1), scr, r, lane); continue; } r -= I4;
                if (r < I4) { p0_transpose_item<false>(p.phiv_w1, 2048, 256, 256, (bf16_t*)(p.ws + OFF_PHIW1) + 256 * 2048, scr, r, lane); continue; } r -= I4;
                if (r < I6) { p0_transpose_item<false>(p.phik_w2, 256, 64, 64, (bf16_t*)(p.ws + OFF_PHIW2), scr, r, lane); continue; } r -= I6;
                p0_transpose_item<false>(p.phiv_w2, 256, 64, 64, (bf16_t*)(p.ws + OFF_PHIW2) + 64 * 256, scr, r, lane);
            }
            for (int q = me * 512 + tid; q < 32768; q += nidle * 512) { const int o = q & 511, kv = o >> 8, j = o & 255, k0 = (q >> 9) * 32; const float* pe = kv ? p.pe_v : p.pe_k; const float* w1 = kv ? p.phiv_w1 : p.phik_w1; float a = 0.f;
#pragma unroll 8
                for (int k = 0; k < 32; ++k) a += pe[k0 + k] * w1[(size_t)(k0 + k) * 256 + j];
                ((float*)(p.ws + OFF_PEB))[q] = a; }
        }
    }
    GSYNC();
    {
        PP(); PH_IDS();
        if (gw < 512) { float v = ((const float*)(p.ws + OFF_PEB))[lane * 512 + gw]; v = wave_sum(v); if (lane == 0) ((float*)(p.ws + OFF_PEBS))[gw] = v; }
        RUN(3) for (int u = blockIdx.x; u < 256; u += G) lru_unit(p, lds, u);
        RUN(4) for (int task = gw; task < 6144; task += NGW) dil_task(p, lds + wave * 16384, task, lane);
        __syncthreads();
        RUN(5) for (int u = blockIdx.x; u < 256; u += G) mem_unit((const bf16_t*)(p.ws + OFF_MEMKV), (const bf16_t*)(p.ws + OFF_QM), (const bf16_t*)(p.ws + OFF_ZM), (bf16_t*)(p.ws + OFF_Y0) + 1536, 1792, lds, u);
    }
    GSYNC();
    RUN(6) { PP(); PH_IDS();
        const bf16_t* Q = (const bf16_t*)(p.ws + OFF_Q); const bf16_t* ZB = (const bf16_t*)(p.ws + OFF_ZB); const float* LSE = (const float*)(p.ws + OFF_LSE); bf16_t* Y0 = (bf16_t*)(p.ws + OFF_Y0);
        for (long i = gt; i < (long)T_ * 64; i += nt) { const int t = (int)(i >> 6), c8 = ((int)i & 63) * 8, h = c8 >> 7;
            const float l0 = LSE[((size_t)0 * T_ + t) * 4 + h], l1 = LSE[((size_t)1 * T_ + t) * 4 + h], l2 = LSE[((size_t)2 * T_ + t) * 4 + h];
            const float mx = fmaxf(l0, fmaxf(l1, l2)), e0 = __expf(l0 - mx), e1 = __expf(l1 - mx), e2 = __expf(l2 - mx), inv = 1.0f / (e0 + e1 + e2), w0 = e0 * inv, w1 = e1 * inv, w2 = e2 * inv;
            const v4u a = *(const v4u*)(Q + (size_t)t * 1536 + c8), b = *(const v4u*)(Q + (size_t)t * 1536 + 512 + c8), c = *(const v4u*)(Q + (size_t)t * 1536 + 1024 + c8), z = *(const v4u*)(ZB + (size_t)t * 512 + c8);
            v4u o;
#define CMB(f) { o.f = pg8::cvt_pk_bf16((w0 * lo16(a.f) + w1 * lo16(b.f) + w2 * lo16(c.f)) * lo16(z.f), (w0 * hi16(a.f) + w1 * hi16(b.f) + w2 * hi16(c.f)) * hi16(z.f)); }
            CMB(x) CMB(y) CMB(z) CMB(w)
#undef CMB
            *(v4u*)(Y0 + (size_t)t * 1792 + 1024 + c8) = o; } }
    GSYNC();
    if (G == 256) {
    RUN(7) { PP(); pg8::Gemm g{HAWK_OUT, HAWK_OUT, HAWK_OUT, 128, 128}; pg8::StaticOrder S; S.init((const bf16_t*)(p.ws + OFF_Y0), (const bf16_t*)(p.ws + OFF_W0OUT), T_, DM, HAWK_OUT, G, vcu);
      pg8::EpiResidNorm E{p.x, (float*)(p.ws + OFF_X1), nullptr, (bf16_t*)p.out, p.nsa_norm, DM, (float*)(p.ws + OFF_LSE), (unsigned*)(p.ws + OFF_CTRL + 16384)};
      pg8::gemm_phase<pg8::EpiResidNorm, pg8::StaticOrder, false, true>(lds, g, S, E); }
    GSYNC();
    } else {
    RUN(7) { PP(); pg8::Gemm g{HAWK_OUT, HAWK_OUT, HAWK_OUT, 128, 128}; pg8::StaticOrder S; S.init((const bf16_t*)(p.ws + OFF_Y0), (const bf16_t*)(p.ws + OFF_W0OUT), T_, DM, HAWK_OUT, G, vcu);
      pg8::EpiResid E{p.x, (float*)(p.ws + OFF_X1), DM};
      pg8::gemm_phase<pg8::EpiResid, pg8::StaticOrder, true, true>(lds, g, S, E); }
    GSYNC();
    RUN(8) { PP(); PH_IDS(); for (int m = gw; m < T_; m += 4 * NGW) rms_rows4_to_bf16((const float*)(p.ws + OFF_X1), p.nsa_norm, (bf16_t*)p.out, m, NGW, T_, lane); }
    GSYNC();
    }
    RUN(9) { PP(); pg8::Gemm g{DM, DM, DM, 128, 128}; pg8::StaticOrder S; S.init((const bf16_t*)p.out, (const bf16_t*)(p.ws + OFF_W1IN), T_, NSA_INP, DM, G, vcu);
      pg8::EpiRoute E{p.ws, (bf16_t*)p.out, 1};
      pg8::gemm_phase<pg8::EpiRoute, pg8::StaticOrder, true, true>(lds, g, S, E); }
    GSYNC();
    {
        PP();
        if (vcu < 16) {
            RUN(10) { const int kv = vcu >> 3, g = (vcu >> 2) & 1, rt = vcu & 3;
                pg8::Gemm gm{2048, 16 * 768, 2048, 768 * 2, 128}; pg8::OneUnit S; S.have = true; S.u.pm = rt; S.u.pn = 0; S.u.tag = kv * 2 + g;
                S.u.A = (const char*)((const bf16_t*)(p.ws + OFF_KV1) + kv * 128 + g * 64) + (size_t)rt * 256 * (16 * 768) * 2; S.u.B = (const char*)((const bf16_t*)(p.ws + OFF_PHIW1) + (size_t)kv * 256 * 2048);
                pg8::EpiCmp E{(const float*)(p.ws + OFF_PEBS), (const bf16_t*)(p.ws + OFF_PHIW2), (bf16_t*)(p.ws + OFF_CMPKV)};
                pg8::gemm_phase<pg8::EpiCmp, pg8::OneUnit, false, true>(lds, gm, S, E); }
        } else {
            RUN(11) for (int u = vcu - 16; u < 256; u += G - 16) mem_unit((const bf16_t*)(p.ws + OFF_MEMKV) + (size_t)NB * NMEM * 512, (const bf16_t*)(p.ws + OFF_QM1), (const bf16_t*)(p.ws + OFF_ZM1), (bf16_t*)(p.ws + OFF_Y1) + 1024, 1280, lds, u);
        }
    }
    GSYNC();
    RUN(13) { PP(); for (int u = blockIdx.x; u < 1024; u += G) nsa_unit<(SKIP >> 16)>(p, lds, u); }
    GSYNC();
    if (G == 256) {
    RUN(14) { PP(); pg8::Gemm g{NSA_OUT, NSA_OUT, NSA_OUT, 128, 128}; pg8::StaticOrder S; S.init((const bf16_t*)(p.ws + OFF_Y1), (const bf16_t*)(p.ws + OFF_W1OUT), T_, DM, NSA_OUT, G, vcu);
      pg8::EpiResidNorm E{(const float*)(p.ws + OFF_X1), nullptr, p.out, nullptr, p.final_norm, DM, (float*)(p.ws + OFF_LSE) + (size_t)T_ * 4, (unsigned*)(p.ws + OFF_CTRL + 16384 + 16384)};
      pg8::gemm_phase<pg8::EpiResidNorm, pg8::StaticOrder, false, true>(lds, g, S, E); }
    } else {
    RUN(14) { PP(); pg8::Gemm g{NSA_OUT, NSA_OUT, NSA_OUT, 128, 128}; pg8::StaticOrder S; S.init((const bf16_t*)(p.ws + OFF_Y1), (const bf16_t*)(p.ws + OFF_W1OUT), T_, DM, NSA_OUT, G, vcu);
      pg8::EpiResid E{(const float*)(p.ws + OFF_X1), p.out, DM};
      pg8::gemm_phase<pg8::EpiResid, pg8::StaticOrder, true, true>(lds, g, S, E); }
    GSYNC();
    RUN(15) { PP(); PH_IDS(); for (int m = gw; m < T_; m += NGW) rms_row_inplace(p.out + (size_t)m * DM, p.final_norm, lane); }
    }
    }
}

extern "C" void kernel_launch(void* const* d_in, const int* in_sizes, int n_in, void* d_out, int out_size, void* d_ws, size_t ws_size, hipStream_t stream) {
    static int grid_blocks = 0;
    if (!grid_blocks) {
        int dev = 0, cus = 0, per_cu = 0;
        (void)hipGetDevice(&dev);
        (void)hipDeviceGetAttribute(&cus, hipDeviceAttributeMultiprocessorCount, dev);
        if (hipFuncSetAttribute((const void*)mega<0u>, hipFuncAttributeMaxDynamicSharedMemorySize, LDS_BYTES) != hipSuccess) fprintf(stderr, "hipFuncSetAttribute failed\n");
#if PROBE_TWICE
        (void)hipFuncSetAttribute((const void*)mega<(unsigned)PROBE_SKIP>, hipFuncAttributeMaxDynamicSharedMemorySize, LDS_BYTES);
#endif
        (void)hipOccupancyMaxActiveBlocksPerMultiprocessor(&per_cu, (const void*)mega<0u>, NWAVES * 64, LDS_BYTES);
        if (per_cu < 1) fprintf(stderr, "occupancy query reports %d blocks per CU\n", per_cu);
        grid_blocks = cus;
        if (ws_size < WS_END) fprintf(stderr, "workspace too small: %zu < %zu\n", ws_size, (size_t)WS_END);
    }
    Params p{};
    const float** f = (const float**)&p;
    for (int i = 0; i < 26; ++i) f[i] = (const float*)d_in[i];
    p.out = (float*)d_out; p.ws = (unsigned char*)d_ws;
    void* args[] = {&p};
#if PROBE_TWICE
    (void)hipMemsetAsync((unsigned char*)d_ws + OFF_CTRL, 0, 16384 + 32768, stream);
    (void)hipLaunchCooperativeKernel((void*)mega<(unsigned)PROBE_SKIP>, dim3(grid_blocks), dim3(NWAVES * 64), args, LDS_BYTES, stream);
#endif
    (void)hipMemsetAsync((unsigned char*)d_ws + OFF_CTRL, 0, 16384 + 32768, stream);
    hipError_t e = hipLaunchCooperativeKernel((void*)mega<0u>, dim3(grid_blocks), dim3(NWAVES * 64), args, LDS_BYTES, stream);
    if (e != hipSuccess) fprintf(stderr, "cooperative launch failed: %s (grid %d)\n", hipGetErrorString(e), grid_blocks);
}
#endif
```

```cpp
#ifndef HOST_EMU
#include <hip/hip_runtime.h>
#include <hip/hip_cooperative_groups.h>
namespace cg = cooperative_groups;
#define DEVFN __device__ __forceinline__
#define DEVNI __device__ __forceinline__
#else
#include <cmath>
#include <cstdint>
#include <cstring>
#define DEVFN static inline
#define DEVNI static
#endif
#include <cstdio>
#include <cstdint>

#ifndef BATCH_
#define BATCH_ 8
#endif
#ifndef DM_
#define DM_ 1024
#endif

typedef unsigned short bf16_t;
constexpr int SEQ = 2048, NB = BATCH_, T_ = NB * SEQ, DM = DM_, NMEM = 256;
constexpr int HAWK_IN = 7680, HAWK_OUT = 1792, NSA_IN = 3376, NSA_INP = 3584, NSA_OUT = 1280;
constexpr float EPS = 1e-6f;

DEVFN float bf2f(bf16_t h) { union { unsigned u; float f; } c; c.u = (unsigned)h << 16; return c.f; }
DEVFN bf16_t f2bf(float f) { union { unsigned u; float f; } c; c.f = f; unsigned u = c.u; u += 0x7fffu + ((u >> 16) & 1u); return (bf16_t)(u >> 16); }
DEVFN float sigmoidf_(float x) { return 1.0f / (1.0f + expf(-x)); }
DEVFN float siluf_(float x) { return x / (1.0f + expf(-x)); }

constexpr size_t al256(size_t x) { return (x + 255) & ~(size_t)255; }
constexpr size_t OFF_CTRL = 0;
constexpr size_t OFF_W0OUT = 65536;
constexpr size_t OFF_W1IN = OFF_W0OUT + al256((size_t)DM * HAWK_OUT * 2);
constexpr size_t OFF_W1OUT = OFF_W1IN + al256((size_t)NSA_INP * DM * 2);
constexpr size_t OFF_PHIW1 = OFF_W1OUT + al256((size_t)DM * NSA_OUT * 2);
constexpr size_t OFF_MEMKV = OFF_PHIW1 + al256((size_t)2 * 256 * 2048 * 2);
constexpr size_t OFF_LSE = OFF_MEMKV + al256((size_t)2 * NB * NMEM * 512 * 2);
constexpr size_t OFF_PEB = OFF_LSE + al256((size_t)3 * T_ * 4 * 4) + 65536;
constexpr size_t OFF_PHIW2 = OFF_LSE + al256((size_t)3 * T_ * 4 * 4);
constexpr size_t OFF_PEBS = OFF_PHIW2 + 65536 + 131072;
constexpr size_t OFF_WMKV = OFF_PEBS + 4096;
constexpr size_t OFF_RA = OFF_WMKV + al256((size_t)2 * 512 * DM * 2);
constexpr size_t RA_BYTES = (size_t)T_ * 1792 * 2;
constexpr size_t OFF_XN = OFF_RA;
constexpr size_t OFF_W0IN = OFF_RA + (size_t)T_ * 1024 * 2;
constexpr size_t OFF_MEMN = OFF_W0IN + (size_t)HAWK_IN * DM * 2;
static_assert(OFF_MEMN + (size_t)NB * NMEM * DM * 2 <= OFF_RA + RA_BYTES, "region A: MEMN");
constexpr size_t OFF_Y0 = OFF_RA;
constexpr size_t OFF_Y1 = OFF_RA;
constexpr size_t OFF_CMPH = OFF_RA + (size_t)T_ * 1280 * 2;
constexpr size_t OFF_CMPKV = OFF_CMPH + al256((size_t)2 * NB * 2 * 128 * 256 * 4);
constexpr size_t OFF_SEL = OFF_CMPKV + al256((size_t)2 * NB * 2 * 128 * 64 * 4);
constexpr size_t OFF_IMP = OFF_SEL + al256((size_t)NB * 2 * SEQ * 4);
static_assert(OFF_W0IN + (size_t)HAWK_IN * DM * 2 <= OFF_RA + RA_BYTES, "region A: XN0 | W0IN");
static_assert(OFF_IMP + (size_t)NB * 2 * SEQ * 32 * 4 <= OFF_RA + RA_BYTES, "region A: layer-1 temporaries");
constexpr size_t OFF_Q = OFF_RA + RA_BYTES;
constexpr size_t OFF_K = OFF_Q + (size_t)T_ * 1536 * 2;
constexpr size_t OFF_V = OFF_K + (size_t)T_ * 1536 * 2;
constexpr size_t OFF_ZB = OFF_V + (size_t)T_ * 1536 * 2;
constexpr size_t OFF_QM = OFF_ZB + (size_t)T_ * 512 * 2;
constexpr size_t OFF_ZM = OFF_QM + (size_t)T_ * 256 * 2;
constexpr size_t WS_END = OFF_ZM + (size_t)T_ * 256 * 2;
constexpr size_t OFF_X1 = OFF_K;
constexpr size_t OFF_Z1 = OFF_K + (size_t)T_ * 1024 * 4;
constexpr size_t OFF_Q1 = OFF_Q;
constexpr size_t OFF_QM1 = OFF_Q + (size_t)T_ * 1024 * 2;
constexpr size_t OFF_ZM1 = OFF_QM1 + (size_t)T_ * 256 * 2;
constexpr size_t OFF_KV1 = OFF_ZB;
constexpr size_t OFF_GATE = OFF_ZM;
static_assert(OFF_Z1 + (size_t)T_ * 1024 * 2 <= OFF_ZB, "Z1 overlay");
static_assert(BATCH_ != 8 || DM_ != 1024 || WS_END <= (size_t)256 * 1024 * 1024, "workspace too big");

struct Params {
    const float *x, *mem, *hawk_norm, *hawk_w_in, *conv_w, *conv_b, *ga_w, *ga_b, *gx_w, *gx_b, *lam, *hawk_mem_norm, *hawk_w_mem_kv, *hawk_w_out;
    const float *nsa_norm, *nsa_w_in, *pe_k, *pe_v, *phik_w1, *phik_w2, *phiv_w1, *phiv_w2, *nsa_mem_norm, *nsa_w_mem_kv, *nsa_w_out, *final_norm;
    float* out; unsigned char* ws;
};

DEVFN int nsa_col_orig(int n) {
    if (n < 1792) return n;
    if (n < 2816) return n - 1792 + 1840;
    if (n < 3072) return n - 2816 + 2864;
    if (n < 3328) return n - 3072 + 3120;
    if (n < 3376) return n - 3328 + 1792;
    return -1;
}

DEVFN void p0_convert(const Params& p, long gt, long nt) {
    bf16_t* w0in = (bf16_t*)(p.ws + OFF_W0IN); bf16_t* w0out = (bf16_t*)(p.ws + OFF_W0OUT);
    bf16_t* w1in = (bf16_t*)(p.ws + OFF_W1IN); bf16_t* w1out = (bf16_t*)(p.ws + OFF_W1OUT); bf16_t* phiw1 = (bf16_t*)(p.ws + OFF_PHIW1);
    for (long i = gt; i < (long)DM * HAWK_IN; i += nt) { const int k = (int)(i / HAWK_IN), n = (int)(i % HAWK_IN); w0in[(size_t)n * DM + k] = f2bf(p.hawk_w_in[i]); }
    for (long i = gt; i < (long)HAWK_OUT * DM; i += nt) { const int k = (int)(i / DM), n = (int)(i % DM); w0out[(size_t)n * HAWK_OUT + k] = f2bf(p.hawk_w_out[i]); }
    for (long i = gt; i < (long)DM * NSA_INP; i += nt) { const int k = (int)(i / NSA_INP), n = (int)(i % NSA_INP); const int no = nsa_col_orig(n);
        w1in[(size_t)n * DM + k] = no >= 0 ? f2bf(p.nsa_w_in[(size_t)k * NSA_IN + no]) : (bf16_t)0; }
    for (long i = gt; i < (long)NSA_OUT * DM; i += nt) { const int k = (int)(i / DM), n = (int)(i % DM); w1out[(size_t)n * NSA_OUT + k] = f2bf(p.nsa_w_out[i]); }
    for (long i = gt; i < (long)2 * 2048 * 256; i += nt) { const int kv = (int)(i / (2048 * 256)), r = (int)(i % (2048 * 256)), k = r / 256, n = r % 256;
        phiw1[(size_t)kv * 256 * 2048 + (size_t)n * 2048 + k] = f2bf((kv ? p.phiv_w1 : p.phik_w1)[r]); }
}
DEVFN void rows_rmsnorm(const float* x, const float* g, bf16_t* xn, long gt, long nt) {
    for (long r = gt; r < T_; r += nt) {
        const float* xr = x + (size_t)r * DM; float ss = 0.f;
        for (int k = 0; k < DM; ++k) ss += xr[k] * xr[k];
        const float rs = 1.0f / sqrtf(ss / DM + EPS);
        for (int k = 0; k < DM; ++k) xn[(size_t)r * DM + k] = f2bf(xr[k] * rs * g[k]);
    }
}
DEVFN void p0_memkv(const Params& p, long gt, long nt) {
    bf16_t* mkv = (bf16_t*)(p.ws + OFF_MEMKV);
    for (long i = gt; i < (long)2 * NB * NMEM * 512; i += nt) {
        const int l = (int)(i / ((long)NB * NMEM * 512)), r = (int)((i / 512) % (NB * NMEM)), c = (int)(i % 512);
        const float* mr = p.mem + (size_t)r * DM; const float* g = l ? p.nsa_mem_norm : p.hawk_mem_norm; const float* w = l ? p.nsa_w_mem_kv : p.hawk_w_mem_kv;
        float ss = 0.f, acc = 0.f;
        for (int k = 0; k < DM; ++k) { const float v = mr[k]; ss += v * v; acc += v * g[k] * w[(size_t)k * 512 + c]; }
        mkv[i] = f2bf(acc / sqrtf(ss / DM + EPS));
    }
}

struct __attribute__((aligned(16))) U4 { unsigned x, y, z, w; };
DEVFN float lo16(unsigned u) { union { unsigned u; float f; } c; c.u = u << 16; return c.f; }
DEVFN float hi16(unsigned u) { union { unsigned u; float f; } c; c.u = u & 0xffff0000u; return c.f; }
DEVFN float dot_bf16(const bf16_t* a, const bf16_t* b, int n) {
    float s0 = 0.f, s1 = 0.f, s2 = 0.f, s3 = 0.f;
    for (int k = 0; k < n; k += 8) { const U4 va = *(const U4*)(a + k), vb = *(const U4*)(b + k);
        s0 += lo16(va.x) * lo16(vb.x) + hi16(va.x) * hi16(vb.x); s1 += lo16(va.y) * lo16(vb.y) + hi16(va.y) * hi16(vb.y);
        s2 += lo16(va.z) * lo16(vb.z) + hi16(va.z) * hi16(vb.z); s3 += lo16(va.w) * lo16(vb.w) + hi16(va.w) * hi16(vb.w); }
    return (s0 + s1) + (s2 + s3);
}

DEVFN void p1_gemm(const Params& p, long gt, long nt) {
    const bf16_t* xn = (const bf16_t*)(p.ws + OFF_XN); const bf16_t* w = (const bf16_t*)(p.ws + OFF_W0IN);
    bf16_t* xaza = (bf16_t*)p.out;
    for (long i = gt; i < (long)T_ * HAWK_IN; i += nt) {
        const int t = (int)(i / HAWK_IN), n = (int)(i % HAWK_IN);
        const bf16_t v = f2bf(dot_bf16(xn + (size_t)t * DM, w + (size_t)n * DM, DM));
        if (n < 2048) xaza[(size_t)t * 2048 + n] = v;
        else if (n < 3584) ((bf16_t*)(p.ws + OFF_Q))[(size_t)t * 1536 + n - 2048] = v;
        else if (n < 5120) ((bf16_t*)(p.ws + OFF_K))[(size_t)t * 1536 + n - 3584] = v;
        else if (n < 6656) ((bf16_t*)(p.ws + OFF_V))[(size_t)t * 1536 + n - 5120] = v;
        else if (n < 7168) ((bf16_t*)(p.ws + OFF_ZB))[(size_t)t * 512 + n - 6656] = v;
        else if (n < 7424) ((bf16_t*)(p.ws + OFF_QM))[(size_t)t * 256 + n - 7168] = v;
        else ((bf16_t*)(p.ws + OFF_ZM))[(size_t)t * 256 + n - 7424] = v;
    }
}

DEVFN void p2_lru(const Params& p, long gt, long nt) {
    const bf16_t* xaza = (const bf16_t*)p.out; bf16_t* Y0 = (bf16_t*)(p.ws + OFF_Y0);
    for (long i = gt; i < (long)NB * 1024; i += nt) {
        const int b = (int)(i / 1024), c = (int)(i % 1024), blk = c >> 6, j = c & 63;
        const float sp = log1pf(expf(-p.lam[c]));
        const float* gaw = p.ga_w + (size_t)blk * 4096; const float* gxw = p.gx_w + (size_t)blk * 4096;
        float h = 0.f;
        for (int t = 0; t < SEQ; ++t) {
            float ra = p.ga_b[c], ri = p.gx_b[c], xcj = 0.f;
            for (int ii = 0; ii < 64; ++ii) {
                const int cc = blk * 64 + ii; float xc = p.conv_b[cc];
                for (int k = 0; k < 4; ++k) { const int tt = t - 3 + k; if (tt >= 0) xc += p.conv_w[k * 1024 + cc] * bf2f(xaza[((size_t)b * SEQ + tt) * 2048 + cc]); }
                ra += xc * gaw[ii * 64 + j]; ri += xc * gxw[ii * 64 + j];
                if (ii == j) xcj = xc;
            }
            const float r = sigmoidf_(ra), ig = sigmoidf_(ri);
            const float log_a = -8.0f * r * sp, a = expf(log_a);
            const float mult = t == 0 ? 1.0f : sqrtf(-expm1f(2.0f * log_a));
            h = a * h + xcj * ig * mult;
            const size_t tt0 = (size_t)b * SEQ + t;
            Y0[tt0 * 1792 + c] = f2bf(h * siluf_(bf2f(xaza[tt0 * 2048 + 1024 + c])));
        }
    }
}
DEVNI void p2_dilated(const Params& p, long gt, long nt) {
    bf16_t* Q = (bf16_t*)(p.ws + OFF_Q); const bf16_t* K = (const bf16_t*)(p.ws + OFF_K); const bf16_t* V = (const bf16_t*)(p.ws + OFF_V);
    float* LSE = (float*)(p.ws + OFF_LSE);
    for (long i = gt; i < (long)T_ * 12; i += nt) {
        const int t = (int)(i / 12), hh = (int)(i % 12), g = hh >> 2, h = hh & 3, s = t % SEQ;
        const int dil = g == 0 ? 1 : (g == 1 ? 4 : 16);
        const float slope = exp2f(-8.0f * (float)(hh + 1) / 12.0f), scale = 0.08838834764831845f;
        bf16_t* qp = Q + (size_t)t * 1536 + hh * 128;
        float o[128], m = -1e30f, l = 0.f;
#pragma unroll
        for (int d = 0; d < 128; ++d) o[d] = 0.f;
        for (int jj = 0; jj <= 128; ++jj) {
            const int sk = s - jj * dil; if (sk < 0) break;
            const bf16_t* kp = K + (size_t)(t - jj * dil) * 1536 + hh * 128; const bf16_t* vp = V + (size_t)(t - jj * dil) * 1536 + hh * 128;
            float sc = 0.f;
#pragma nounroll
            for (int d = 0; d < 128; ++d) sc += bf2f(qp[d]) * bf2f(kp[d]);
            sc = sc * scale - slope * (float)(jj * dil);
            const float mn = fmaxf(m, sc), al = expf(m - mn), pe = expf(sc - mn);
            l = l * al + pe; m = mn;
#pragma unroll
            for (int d = 0; d < 128; ++d) o[d] = o[d] * al + pe * bf2f(vp[d]);
        }
        const float inv = 1.0f / l;
#pragma unroll
        for (int d = 0; d < 128; ++d) qp[d] = f2bf(o[d] * inv);
        LSE[((size_t)g * T_ + t) * 4 + h] = m + logf(l);
    }
}
DEVFN void p2_combine(const Params& p, long gt, long nt) {
    const bf16_t* Q = (const bf16_t*)(p.ws + OFF_Q); const bf16_t* ZB = (const bf16_t*)(p.ws + OFF_ZB); const float* LSE = (const float*)(p.ws + OFF_LSE); bf16_t* Y0 = (bf16_t*)(p.ws + OFF_Y0);
    for (long i = gt; i < (long)T_ * 512; i += nt) {
        const int t = (int)(i / 512), c = (int)(i % 512), h = c >> 7;
        const float l0 = LSE[((size_t)0 * T_ + t) * 4 + h], l1 = LSE[((size_t)1 * T_ + t) * 4 + h], l2 = LSE[((size_t)2 * T_ + t) * 4 + h];
        const float mx = fmaxf(l0, fmaxf(l1, l2)), e0 = expf(l0 - mx), e1 = expf(l1 - mx), e2 = expf(l2 - mx), inv = 1.0f / (e0 + e1 + e2);
        const float o = (e0 * bf2f(Q[(size_t)t * 1536 + c]) + e1 * bf2f(Q[(size_t)t * 1536 + 512 + c]) + e2 * bf2f(Q[(size_t)t * 1536 + 1024 + c])) * inv;
        Y0[(size_t)t * 1792 + 1024 + c] = f2bf(o * siluf_(bf2f(ZB[i])));
    }
}
DEVNI void mem_attn(const bf16_t* mkv, const bf16_t* QMb, const bf16_t* ZMb, bf16_t* Y, int ldy, long gt, long nt) {
    for (long i = gt; i < (long)T_ * 4; i += nt) {
        const int t = (int)(i / 4), h = (int)(i % 4), b = t / SEQ;
        const bf16_t* qp = QMb + (size_t)t * 256 + h * 64;
        float o[64], m = -1e30f, l = 0.f;
#pragma unroll
        for (int d = 0; d < 64; ++d) o[d] = 0.f;
        for (int j = 0; j < NMEM; ++j) {
            const bf16_t* kp = mkv + ((size_t)b * NMEM + j) * 512 + h * 64; const bf16_t* vp = kp + 256;
            float sc = 0.f;
#pragma nounroll
            for (int d = 0; d < 64; ++d) sc += bf2f(qp[d]) * bf2f(kp[d]);
            sc *= 0.125f;
            const float mn = fmaxf(m, sc), al = expf(m - mn), pe = expf(sc - mn);
            l = l * al + pe; m = mn;
#pragma unroll
            for (int d = 0; d < 64; ++d) o[d] = o[d] * al + pe * bf2f(vp[d]);
        }
        const float inv = 1.0f / l;
#pragma unroll
        for (int d = 0; d < 64; ++d) Y[(size_t)t * ldy + h * 64 + d] = f2bf(o[d] * inv * siluf_(bf2f(ZMb[(size_t)t * 256 + h * 64 + d])));
    }
}

DEVFN void p3_gemm(const Params& p, long gt, long nt) {
    const bf16_t* y = (const bf16_t*)(p.ws + OFF_Y0); const bf16_t* w = (const bf16_t*)(p.ws + OFF_W0OUT); float* x1 = (float*)(p.ws + OFF_X1);
    for (long i = gt; i < (long)T_ * DM; i += nt) {
        const int t = (int)(i / DM), n = (int)(i % DM);
        x1[i] = p.x[i] + dot_bf16(y + (size_t)t * HAWK_OUT, w + (size_t)n * HAWK_OUT, HAWK_OUT);
    }
}
DEVFN void p4_gemm(const Params& p, long gt, long nt) {
    const bf16_t* xn = (const bf16_t*)(p.ws + OFF_XN); const bf16_t* w = (const bf16_t*)(p.ws + OFF_W1IN);
    for (long i = gt; i < (long)T_ * NSA_IN; i += nt) {
        const int t = (int)(i / NSA_IN), n = (int)(i % NSA_IN);
        const float a = dot_bf16(xn + (size_t)t * DM, w + (size_t)n * DM, DM); const bf16_t v = f2bf(a);
        if (n < 1024) ((bf16_t*)(p.ws + OFF_Q1))[(size_t)t * 1024 + n] = v;
        else if (n < 1792) ((bf16_t*)(p.ws + OFF_KV1))[(size_t)t * 768 + n - 1024] = v;
        else if (n < 2816) ((bf16_t*)(p.ws + OFF_Z1))[(size_t)t * 1024 + n - 1792] = v;
        else if (n < 3072) ((bf16_t*)(p.ws + OFF_QM1))[(size_t)t * 256 + n - 2816] = v;
        else if (n < 3328) ((bf16_t*)(p.ws + OFF_ZM1))[(size_t)t * 256 + n - 3072] = v;
        else ((bf16_t*)(p.ws + OFF_GATE))[(size_t)t * 256 + n - 3328] = v;
    }
}
DEVFN void p5_cmp1(const Params& p, long gt, long nt) {
    const bf16_t* KV = (const bf16_t*)(p.ws + OFF_KV1); const bf16_t* w1 = (const bf16_t*)(p.ws + OFF_PHIW1); float* hid = (float*)(p.ws + OFF_CMPH);
    for (long i = gt; i < (long)2 * NB * 2 * 127 * 256; i += nt) {
        const int j = (int)(i % 256); long r = i / 256; const int n = (int)(r % 127); r /= 127; const int g = (int)(r % 2); r /= 2; const int b = (int)(r % NB), kv = (int)(r / NB);
        const float* pe = kv ? p.pe_v : p.pe_k; const bf16_t* wj = w1 + ((size_t)kv * 256 + j) * 2048;
        float acc = 0.f;
        for (int ii = 0; ii < 32; ++ii) { const bf16_t* tp = KV + ((size_t)b * SEQ + 16 * n + ii) * 768 + kv * 128 + g * 64;
            for (int d = 0; d < 64; ++d) acc += (bf2f(tp[d]) + pe[ii * 64 + d]) * bf2f(wj[ii * 64 + d]); }
        hid[((((size_t)kv * NB + b) * 2 + g) * 128 + n) * 256 + j] = siluf_(acc);
    }
}
DEVFN void p5_cmp2(const Params& p, long gt, long nt) {
    const float* hid = (const float*)(p.ws + OFF_CMPH); bf16_t* ckv = (bf16_t*)(p.ws + OFF_CMPKV);
    for (long i = gt; i < (long)2 * NB * 2 * 128 * 64; i += nt) {
        const int d = (int)(i % 64); long r = i / 64; const int n = (int)(r % 128); r /= 128; const int g = (int)(r % 2); r /= 2; const int b = (int)(r % NB), kv = (int)(r / NB);
        const float* w2 = kv ? p.phiv_w2 : p.phik_w2; const size_t row = (((size_t)kv * NB + b) * 2 + g) * 128 + n;
        float acc = 0.f;
        if (n < 127) for (int j = 0; j < 256; ++j) acc += hid[row * 256 + j] * w2[j * 64 + d];
        ckv[row * 64 + d] = f2bf(acc);
    }
}
DEVNI void p5_cmp_attn(const Params& p, long gt, long nt) {
    const bf16_t* Q1 = (const bf16_t*)(p.ws + OFF_Q1); const bf16_t* ckv = (const bf16_t*)(p.ws + OFF_CMPKV); const bf16_t* gate = (const bf16_t*)(p.ws + OFF_GATE);
    unsigned* SEL = (unsigned*)(p.ws + OFF_SEL); float* ocmp = p.out; float* IMP = (float*)(p.ws + OFF_IMP);
    for (long i = gt; i < (long)NB * 2 * SEQ; i += nt) {
        const int s = (int)(i % SEQ), g = (int)((i / SEQ) % 2), b = (int)(i / (2 * SEQ)); const int t = b * SEQ + s;
        const bf16_t* kc = ckv + (((size_t)0 * NB + b) * 2 + g) * 128 * 64; const bf16_t* vc = ckv + (((size_t)1 * NB + b) * 2 + g) * 128 * 64;
        const int nvis = s >= 31 ? (s - 31) / 16 + 1 : 0;
        float* imp = IMP + (size_t)i * 32;
        for (int r = 0; r < 8; ++r) {
            const int hidx = g * 8 + r; const float slope = exp2f(-0.5f * (float)(hidx + 1));
            const bf16_t* qp = Q1 + (size_t)t * 1024 + hidx * 64;
            float m = -1e30f;
            for (int n = 0; n < nvis; ++n) { float sc = 0.f;
_Pragma("nounroll") for (int d = 0; d < 64; ++d) sc += bf2f(qp[d]) * bf2f(kc[n * 64 + d]);
                sc = sc * 0.125f - slope * (float)(s - (16 * n + 31)); m = fmaxf(m, sc); }
            float l = 0.f;
            for (int n = 0; n < nvis; ++n) { float sc = 0.f;
_Pragma("nounroll") for (int d = 0; d < 64; ++d) sc += bf2f(qp[d]) * bf2f(kc[n * 64 + d]);
                sc = sc * 0.125f - slope * (float)(s - (16 * n + 31)); l += expf(sc - m); }
            const float inv = nvis > 0 ? 1.0f / l : 0.f;
            float o[64];
#pragma unroll
            for (int d = 0; d < 64; ++d) o[d] = 0.f;
            float carry = 0.f;
            for (int j = 0; j < 32; ++j) {
                float acc = carry; carry = 0.f;
                for (int q4 = 0; q4 < 4; ++q4) { const int n = 4 * j + q4;
                    if (n < nvis) { float sc = 0.f;
_Pragma("nounroll") for (int d = 0; d < 64; ++d) sc += bf2f(qp[d]) * bf2f(kc[n * 64 + d]);
                        sc = sc * 0.125f - slope * (float)(s - (16 * n + 31)); const float pr = expf(sc - m) * inv;
                        acc += pr; if (q4 == 3) carry = pr;
#pragma unroll
                        for (int d = 0; d < 64; ++d) o[d] += pr * bf2f(vc[n * 64 + d]); } }
                imp[j] = (r == 0 ? 0.f : imp[j]) + acc;
            }
            const float g0 = sigmoidf_(bf2f(gate[(size_t)t * 256 + hidx * 3 + 0]));
#pragma unroll
            for (int d = 0; d < 64; ++d) ocmp[(size_t)t * 1024 + hidx * 64 + d] = g0 * o[d];
        }
        const int cur = s >> 6; unsigned mask = 1u | (1u << cur) | (cur > 0 ? (1u << (cur - 1)) : 0u);
        const int nf = cur == 0 ? 1 : (cur == 1 ? 2 : 3), need = 8 - nf;
        for (int j = 1; j < 30; ++j) {
            if (j <= cur - 2) { int rank = 0;
                for (int j2 = 1; j2 < 30; ++j2) if (j2 <= cur - 2 && j2 != j) rank += (imp[j2] > imp[j] || (imp[j2] == imp[j] && j2 < j)) ? 1 : 0;
                if (rank < need) mask |= 1u << j; }
        }
        SEL[i] = mask;
    }
}
DEVNI void p5_slc_win(const Params& p, long gt, long nt) {
    const bf16_t* Q1 = (const bf16_t*)(p.ws + OFF_Q1); const bf16_t* KV = (const bf16_t*)(p.ws + OFF_KV1); const bf16_t* gate = (const bf16_t*)(p.ws + OFF_GATE);
    const unsigned* SEL = (const unsigned*)(p.ws + OFF_SEL); const float* ocmp = p.out; const bf16_t* Z1 = (const bf16_t*)(p.ws + OFF_Z1); bf16_t* Y1 = (bf16_t*)(p.ws + OFF_Y1);
    for (long i = gt; i < (long)T_ * 16; i += nt) {
        const int t = (int)(i / 16), hidx = (int)(i % 16), g = hidx >> 3, b = t / SEQ, s = t % SEQ;
        const float slope = exp2f(-0.5f * (float)(hidx + 1));
        const bf16_t* qp = Q1 + (size_t)t * 1024 + hidx * 64;
        const unsigned mask = SEL[((size_t)b * 2 + g) * SEQ + s];
        float res[64];
        {
            float o[64], m = -1e30f, l = 0.f;
#pragma unroll
            for (int d = 0; d < 64; ++d) o[d] = 0.f;
            for (int j = 0; j < 32; ++j) { if (!((mask >> j) & 1u)) continue;
                for (int kk = 0; kk < 64; ++kk) { const int kpos = j * 64 + kk; if (kpos > s) break;
                    const bf16_t* kp = KV + ((size_t)b * SEQ + kpos) * 768 + 2 * 128 + g * 64; const bf16_t* vp = kp + 128;
                    float sc = 0.f;
#pragma nounroll
                    for (int d = 0; d < 64; ++d) sc += bf2f(qp[d]) * bf2f(kp[d]);
                    sc = sc * 0.125f - slope * (float)(s - kpos);
                    const float mn = fmaxf(m, sc), al = expf(m - mn), pe = expf(sc - mn); l = l * al + pe; m = mn;
#pragma unroll
                    for (int d = 0; d < 64; ++d) o[d] = o[d] * al + pe * bf2f(vp[d]); } }
            const float g1 = sigmoidf_(bf2f(gate[(size_t)t * 256 + hidx * 3 + 1])) / l;
#pragma unroll
            for (int d = 0; d < 64; ++d) res[d] = ocmp[(size_t)t * 1024 + hidx * 64 + d] + g1 * o[d];
        }
        {
            float o[64], m = -1e30f, l = 0.f;
#pragma unroll
            for (int d = 0; d < 64; ++d) o[d] = 0.f;
            for (int kpos = (s - 511 > 0 ? s - 511 : 0); kpos <= s; ++kpos) {
                const bf16_t* kp = KV + ((size_t)b * SEQ + kpos) * 768 + 4 * 128 + g * 64; const bf16_t* vp = kp + 128;
                float sc = 0.f;
#pragma nounroll
                for (int d = 0; d < 64; ++d) sc += bf2f(qp[d]) * bf2f(kp[d]);
                sc = sc * 0.125f - slope * (float)(s - kpos);
                const float mn = fmaxf(m, sc), al = expf(m - mn), pe = expf(sc - mn); l = l * al + pe; m = mn;
#pragma unroll
                for (int d = 0; d < 64; ++d) o[d] = o[d] * al + pe * bf2f(vp[d]); }
            const float g2 = sigmoidf_(bf2f(gate[(size_t)t * 256 + hidx * 3 + 2])) / l;
#pragma unroll
            for (int d = 0; d < 64; ++d) res[d] += g2 * o[d];
        }
#pragma unroll
        for (int d = 0; d < 64; ++d) Y1[(size_t)t * 1280 + hidx * 64 + d] = f2bf(res[d] * siluf_(bf2f(Z1[(size_t)t * 1024 + hidx * 64 + d])));
    }
}
DEVFN void p6_gemm(const Params& p, long gt, long nt) {
    const bf16_t* y = (const bf16_t*)(p.ws + OFF_Y1); const bf16_t* w = (const bf16_t*)(p.ws + OFF_W1OUT); const float* x1 = (const float*)(p.ws + OFF_X1);
    for (long i = gt; i < (long)T_ * DM; i += nt) {
        const int t = (int)(i / DM), n = (int)(i % DM);
        p.out[i] = x1[i] + dot_bf16(y + (size_t)t * NSA_OUT, w + (size_t)n * NSA_OUT, NSA_OUT);
    }
}
DEVFN void p7_final(const Params& p, long gt, long nt) {
    for (long r = gt; r < T_; r += nt) {
        float* xr = p.out + (size_t)r * DM; float ss = 0.f;
        for (int k = 0; k < DM; ++k) ss += xr[k] * xr[k];
        const float rs = 1.0f / sqrtf(ss / DM + EPS);
        for (int k = 0; k < DM; ++k) xr[k] = xr[k] * rs * p.final_norm[k];
    }
}

#ifndef HOST_EMU
static_assert(DM == 1024 && NB == 8, "device build is for the real shapes");
#define LAS __attribute__((address_space(3)))
#define GAS __attribute__((address_space(1)))
typedef unsigned v4u __attribute__((ext_vector_type(4)));
typedef float f32x4 __attribute__((ext_vector_type(4)));
typedef short bf16x8 __attribute__((ext_vector_type(8)));
typedef unsigned v2u __attribute__((ext_vector_type(2)));
#define LDS_WAIT() asm volatile("s_waitcnt lgkmcnt(0)" ::: "memory")
#define VM_WAIT() asm volatile("s_waitcnt vmcnt(0)" ::: "memory")
__device__ __forceinline__ unsigned pk2(float lo, float hi) { return (unsigned)f2bf(lo) | ((unsigned)f2bf(hi) << 16); }

__device__ __forceinline__ int fresh_tid();
namespace pg8 {
constexpr int BM = 256, BK = 64, HALF = 128, HTB = HALF * BK * 2  , STAGE_BYTES = 8 * HTB, NXCD = 8, WGM = 4;
__host__ __device__ __forceinline__ int lds_byte(int r, int c) { const int st = (r >> 4) * 2 + (c >> 5), rr = r & 15, cc = c & 31, ob = rr * 64 + cc * 2; return st * 1024 + (ob ^ (((ob >> 9) & 1) << 5)); }
__host__ __device__ __forceinline__ void stage_rc(int b, int& R, int& C) { const int st = b / 1024, sb = b % 1024, swz = sb ^ (((sb >> 9) & 1) << 5); R = (st >> 1) * 16 + swz / 64; C = (st & 1) * 32 + (swz % 64) / 2; }
__host__ __device__ __forceinline__ int perm32(int rho) { const int n = rho >> 4, i = rho & 15; return 8 * (i >> 2) + 4 * n + (i & 3); }
struct Unit { int pm, pn, tag; const char* A; const char* B; };
struct Gemm { int K, lda, ldb, kstepA, kstepB; };
struct StaticOrder {
    int nM, nN, nwg, G, c, K; const char* A; const char* B; int nE, nNe; const char* Ae; const char* Be;
    __host__ __device__ void init(const bf16_t* A_, const bf16_t* B_, int M, int N, int K_, int G_, int c_) { A = (const char*)A_; B = (const char*)B_; K = K_; nM = M / BM; nN = N / BM; nwg = nM * nN; G = G_; c = c_; nE = 0; nNe = 1; Ae = Be = nullptr; }
    __host__ __device__ void extra(const bf16_t* A_, const bf16_t* B_, int M, int N) { Ae = (const char*)A_; Be = (const char*)B_; nNe = N / BM; nE = (M / BM) * nNe; }
    __host__ __device__ __forceinline__ bool next(int i, Unit& u) const {
        const long L = (long)i * G + c; const size_t tstep = (size_t)BM * K * 2;
        if (L >= nwg) { const long e = L - nwg; if (e >= nE) return false; u.pm = (int)(e / nNe); u.pn = (int)(e % nNe); u.tag = 1; u.A = Ae + (size_t)u.pm * tstep; u.B = Be + (size_t)u.pn * tstep; return true; }
        int wgid = (int)L; { const int q = nwg / NXCD, r = nwg % NXCD, xcd = wgid % NXCD, off = wgid / NXCD; wgid = (xcd < r ? xcd * (q + 1) : r * (q + 1) + (xcd - r) * q) + off; }
        const int nig = WGM * nN, gid = wgid / nig, fm = gid * WGM, gsz = (nM - fm) < WGM ? (nM - fm) : WGM;
        u.pm = fm + ((wgid % nig) % gsz); u.pn = (wgid % nig) / gsz; u.tag = 0; u.A = A + (size_t)u.pm * tstep; u.B = B + (size_t)u.pn * tstep; return true;
    }
    __device__ __forceinline__ void a_ready(const Unit&) const {}
    __device__ __forceinline__ void done(const Unit&) const {}
};
struct OneUnit {
    Unit u; bool have;
    __host__ __device__ __forceinline__ bool next(int i, Unit& o) const { if (i != 0 || !have) return false; o = u; return true; }
    __device__ __forceinline__ void a_ready(const Unit&) const {}
    __device__ __forceinline__ void done(const Unit&) const {}
};
typedef __bf16 bf16x2_t __attribute__((ext_vector_type(2)));
__device__ __forceinline__ unsigned cvt_pk_bf16(float lo, float hi) { const bf16x2_t v = {(__bf16)lo, (__bf16)hi}; return __builtin_bit_cast(unsigned, v); }

struct EpiRoute {
    static constexpr bool PERM = true, AFTER_DRAIN = false;
    unsigned char* ws; bf16_t* xaza; int layer;
    __device__ __forceinline__ void operator()(const f32x4 (&acc)[2][2][4][2], const Unit& u, int wr, int wc, int fr, int fq) const {
        bf16_t* base; int ldc, colt; const int pn = u.pn;
        if (u.tag == 1) { base = (bf16_t*)(ws + OFF_MEMKV) + (size_t)(pn >> 1) * NB * NMEM * 512; ldc = 512; colt = (pn & 1) * 256; }
        else if (layer == 0) {
            if (pn < 8) { base = xaza; ldc = 2048; colt = pn * 256; }
            else if (pn < 14) { base = (bf16_t*)(ws + OFF_Q); ldc = 1536; colt = (pn - 8) * 256; }
            else if (pn < 20) { base = (bf16_t*)(ws + OFF_K); ldc = 1536; colt = (pn - 14) * 256; }
            else if (pn < 26) { base = (bf16_t*)(ws + OFF_V); ldc = 1536; colt = (pn - 20) * 256; }
            else if (pn < 28) { base = (bf16_t*)(ws + OFF_ZB); ldc = 512; colt = (pn - 26) * 256; }
            else if (pn < 29) { base = (bf16_t*)(ws + OFF_QM); ldc = 256; colt = 0; }
            else { base = (bf16_t*)(ws + OFF_ZM); ldc = 256; colt = 0; }
        } else {
            if (pn < 4) { base = (bf16_t*)(ws + OFF_Q1); ldc = 1024; colt = pn * 256; }
            else if (pn < 7) { base = (bf16_t*)(ws + OFF_KV1); ldc = 768; colt = (pn - 4) * 256; }
            else if (pn < 11) { base = (bf16_t*)(ws + OFF_Z1); ldc = 1024; colt = (pn - 7) * 256; }
            else if (pn < 12) { base = (bf16_t*)(ws + OFF_QM1); ldc = 256; colt = 0; }
            else if (pn < 13) { base = (bf16_t*)(ws + OFF_ZM1); ldc = 256; colt = 0; }
            else { base = (bf16_t*)(ws + OFF_GATE); ldc = 256; colt = 0; }
        }
        const int row0 = u.pm * BM + wr * 64 + fr, col0 = colt + wc * 32 + 8 * fq;
        const bool act = u.tag == 0 && (layer == 0 ? ((pn >= 4 && pn < 8) || pn == 26 || pn == 27 || pn == 29) : ((pn >= 7 && pn < 11) || pn == 12));
#pragma unroll
        for (int ai = 0; ai < 2; ++ai)
#pragma unroll
            for (int m = 0; m < 4; ++m) { bf16_t* rowp = base + (size_t)(row0 + ai * HALF + m * 16) * ldc + col0;
#pragma unroll
                for (int bj = 0; bj < 2; ++bj) { f32x4 v0 = acc[ai][bj][m][0], v1 = acc[ai][bj][m][1];
                    if (act) {
#pragma unroll
                        for (int e = 0; e < 4; ++e) { v0[e] = v0[e] * __builtin_amdgcn_rcpf(1.0f + __builtin_amdgcn_exp2f(-v0[e] * 1.4426950408889634f)); v1[e] = v1[e] * __builtin_amdgcn_rcpf(1.0f + __builtin_amdgcn_exp2f(-v1[e] * 1.4426950408889634f)); } }
                    v4u w; w.x = cvt_pk_bf16(v0[0], v0[1]); w.y = cvt_pk_bf16(v0[2], v0[3]); w.z = cvt_pk_bf16(v1[0], v1[1]); w.w = cvt_pk_bf16(v1[2], v1[3]);
                    *(v4u*)(rowp + bj * HALF) = w; } }
    }
};
struct EpiResid {
    static constexpr bool PERM = false, AFTER_DRAIN = false;
    const float* base; float* out; int ldc;
    __device__ __forceinline__ void operator()(const f32x4 (&acc)[2][2][4][2], const Unit& u, int wr, int wc, int fr, int fq) const {
        const int col0 = u.pn * BM + wc * 32 + 4 * fq;
#pragma unroll
        for (int ai = 0; ai < 2; ++ai)
#pragma unroll
            for (int m = 0; m < 4; ++m) { const size_t off = (size_t)(u.pm * BM + ai * HALF + wr * 64 + m * 16 + fr) * ldc + col0;
#pragma unroll
                for (int bj = 0; bj < 2; ++bj)
#pragma unroll
                    for (int n = 0; n < 2; ++n) { const f32x4 bs = *(const f32x4*)(base + off + bj * HALF + n * 16); *(f32x4*)(out + off + bj * HALF + n * 16) = bs + acc[ai][bj][m][n]; } }
    }
};

struct EpiResidNorm {
    static constexpr bool PERM = false, AFTER_DRAIN = true;
    const float* base; float* outx; float* outn; bf16_t* xn; const float* gain; int ldc; float* xb; unsigned* cnt;
    __device__ __forceinline__ void fused(f32x4 (&acc)[2][2][4][2], const Unit& u, int wr, int wc, int fr, int fq, LAS unsigned char* lds, int wid, int lane) const {
        LAS float* P = (LAS float*)lds; LAS float* S = (LAS float*)(lds + 4096);
        const int col0 = u.pn * BM + wc * 32 + 4 * fq, tid = wid * 64 + lane;
#pragma unroll
        for (int ai = 0; ai < 2; ++ai)
#pragma unroll
            for (int m = 0; m < 4; ++m) { const int rl = ai * HALF + wr * 64 + m * 16 + fr; const size_t off = (size_t)(u.pm * BM + rl) * ldc + col0; float ss = 0.f;
#pragma unroll
                for (int bj = 0; bj < 2; ++bj)
#pragma unroll
                    for (int n = 0; n < 2; ++n) { const f32x4 v = *(const f32x4*)(base + off + bj * HALF + n * 16) + acc[ai][bj][m][n]; acc[ai][bj][m][n] = v;
                        if (outx) *(f32x4*)(outx + off + bj * HALF + n * 16) = v;
                        ss += (v[0] * v[0] + v[1] * v[1]) + (v[2] * v[2] + v[3] * v[3]); }
                ss += __shfl_xor(ss, 16); ss += __shfl_xor(ss, 32);
                if (fq == 0) P[rl * 4 + wc] = ss; }
        asm volatile("s_waitcnt lgkmcnt(0)" ::: "memory"); __builtin_amdgcn_s_barrier(); asm volatile("" ::: "memory");
        if (tid < 256) { const float t = (P[tid * 4] + P[tid * 4 + 1]) + (P[tid * 4 + 2] + P[tid * 4 + 3]);
            __hip_atomic_store((unsigned*)xb + ((size_t)(u.pm * BM + tid) * 4 + u.pn), __float_as_uint(t), __ATOMIC_RELAXED, __HIP_MEMORY_SCOPE_AGENT); }
        asm volatile("s_waitcnt vmcnt(0)" ::: "memory");
        if (tid < 256 && lane == 0) __hip_atomic_fetch_add(cnt + 64 * u.pm, 1u, __ATOMIC_RELAXED, __HIP_MEMORY_SCOPE_AGENT);
        if (wid == 0) { unsigned sp = 0;
            while ((unsigned)__builtin_amdgcn_readfirstlane(__hip_atomic_load(cnt + 64 * u.pm, __ATOMIC_RELAXED, __HIP_MEMORY_SCOPE_AGENT)) < 16u) { __builtin_amdgcn_s_sleep(2); if (++sp > (1u << 20)) break; }
            __builtin_amdgcn_fence(__ATOMIC_ACQUIRE, "agent"); }
        asm volatile("s_waitcnt vmcnt(0) lgkmcnt(0)" ::: "memory"); __builtin_amdgcn_s_barrier(); asm volatile("" ::: "memory");
        if (tid < 256) { const unsigned* q = (const unsigned*)xb + (size_t)(u.pm * BM + tid) * 4; float t = 0.f;
#pragma unroll
            for (int k = 0; k < 4; ++k) t += __uint_as_float(__hip_atomic_load(q + k, __ATOMIC_RELAXED, __HIP_MEMORY_SCOPE_AGENT));
            S[tid] = 1.0f / sqrtf(t * (1.0f / 1024.0f) + 1e-6f); }
        asm volatile("s_waitcnt vmcnt(0) lgkmcnt(0)" ::: "memory"); __builtin_amdgcn_s_barrier(); asm volatile("" ::: "memory");
        f32x4 gv[2][2];
#pragma unroll
        for (int bj = 0; bj < 2; ++bj)
#pragma unroll
            for (int n = 0; n < 2; ++n) gv[bj][n] = *(const f32x4*)(gain + col0 + bj * HALF + n * 16);
#pragma unroll
        for (int ai = 0; ai < 2; ++ai)
#pragma unroll
            for (int m = 0; m < 4; ++m) { const int rl = ai * HALF + wr * 64 + m * 16 + fr; const size_t off = (size_t)(u.pm * BM + rl) * ldc + col0; const float rs = S[rl];
#pragma unroll
                for (int bj = 0; bj < 2; ++bj)
#pragma unroll
                    for (int n = 0; n < 2; ++n) { const f32x4 o = acc[ai][bj][m][n] * rs * gv[bj][n];
                        if (outn) *(f32x4*)(outn + off + bj * HALF + n * 16) = o;
                        if (xn) { v2u w; w.x = cvt_pk_bf16(o[0], o[1]); w.y = cvt_pk_bf16(o[2], o[3]); *(v2u*)(xn + off + bj * HALF + n * 16) = w; } } }
    }
};
struct EpiCmp {
    static constexpr bool PERM = true, AFTER_DRAIN = true;
    const float* peb; const bf16_t* w2t; bf16_t* ckv;
    __device__ __forceinline__ void fused(f32x4 (&acc)[2][2][4][2], const Unit& u, int wr, int wc, int fr, int fq, LAS unsigned char* lds, int wid, int lane) const {
        const int kv = u.tag >> 1, g = u.tag & 1, col0 = wc * 32 + 8 * fq;
#pragma unroll
        for (int bj = 0; bj < 2; ++bj) { float pb[8];
#pragma unroll
            for (int e = 0; e < 8; ++e) pb[e] = peb[kv * 256 + bj * HALF + col0 + e];
#pragma unroll
            for (int ai = 0; ai < 2; ++ai)
#pragma unroll
                for (int m = 0; m < 4; ++m) { const int row = ai * HALF + wr * 64 + m * 16 + fr, chunk = bj * 16 + wc * 4 + fq; float v[8];
#pragma unroll
                    for (int e = 0; e < 4; ++e) { v[e] = acc[ai][bj][m][0][e] + pb[e]; v[4 + e] = acc[ai][bj][m][1][e] + pb[4 + e]; }
#pragma unroll
                    for (int e = 0; e < 8; ++e) v[e] = v[e] * __builtin_amdgcn_rcpf(1.0f + __builtin_amdgcn_exp2f(-v[e] * 1.4426950408889634f));
                    v4u w; w.x = cvt_pk_bf16(v[0], v[1]); w.y = cvt_pk_bf16(v[2], v[3]); w.z = cvt_pk_bf16(v[4], v[5]); w.w = cvt_pk_bf16(v[6], v[7]);
                    *(LAS v4u*)(lds + row * 512 + ((chunk ^ (row & 15)) * 16)) = w; } }
        asm volatile("s_waitcnt lgkmcnt(0)" ::: "memory"); __builtin_amdgcn_s_barrier(); asm volatile("" ::: "memory");
        typedef float f32x16_t __attribute__((ext_vector_type(16)));
        const int r32 = lane & 31, hi = lane >> 5, row = wid * 32 + r32;
        f32x16_t o0, o1;
#pragma unroll
        for (int r = 0; r < 16; ++r) { o0[r] = 0.f; o1[r] = 0.f; }
        const bf16_t* wb = w2t + ((size_t)kv * 64 + r32) * 256 + hi * 8;
#pragma unroll
        for (int ks = 0; ks < 16; ++ks) { const bf16x8 af = *(const LAS bf16x8*)(lds + row * 512 + (((2 * ks + hi) ^ (row & 15)) * 16));
            o0 = __builtin_amdgcn_mfma_f32_32x32x16_bf16(af, *(const bf16x8*)(wb + 16 * ks), o0, 0, 0, 0);
            o1 = __builtin_amdgcn_mfma_f32_32x32x16_bf16(af, *(const bf16x8*)(wb + 32 * 256 + 16 * ks), o1, 0, 0, 0); }
#pragma unroll
        for (int r = 0; r < 16; ++r) { const int rp = u.pm * BM + wid * 32 + (r & 3) + 8 * (r >> 2) + 4 * hi, b = rp >> 7, n = rp & 127;
            bf16_t* o = ckv + ((((size_t)kv * NB + b) * 2 + g) * 128 + n) * 64 + r32;
            o[0] = f2bf(n == 127 ? 0.f : o0[r]); o[32] = f2bf(n == 127 ? 0.f : o1[r]); }
    }
};

template <class Epi, class Sched, bool ALIGN_EPI = false, bool SP2 = false>
__device__ __forceinline__ void gemm_phase(LAS unsigned char* lds, const Gemm g, const Sched& S, const Epi& E) {
    const int tid = fresh_tid(), wid = __builtin_amdgcn_readfirstlane(tid >> 6), lane = tid & 63, wr = wid >> 2, wc = wid & 3, fr = lane & 15, fq = lane >> 4;
    const int K = g.K, nt = K / BK;
    unsigned voffA[2], voffB[2];
#pragma unroll
    for (int i = 0; i < 2; ++i) { int R, C; stage_rc(tid * 16 + i * 8192, R, C); const int Rb = Epi::PERM ? ((R & ~31) + perm32(R & 31)) : R;
        voffA[i] = (unsigned)(R * g.lda + C) * 2u; voffB[i] = (unsigned)(Rb * g.ldb + C) * 2u; }
    const size_t kstepA = (size_t)g.kstepA, kstepB = (size_t)g.kstepB;
    const size_t hstepA = (size_t)HALF * g.lda * 2, hstepB = (size_t)HALF * g.ldb * 2;
    const unsigned ldsw = (unsigned)wid * 1024u;
    const int aoff = lds_byte(wr * 64 + fr, fq * 8), boff = lds_byte(wc * 32 + fr, fq * 8);
#define PG8_SA(b, h) (((b) * 2 + (h)) * HTB)
#define PG8_SB(b, h) ((4 + (b) * 2 + (h)) * HTB)
#define PG8_STAGE(bufoff, gbase, voff) do { _Pragma("unroll") for (int _i = 0; _i < 2; ++_i) \
        __builtin_amdgcn_global_load_lds((const unsigned*)((const char*)(gbase) + (voff)[_i]), (LAS unsigned*)(lds + (bufoff) + ldsw + _i * 8192), 16, 0, 0); } while (0)
#define PG8_LDA(dst, b, h) do { _Pragma("unroll") for (int m = 0; m < 4; ++m) _Pragma("unroll") for (int k = 0; k < 2; ++k) dst[m][k] = *(const LAS bf16x8*)(lds + PG8_SA(b, h) + aoff + m * 2048 + k * 1024); } while (0)
#define PG8_LDB(dst, b, h) do { _Pragma("unroll") for (int n = 0; n < 2; ++n) _Pragma("unroll") for (int k = 0; k < 2; ++k) dst[n][k] = *(const LAS bf16x8*)(lds + PG8_SB(b, h) + boff + n * 2048 + k * 1024); } while (0)
#define PG8_MMA(ai, bj, At, Bt) do { __builtin_amdgcn_s_setprio(1); _Pragma("unroll") for (int m = 0; m < 4; ++m) _Pragma("unroll") for (int n = 0; n < 2; ++n) _Pragma("unroll") for (int k = 0; k < 2; ++k) \
        acc[ai][bj][m][n] = __builtin_amdgcn_mfma_f32_16x16x32_bf16(Bt[n][k], At[m][k], acc[ai][bj][m][n], 0, 0, 0); __builtin_amdgcn_s_setprio(0); } while (0)
#define PG8_WAIT_V(n) asm volatile("s_waitcnt vmcnt(" #n ")" ::: "memory")
#define PG8_WAIT_L(n) asm volatile("s_waitcnt lgkmcnt(" #n ")" ::: "memory")
#define PG8_BAR __builtin_amdgcn_s_barrier()
#define PG8_SCHED __builtin_amdgcn_sched_barrier(0)
    Unit cur, nxt; int ui = 0;
    if (!S.next(0, cur)) return;
    f32x4 acc[2][2][4][2];
#pragma unroll
    for (int a = 0; a < 2; ++a)
#pragma unroll
        for (int b = 0; b < 2; ++b)
#pragma unroll
            for (int m = 0; m < 4; ++m)
#pragma unroll
                for (int n = 0; n < 2; ++n) acc[a][b][m][n] = (f32x4){0.f, 0.f, 0.f, 0.f};
    bf16x8 At[4][2], B0[2][2], B1[2][2];
    const char* cA = cur.A; const char* cB = cur.B;
    S.a_ready(cur);
    static_assert(SP2, "only the two-super-phase loop is kept in this file");
    {
        PG8_STAGE(PG8_SB(0, 0), cB, voffB); PG8_STAGE(PG8_SB(0, 1), cB + hstepB, voffB); PG8_STAGE(PG8_SA(0, 0), cA, voffA); PG8_STAGE(PG8_SA(0, 1), cA + hstepA, voffA);
        if (wr == 1) PG8_BAR;
        PG8_WAIT_V(2); PG8_BAR;
        PG8_STAGE(PG8_SB(1, 0), cB + kstepB, voffB); PG8_STAGE(PG8_SA(1, 0), cA + kstepA, voffA); PG8_STAGE(PG8_SB(1, 1), cB + hstepB + kstepB, voffB);
        PG8_WAIT_V(6); PG8_BAR;
    }
    for (;;) {
        const bool has_next = S.next(ui + 1, nxt);
        const char* nA = has_next ? nxt.A : cA; const char* nB = has_next ? nxt.B : cB;
        for (int t = 0; t < nt; t += 2) {
            const bool last = (t == nt - 2);
            const char* a1 = cA + (size_t)(t + 1) * kstepA;
            const char* a2 = last ? nA : cA + (size_t)(t + 2) * kstepA; const char* b2 = last ? nB : cB + (size_t)(t + 2) * kstepB;
            const char* a3 = a2 + kstepA; const char* b3 = b2 + kstepB;
            if (last && has_next) S.a_ready(nxt);
            PG8_LDB(B0, 0, 0); PG8_LDB(B1, 0, 1); PG8_SCHED; PG8_LDA(At, 0, 0); PG8_STAGE(PG8_SA(1, 1), a1 + hstepA, voffA);
            PG8_WAIT_V(8); PG8_WAIT_L(0); PG8_BAR; PG8_MMA(0, 0, At, B0); PG8_MMA(0, 1, At, B1); PG8_BAR; PG8_SCHED;
            PG8_LDA(At, 0, 1); PG8_STAGE(PG8_SB(0, 0), b2, voffB); PG8_STAGE(PG8_SB(0, 1), b2 + hstepB, voffB); PG8_STAGE(PG8_SA(0, 0), a2, voffA);
            PG8_WAIT_V(8); PG8_WAIT_L(0); PG8_BAR; PG8_MMA(1, 0, At, B0); PG8_MMA(1, 1, At, B1); PG8_BAR; PG8_SCHED;
            PG8_LDB(B0, 1, 0); PG8_LDB(B1, 1, 1); PG8_SCHED; PG8_LDA(At, 1, 0); PG8_STAGE(PG8_SA(0, 1), a2 + hstepA, voffA);
            PG8_WAIT_V(8); PG8_WAIT_L(0); PG8_BAR; PG8_MMA(0, 0, At, B0); PG8_MMA(0, 1, At, B1); PG8_BAR; PG8_SCHED;
            PG8_LDA(At, 1, 1); PG8_STAGE(PG8_SB(1, 0), b3, voffB); PG8_STAGE(PG8_SB(1, 1), b3 + hstepB, voffB); PG8_STAGE(PG8_SA(1, 0), a3, voffA);
            PG8_WAIT_V(8); PG8_WAIT_L(0); PG8_BAR; PG8_MMA(1, 0, At, B0); PG8_MMA(1, 1, At, B1); PG8_BAR; PG8_SCHED;
        }
        if constexpr (ALIGN_EPI) { if (wr == 0) PG8_BAR; }
        if constexpr (!Epi::AFTER_DRAIN) { E(acc, cur, wr, wc, fr, fq); S.done(cur); }
        if (!has_next) break;
#pragma unroll
        for (int a = 0; a < 2; ++a)
#pragma unroll
            for (int b = 0; b < 2; ++b)
#pragma unroll
                for (int m = 0; m < 4; ++m)
#pragma unroll
                    for (int n = 0; n < 2; ++n) acc[a][b][m][n] = (f32x4){0.f, 0.f, 0.f, 0.f};
        cur = nxt; cA = nA; cB = nB; ++ui;
        if constexpr (ALIGN_EPI) { if (wr == 1) PG8_BAR; }
    }
    PG8_WAIT_V(0);
    if constexpr (!ALIGN_EPI) { if (wr == 0) PG8_BAR; }
    PG8_BAR;
    if constexpr (Epi::AFTER_DRAIN) { E.fused(acc, cur, wr, wc, fr, fq, lds, wid, lane); S.done(cur); }
#undef PG8_SA
#undef PG8_SB
#undef PG8_STAGE
#undef PG8_LDA
#undef PG8_LDB
#undef PG8_MMA
#undef PG8_WAIT_V
#undef PG8_WAIT_L
#undef PG8_BAR
#undef PG8_SCHED
}
}

constexpr int NWAVES = 8, LDS_BYTES = 147456;
__device__ __forceinline__ float wave_sum(float v) {
#pragma unroll
    for (int o = 1; o < 64; o <<= 1) v += __shfl_xor(v, o);
    return v;
}
template <bool PERM>
__device__ __forceinline__ void p0_transpose_item(const float* W, int K, int N, int NP, bf16_t* WT, LAS float* scr, int item, int lane, const float* ksc = nullptr) {
    const int nblk = NP / 32, kb = item / nblk, nb = item % nblk, k0 = 64 * kb, n0 = 32 * nb;
    int ncol = n0 + (lane & 7) * 4; if (PERM) ncol = nsa_col_orig(ncol);
    f32x4 v[8];
#pragma unroll
    for (int i = 0; i < 8; ++i) { const int kk = 8 * i + (lane >> 3); v[i] = ncol >= 0 ? *(const f32x4*)(W + (size_t)(k0 + kk) * N + ncol) : (f32x4){0.f, 0.f, 0.f, 0.f}; if (ksc) v[i] = v[i] * ksc[k0 + kk]; }
#pragma unroll
    for (int i = 0; i < 8; ++i) { const int kk = 8 * i + (lane >> 3); LAS float* d = scr + kk * 33 + (lane & 7) * 4; d[0] = v[i][0]; d[1] = v[i][1]; d[2] = v[i][2]; d[3] = v[i][3]; }
    LDS_WAIT(); asm volatile("" ::: "memory");
    const int c = lane & 7;
#pragma unroll
    for (int j = 0; j < 4; ++j) { const int n = (lane >> 3) + 8 * j; const LAS float* s = scr + (8 * c) * 33 + n;
        v4u o; o.x = pk2(s[0 * 33], s[1 * 33]); o.y = pk2(s[2 * 33], s[3 * 33]); o.z = pk2(s[4 * 33], s[5 * 33]); o.w = pk2(s[6 * 33], s[7 * 33]);
        *(v4u*)(WT + (size_t)(n0 + n) * K + k0 + 8 * c) = o; }
    LDS_WAIT(); asm volatile("" ::: "memory");
}
__device__ __forceinline__ void rms_row_to_bf16(const float* xrow, const float* g, bf16_t* orow, int lane) {
    const f32x4* xr = (const f32x4*)xrow + lane; const f32x4* gr = (const f32x4*)g + lane;
    f32x4 v[4]; float s = 0.f;
#pragma unroll
    for (int j = 0; j < 4; ++j) { v[j] = xr[64 * j]; s += (v[j].x * v[j].x + v[j].y * v[j].y) + (v[j].z * v[j].z + v[j].w * v[j].w); }
    const float rs = 1.f / sqrtf(wave_sum(s) * (1.f / 1024.f) + EPS);
    unsigned long long* o8 = (unsigned long long*)orow + lane;
#pragma unroll
    for (int j = 0; j < 4; ++j) { const f32x4 gg = g ? gr[64 * j] : (f32x4){1.f, 1.f, 1.f, 1.f};
        o8[64 * j] = (unsigned long long)pk2(v[j].x * rs * gg.x, v[j].y * rs * gg.y) | ((unsigned long long)pk2(v[j].z * rs * gg.z, v[j].w * rs * gg.w) << 32); }
}
__device__ __forceinline__ void rms_rows4_to_bf16(const float* x, const float* g, bf16_t* o, int m0, int stride, int nrows, int lane) {
    f32x4 v[4][4];
#pragma unroll
    for (int k = 0; k < 4; ++k) { const int m = m0 + k * stride; if (m < nrows) {
#pragma unroll
        for (int j = 0; j < 4; ++j) v[k][j] = ((const f32x4*)(x + (size_t)m * 1024) + lane)[64 * j]; } }
    f32x4 gg[4];
#pragma unroll
    for (int j = 0; j < 4; ++j) gg[j] = g ? ((const f32x4*)g + lane)[64 * j] : (f32x4){1.f, 1.f, 1.f, 1.f};
#pragma unroll
    for (int k = 0; k < 4; ++k) { const int m = m0 + k * stride; if (m < nrows) { float s = 0.f;
#pragma unroll
        for (int j = 0; j < 4; ++j) s += (v[k][j].x * v[k][j].x + v[k][j].y * v[k][j].y) + (v[k][j].z * v[k][j].z + v[k][j].w * v[k][j].w);
        const float rs = 1.f / sqrtf(wave_sum(s) * (1.f / 1024.f) + EPS);
        unsigned long long* o8 = (unsigned long long*)(o + (size_t)m * 1024) + lane;
#pragma unroll
        for (int j = 0; j < 4; ++j) o8[64 * j] = (unsigned long long)pk2(v[k][j].x * rs * gg[j].x, v[k][j].y * rs * gg[j].y) | ((unsigned long long)pk2(v[k][j].z * rs * gg[j].z, v[k][j].w * rs * gg[j].w) << 32); } }
}
__device__ __forceinline__ void rms_row_inplace(float* xrow, const float* g, int lane) {
    f32x4* xr = (f32x4*)xrow + lane; const f32x4* gr = (const f32x4*)g + lane;
    f32x4 v[4]; float s = 0.f;
#pragma unroll
    for (int j = 0; j < 4; ++j) { v[j] = xr[64 * j]; s += (v[j].x * v[j].x + v[j].y * v[j].y) + (v[j].z * v[j].z + v[j].w * v[j].w); }
    const float rs = 1.f / sqrtf(wave_sum(s) * (1.f / 1024.f) + EPS);
#pragma unroll
    for (int j = 0; j < 4; ++j) xr[64 * j] = v[j] * rs * gr[64 * j];
}

typedef float f32x16 __attribute__((ext_vector_type(16)));
typedef short s16x4 __attribute__((ext_vector_type(4)));
typedef short v4i16_t __attribute__((ext_vector_type(4)));
#define MFMA32(a, b, c) __builtin_amdgcn_mfma_f32_32x32x16_bf16(a, b, c, 0, 0, 0)
constexpr float LOG2E = 1.4426950408889634f, LN2 = 0.6931471805599453f;
__device__ __forceinline__ int crow(int r, int hi) { return (r & 3) + 8 * (r >> 2) + 4 * hi; }
__device__ __forceinline__ s16x4 vtr(const LAS unsigned char* p) { return __builtin_bit_cast(s16x4, __builtin_amdgcn_ds_read_tr16_b64_v4i16((LAS v4i16_t*)p)); }
__device__ __forceinline__ float xmax32(float v) { auto rr = __builtin_amdgcn_permlane32_swap(__float_as_uint(v), __float_as_uint(v), false, false); return fmaxf(__uint_as_float(rr[0]), __uint_as_float(rr[1])); }
__device__ __forceinline__ float xsum32(float v) { auto rr = __builtin_amdgcn_permlane32_swap(__float_as_uint(v), __float_as_uint(v), false, false); return __uint_as_float(rr[0]) + __uint_as_float(rr[1]); }
__device__ __forceinline__ float ex2(float x) { return __builtin_amdgcn_exp2f(x); }
__device__ __forceinline__ float sigm_(float x) { return __builtin_amdgcn_rcpf(1.0f + ex2(-x * LOG2E)); }
__device__ __forceinline__ bf16x8 pack8(const f32x16& v, int r0) {
    v4u w; w.x = pg8::cvt_pk_bf16(v[r0], v[r0 + 1]); w.y = pg8::cvt_pk_bf16(v[r0 + 2], v[r0 + 3]); w.z = pg8::cvt_pk_bf16(v[r0 + 4], v[r0 + 5]); w.w = pg8::cvt_pk_bf16(v[r0 + 6], v[r0 + 7]);
    return __builtin_bit_cast(bf16x8, w);
}
__device__ __forceinline__ bf16x8 vfrag(const LAS unsigned char* p) { const s16x4 a = vtr(p), b = vtr(p + 512); return (bf16x8){a[0], a[1], a[2], a[3], b[0], b[1], b[2], b[3]}; }

struct KVRegs { v4u k, v; };
__device__ __forceinline__ KVRegs kv_load(const bf16_t* Kg, const bf16_t* Vg, int ld, int tid) {
    const int key = (tid & 7) + 8 * (tid >> 6), ch = (tid >> 3) & 7;
    KVRegs r; r.k = *(const v4u*)(Kg + (size_t)key * ld + ch * 8); r.v = *(const v4u*)(Vg + (size_t)key * ld + ch * 8); return r;
}
__device__ __forceinline__ void kv_store(LAS unsigned char* buf, const KVRegs& r, int tid) {
    const int key = (tid & 7) + 8 * (tid >> 6), ch = (tid >> 3) & 7;
    *(LAS v4u*)(buf + ch * 1024 + key * 16) = r.k;
    *(LAS v4u*)(buf + 8192 + (ch >> 2) * 4096 + key * 64 + (ch & 3) * 16) = r.v;
}
struct Sm64 { f32x16 o[2]; float m, l; };
__device__ __forceinline__ void sm64_init(Sm64& st) {
#pragma unroll
    for (int r = 0; r < 16; ++r) { st.o[0][r] = 0.f; st.o[1][r] = 0.f; }
    st.m = -1e30f; st.l = 0.f;
}
__device__ __forceinline__ void qk64(f32x16& s0, f32x16& s1, const bf16x8 (&qf)[4], const LAS unsigned char* buf, int r32, int hi, float kbs = 0.f) {
    const LAS unsigned char* kp = buf + hi * 1024 + r32 * 16;
    const float kbh = kbs * (float)(4 * hi);
#pragma unroll
    for (int r = 0; r < 16; ++r) { s0[r] = fmaf(kbs, (float)((r & 3) + 8 * (r >> 2)), kbh); s1[r] = s0[r]; }
#pragma unroll
    for (int d0 = 0; d0 < 4; ++d0) { const bf16x8 k0 = *(const LAS bf16x8*)(kp + d0 * 2048), k1 = *(const LAS bf16x8*)(kp + d0 * 2048 + 512);
        s0 = MFMA32(k0, qf[d0], s0); s1 = MFMA32(k1, qf[d0], s1); }
}
__device__ __forceinline__ void pv64(f32x16 (&o)[2], const f32x16& p0, const f32x16& p1, const LAS unsigned char* buf, int lane, int hi) {
    const bf16x8 pf0 = pack8(p0, 0), pf1 = pack8(p0, 8), pf2 = pack8(p1, 0), pf3 = pack8(p1, 8);
    const LAS unsigned char* vp = buf + 8192 + ((lane >> 4) & 1) * 32 + (lane & 3) * 8 + (4 * hi + ((lane & 15) >> 2)) * 64;
#pragma unroll
    for (int dt = 0; dt < 2; ++dt) {
        o[dt] = MFMA32(vfrag(vp + dt * 4096), pf0, o[dt]); o[dt] = MFMA32(vfrag(vp + dt * 4096 + 1024), pf1, o[dt]);
        o[dt] = MFMA32(vfrag(vp + dt * 4096 + 2048), pf2, o[dt]); o[dt] = MFMA32(vfrag(vp + dt * 4096 + 3072), pf3, o[dt]);
    }
}
typedef float f32x2 __attribute__((ext_vector_type(2)));
template <int MODE>
__device__ __forceinline__ void tile64(Sm64& st, const bf16x8 (&qf)[4], const LAS unsigned char* buf, int lane, float c2, float kbs, float off, float off32, int lim, int lo) {
    const int r32 = lane & 31, hi = lane >> 5;
    f32x16 s0, s1; qk64(s0, s1, qf, buf, r32, hi, kbs);
    if (MODE != 0) {
        const int l0 = lim - 4 * hi, l1 = lim - 32 - 4 * hi, g0 = lo - 4 * hi, g1 = lo - 32 - 4 * hi;
#pragma unroll
        for (int r = 0; r < 16; ++r) { const int kc = (r & 3) + 8 * (r >> 2);
            const bool v0 = (kc <= l0) && (MODE == 1 || kc >= g0), v1 = (kc <= l1) && (MODE == 1 || kc >= g1);
            s0[r] = v0 ? s0[r] : -INFINITY; s1[r] = v1 ? s1[r] : -INFINITY; }
    }
    float m0 = fmaxf(s0[0], s0[1]), m1 = fmaxf(s1[0], s1[1]);
#pragma unroll
    for (int r = 2; r < 16; r += 2) { m0 = fmaxf(fmaxf(m0, s0[r]), s0[r + 1]); m1 = fmaxf(fmaxf(m1, s1[r]), s1[r + 1]); }
    const float mx = xmax32(fmaxf(fmaf(m0, c2, off), fmaf(m1, c2, off32)));
    const float mn = fmaxf(st.m, mx), al = ex2(st.m - mn);
    const f32x2 c2v = {c2, c2}, d0 = {off - mn, off - mn}, d1 = {off32 - mn, off32 - mn};
    f32x2 sum2 = {0.f, 0.f};
#pragma unroll
    for (int r = 0; r < 16; r += 2) { f32x2 a = {s0[r], s0[r + 1]}, b = {s1[r], s1[r + 1]};
        a = __builtin_elementwise_fma(a, c2v, d0); b = __builtin_elementwise_fma(b, c2v, d1);
        a.x = ex2(a.x); a.y = ex2(a.y); b.x = ex2(b.x); b.y = ex2(b.y);
        sum2 = sum2 + a; sum2 = sum2 + b;
        s0[r] = a.x; s0[r + 1] = a.y; s1[r] = b.x; s1[r + 1] = b.y; }
    const float sum = xsum32(sum2.x + sum2.y);
    st.l = st.l * al + sum; st.m = mn;
    const f32x2 alv = {al, al};
#pragma unroll
    for (int r = 0; r < 16; r += 2) { f32x2 a = {st.o[0][r], st.o[0][r + 1]}, b = {st.o[1][r], st.o[1][r + 1]}; a = a * alv; b = b * alv;
        st.o[0][r] = a.x; st.o[0][r + 1] = a.y; st.o[1][r] = b.x; st.o[1][r + 1] = b.y; }
    pv64(st.o, s0, s1, buf, lane, hi);
}

struct NsaPre { KVRegs c0, c1; bf16x8 qf[4]; float gl0, gl1, gl2; };
__device__ __forceinline__ void nsa_prefetch(NsaPre& n, const Params& p, int unit, int tid) {
    const int lane = tid & 63, r32 = lane & 31, hi = lane >> 5, w = __builtin_amdgcn_readfirstlane(tid >> 6);
    const int q32 = unit & 63, g = (unit >> 6) & 1, b = unit >> 7, hidx = g * 8 + w; const size_t trow = (size_t)b * SEQ + q32 * 32 + r32;
    const bf16_t* Q1 = (const bf16_t*)(p.ws + OFF_Q1); const bf16_t* gate = (const bf16_t*)(p.ws + OFF_GATE); const bf16_t* ckv = (const bf16_t*)(p.ws + OFF_CMPKV);
    const bf16_t* kc = ckv + (((size_t)0 * NB + b) * 2 + g) * 128 * 64; const bf16_t* vc = ckv + (((size_t)1 * NB + b) * 2 + g) * 128 * 64;
    n.c0 = kv_load(kc, vc, 64, tid); n.c1 = kv_load(kc + 64 * 64, vc + 64 * 64, 64, tid);
#pragma unroll
    for (int d0 = 0; d0 < 4; ++d0) n.qf[d0] = *(const bf16x8*)(Q1 + trow * 1024 + hidx * 64 + d0 * 16 + hi * 8);
    n.gl0 = bf2f(gate[trow * 256 + hidx * 3 + 0]); n.gl1 = bf2f(gate[trow * 256 + hidx * 3 + 1]); n.gl2 = bf2f(gate[trow * 256 + hidx * 3 + 2]);
}
template <unsigned NOPT>
__device__ __forceinline__ void nsa_unit(const Params& p, LAS unsigned char* lds, int unit, const NsaPre& pre, bool has_next, int next_unit, NsaPre& nxt) {
    const int tid = fresh_tid(), lane = tid & 63, r32 = lane & 31, hi = lane >> 5, w = __builtin_amdgcn_readfirstlane(tid >> 6);
    const int q32 = unit & 63, g = (unit >> 6) & 1, b = unit >> 7;
    const int q0 = q32 * 32, cur = q0 >> 6, hidx = g * 8 + w, s = q0 + r32;
    const size_t trow = (size_t)b * SEQ + s;
    const bf16_t* KV = (const bf16_t*)(p.ws + OFF_KV1); const bf16_t* Z1 = (const bf16_t*)(p.ws + OFF_Z1); bf16_t* Y1 = (bf16_t*)(p.ws + OFF_Y1);
    const float slope2 = exp2f(-0.5f * (float)(hidx + 1)) * LOG2E, c2 = 0.125f * LOG2E;
    const float kbs = slope2 / c2;
    LAS float* otl = (LAS float*)(lds + 73728); LAS float* impw = otl + w * 1056; LAS float* impt = (LAS float*)(lds + 66560); LAS unsigned* msk = (LAS unsigned*)(lds + 66560 + 4224);
    bf16x8 qf[4];
#pragma unroll
    for (int d0 = 0; d0 < 4; ++d0) qf[d0] = pre.qf[d0];
    const int wlo = (q0 - 511 > 0 ? q0 - 511 : 0) >> 6, nwin = cur - wlo + 1;
    const bf16_t* kvb = KV + (size_t)b * SEQ * 768 + g * 64;
    auto kvw = [&](int i) { const int j = wlo + i; return kv_load(kvb + (size_t)64 * j * 768 + 512, kvb + (size_t)64 * j * 768 + 640, 768, tid); };
    KVRegs ra0, ra1;
    ra0 = kvw(0); if (nwin > 1) ra1 = kvw(1);
    kv_store(lds, pre.c0, tid); kv_store(lds + 16384, pre.c1, tid);
    const float g0 = sigm_(pre.gl0), g2 = sigm_(pre.gl2);
    __syncthreads();
    f32x16 oc[2];
    {
        if (NOPT & 4u) {
#pragma unroll
            for (int r = 0; r < 16; ++r) { oc[0][r] = 0.f; oc[1][r] = 0.f; }
        } else {
        f32x16 sc[4]; qk64(sc[0], sc[1], qf, lds, r32, hi); qk64(sc[2], sc[3], qf, lds + 16384, r32, hi);
        float mx = -INFINITY;
#pragma unroll
        for (int T = 0; T < 4; ++T)
#pragma unroll
            for (int r = 0; r < 16; ++r) { const int n = 32 * T + crow(r, hi), dist = s - (16 * n + 31);
                const float v = dist >= 0 ? fmaf(sc[T][r], c2, -slope2 * (float)dist) : -INFINITY; sc[T][r] = v; mx = fmaxf(mx, v); }
        mx = fmaxf(xmax32(mx), -1e30f);
        float sum = 0.f;
#pragma unroll
        for (int T = 0; T < 4; ++T)
#pragma unroll
            for (int r = 0; r < 16; ++r) { sc[T][r] = ex2(sc[T][r] - mx); sum += sc[T][r]; }
        sum = xsum32(sum);
        const float inv = sum > 0.f ? 1.0f / sum : 0.f;
        float prev_y = 0.f;
#pragma unroll
        for (int T = 0; T < 4; ++T)
#pragma unroll
            for (int c = 0; c < 4; ++c) { const float x3 = sc[T][4 * c + 3], y = __shfl_xor(x3, 32);
                const float sum4 = (sc[T][4 * c] + sc[T][4 * c + 1]) + (sc[T][4 * c + 2] + x3);
                impw[r32 * 33 + 8 * T + 2 * c + hi] = (sum4 + (hi ? y : prev_y)) * inv; prev_y = y; }
#pragma unroll
        for (int r = 0; r < 16; ++r) { oc[0][r] = 0.f; oc[1][r] = 0.f; }
        pv64(oc, sc[0], sc[1], lds, lane, hi); pv64(oc, sc[2], sc[3], lds + 16384, lane, hi);
        const float f0 = g0 * inv;
#pragma unroll
        for (int r = 0; r < 16; ++r) { oc[0][r] *= f0; oc[1][r] *= f0; }
        }
    }
    kv_store(lds + 2 * 16384, ra0, tid); if (nwin > 1) kv_store(lds + 3 * 16384, ra1, tid);
    if (nwin > 2) ra0 = kvw(2);
    if (nwin > 3) ra1 = kvw(3);
    __syncthreads();
    for (int idx = tid; idx < 1024; idx += 512) { float a = 0.f;
#pragma unroll
        for (int ww = 0; ww < 8; ++ww) a += otl[ww * 1056 + (idx >> 5) * 33 + (idx & 31)];
        impt[(idx >> 5) * 33 + (idx & 31)] = a; }
    __syncthreads();
    {
        const int nf = cur == 0 ? 1 : (cur == 1 ? 2 : 3), need = 8 - nf;
#pragma unroll
        for (int pi = 0; pi < 2; ++pi) {
            const int q = pi * 16 + 2 * w + hi, j = r32; bool sel;
            if (j == 0 || j == cur || j == cur - 1) sel = true;
            else if (!(NOPT & 8u) && j <= cur - 2) { const float v = impt[q * 33 + j]; int rank = 0;
#pragma unroll
                for (int j2 = 1; j2 < 30; ++j2) { const float v2 = impt[q * 33 + j2]; rank += (j2 <= cur - 2 && j2 != j && (v2 > v || (v2 == v && j2 < j))) ? 1 : 0; }
                sel = rank < need; }
            else sel = false;
            const unsigned long long bal = __ballot(sel);
            if (lane == 0) msk[pi * 16 + 2 * w] = (unsigned)bal;
            if (lane == 32) msk[pi * 16 + 2 * w + 1] = (unsigned)(bal >> 32);
        }
    }
#pragma unroll
    for (int r = 0; r < 16; ++r) { otl[r * 512 + tid] = oc[0][r]; otl[(16 + r) * 512 + tid] = oc[1][r]; }
    __syncthreads();
    const unsigned mymask = msk[r32];
    unsigned uni = mymask;
#pragma unroll
    for (int o = 1; o < 32; o <<= 1) uni |= (unsigned)__shfl_xor((int)uni, o);
    uni = (unsigned)__builtin_amdgcn_readfirstlane((int)uni);
    const int nslc = __builtin_popcount(uni), ntile = nwin + nslc;
    unsigned rem_l = uni, rem_c = uni;
    auto tile_j = [&](int i, unsigned& rem) { int j; if (i < nwin) j = wlo + i; else { j = __builtin_ctz(rem); rem &= rem - 1; } return j; };
    auto kvl = [&](int i, unsigned& rem) { const int j = tile_j(i, rem); const int col = i < nwin ? 512 : 256; return kv_load(kvb + (size_t)64 * j * 768 + col, kvb + (size_t)64 * j * 768 + col + 128, 768, tid); };
    if (nwin <= 1) { const KVRegs r1 = kvl(1, rem_l); kv_store(lds + 3 * 16384, r1, tid); }
    if (nwin <= 2 && 2 < ntile) ra0 = kvl(2, rem_l);
    if (nwin <= 3 && 3 < ntile) ra1 = kvl(3, rem_l);
    if (nwin <= 1) __syncthreads();
    Sm64 st; sm64_init(st);
    auto do_tile = [&](int i) {
        const int j = tile_j(i, rem_c); const LAS unsigned char* buf = lds + ((i + 2) & 3) * 16384;
        if (NOPT & 1u) return;
        const float off = slope2 * (float)(64 * j - s), off32 = off + 32.0f * slope2;
        if (i < nwin) {
            if (64 * j + 63 <= q0 && 64 * j >= q0 - 480) tile64<0>(st, qf, buf, lane, c2, kbs, off, off32, 0, 0);
            else tile64<2>(st, qf, buf, lane, c2, kbs, off, off32, s - 64 * j, s - 511 - 64 * j);
            if (i == nwin - 1) { const float f2 = g2 / st.l;
#pragma unroll
                for (int r = 0; r < 16; ++r) { otl[r * 512 + tid] += st.o[0][r] * f2; otl[(16 + r) * 512 + tid] += st.o[1][r] * f2; }
                sm64_init(st); }
        } else { const bool has = (mymask >> j) & 1u; const float offh = has ? off : -INFINITY, offh32 = has ? off32 : -INFINITY;
            if (j < cur) tile64<0>(st, qf, buf, lane, c2, kbs, offh, offh32, 0, 0);
            else tile64<1>(st, qf, buf, lane, c2, kbs, offh, offh32, s - 64 * j, 0);
        }
    };
    for (int i = 0; i < ((NOPT & 2u) ? 0 : ntile); i += 2) {
        if (i > 0) { if (i + 2 < ntile) ra0 = kvl(i + 2, rem_l); if (i + 3 < ntile) ra1 = kvl(i + 3, rem_l); }
        do_tile(i);
        if (i + 1 < ntile) do_tile(i + 1);
        if (i + 2 < ntile) kv_store(lds + (i & 3) * 16384, ra0, tid);
        if (i + 3 < ntile) kv_store(lds + ((i + 1) & 3) * 16384, ra1, tid);
        __syncthreads();
    }
    const int tid2 = fresh_tid(), hi2 = (tid2 >> 5) & 1, hidx2 = g * 8 + __builtin_amdgcn_readfirstlane(tid2 >> 6); const size_t trow2 = (size_t)b * SEQ + q0 + (tid2 & 31);
    nsa_prefetch(nxt, p, has_next ? next_unit : unit, tid2);
    f32x16 ot[2];
    { const float f1 = sigm_(bf2f(((const bf16_t*)(p.ws + OFF_GATE))[trow2 * 256 + hidx2 * 3 + 1])) / st.l;
#pragma unroll
      for (int r = 0; r < 16; ++r) { ot[0][r] = otl[r * 512 + tid2] + st.o[0][r] * f1; ot[1][r] = otl[(16 + r) * 512 + tid2] + st.o[1][r] * f1; } }
    if (!(NOPT & 16u))
#pragma unroll
    for (int dt = 0; dt < 2; ++dt)
#pragma unroll
        for (int c = 0; c < 4; ++c) { const int d = 32 * dt + 8 * c + 4 * hi2;
            const v2u zz = *(const v2u*)(Z1 + trow2 * 1024 + hidx2 * 64 + d);
            const float z0 = lo16(zz.x), z1 = hi16(zz.x), z2 = lo16(zz.y), z3 = hi16(zz.y);
            const float y0 = ot[dt][4 * c] * z0, y1 = ot[dt][4 * c + 1] * z1, y2 = ot[dt][4 * c + 2] * z2, y3 = ot[dt][4 * c + 3] * z3;
            v2u o2; o2.x = pg8::cvt_pk_bf16(y0, y1); o2.y = pg8::cvt_pk_bf16(y2, y3);
            *(v2u*)(Y1 + trow2 * 1280 + hidx2 * 64 + d) = o2; }
}

__device__ __forceinline__ void mem_unit(const bf16_t* mkv, const bf16_t* QMb, const bf16_t* ZMb, bf16_t* Y, int ldy, LAS unsigned char* lds, int unit) {
    const int tid = fresh_tid(), lane = tid & 63, r32 = lane & 31, hi = lane >> 5, w = __builtin_amdgcn_readfirstlane(tid >> 6);
    const int qc = unit & 7, h = (unit >> 3) & 3, b = unit >> 5;
    const size_t trow = (size_t)b * SEQ + qc * 256 + w * 32 + r32;
    const bf16_t* kb = mkv + (size_t)b * NMEM * 512 + h * 64;
#pragma unroll
    for (int t = 0; t < 4; ++t) { const KVRegs r = kv_load(kb + (size_t)t * 64 * 512, kb + (size_t)t * 64 * 512 + 256, 512, tid); kv_store(lds + t * 16384, r, tid); }
    bf16x8 qf[4];
#pragma unroll
    for (int d0 = 0; d0 < 4; ++d0) qf[d0] = *(const bf16x8*)(QMb + trow * 256 + h * 64 + d0 * 16 + hi * 8);
    __syncthreads();
    Sm64 st; sm64_init(st);
#pragma unroll 1
    for (int t = 0; t < 4; ++t) tile64<0>(st, qf, lds + t * 16384, lane, 0.125f * LOG2E, 0.f, 0.f, 0.f, 0, 0);
    const float inv = 1.0f / st.l;
#pragma unroll
    for (int dt = 0; dt < 2; ++dt)
#pragma unroll
        for (int c = 0; c < 4; ++c) { const int d = 32 * dt + 8 * c + 4 * hi;
            const v2u zz = *(const v2u*)(ZMb + trow * 256 + h * 64 + d);
            const float z0 = lo16(zz.x), z1 = hi16(zz.x), z2 = lo16(zz.y), z3 = hi16(zz.y);
            const float y0 = st.o[dt][4 * c] * inv * z0, y1 = st.o[dt][4 * c + 1] * inv * z1, y2 = st.o[dt][4 * c + 2] * inv * z2, y3 = st.o[dt][4 * c + 3] * inv * z3;
            v2u o2; o2.x = pg8::cvt_pk_bf16(y0, y1); o2.y = pg8::cvt_pk_bf16(y2, y3);
            *(v2u*)(Y + trow * ldy + h * 64 + d) = o2; }
    __syncthreads();
}

__device__ __forceinline__ void dil_task(const Params& p, LAS unsigned char* wl  , int task, int lane, bool dry = false) {
    const int r32 = lane & 31, hi = lane >> 5;
    const int grp = task >> 11, idx = task & 2047, dil = grp == 0 ? 1 : (grp == 1 ? 4 : 16), lg = grp * 2, nq = 64 >> lg;
    const int qi = idx & (nq - 1), rest = idx >> (6 - lg), h = rest & 3, brho = rest >> 2, b = brho >> lg, rho = brho & (dil - 1);
    const int hh = grp * 4 + h, i0 = 32 * qi, isub = i0 + r32;
    bf16_t* Q = (bf16_t*)(p.ws + OFF_Q); const bf16_t* K = (const bf16_t*)(p.ws + OFF_K); const bf16_t* V = (const bf16_t*)(p.ws + OFF_V); float* LSE = (float*)(p.ws + OFF_LSE);
    const size_t base = (size_t)b * SEQ + rho;
    const size_t trow = base + (size_t)isub * dil;
    const float slope2 = exp2f(-8.0f * (float)(hh + 1) / 12.0f) * (float)dil * LOG2E, c2 = 0.08838834764831845f * LOG2E;
    bf16x8 qf[8];
#pragma unroll
    for (int d0 = 0; d0 < 8; ++d0) qf[d0] = *(const bf16x8*)(Q + trow * 1536 + hh * 128 + d0 * 16 + hi * 8);
    f32x16 o[4]; float m = -1e30f, l = 0.f;
#pragma unroll
    for (int dt = 0; dt < 4; ++dt)
#pragma unroll
        for (int r = 0; r < 16; ++r) o[dt][r] = 0.f;
    LAS unsigned char* kl = wl; LAS unsigned char* vl = wl + 8192;
    const LAS unsigned char* vp = vl + ((lane >> 4) & 1) * 32 + (lane & 3) * 8 + (4 * hi + ((lane & 15) >> 2)) * 64;
    const int jt0 = qi - 4 > 0 ? qi - 4 : 0;
    v4u kr[8], vr[8];
    const int ekey = lane >> 4, ech = lane & 15;
#define DIL_LOAD(jt_) do { _Pragma("unroll") for (int it = 0; it < 8; ++it) { const size_t go = (base + (size_t)(32 * (jt_) + 4 * it + ekey) * dil) * 1536 + hh * 128 + ech * 8; \
        kr[it] = *(const v4u*)(K + go); vr[it] = *(const v4u*)(V + go); } } while (0)
    DIL_LOAD(jt0);
    for (int jt = jt0; jt <= qi; ++jt) {
        asm volatile("s_waitcnt lgkmcnt(0)" ::: "memory");
#pragma unroll
        for (int it = 0; it < 8; ++it) { const int key = 4 * it + ekey;
            *(LAS v4u*)(kl + key * 256 + ((ech ^ (key & 15)) * 16)) = kr[it];
            *(LAS v4u*)(vl + (ech >> 2) * 2048 + key * 64 + (ech & 3) * 16) = vr[it]; }
        if (jt < qi) DIL_LOAD(jt + 1);
        asm volatile("s_waitcnt lgkmcnt(0)" ::: "memory");
        f32x16 sc;
#pragma unroll
        for (int r = 0; r < 16; ++r) sc[r] = 0.f;
#pragma unroll
        for (int d0 = 0; d0 < 8; ++d0) { const bf16x8 kf = *(const LAS bf16x8*)(kl + r32 * 256 + (((2 * d0 + hi) ^ (r32 & 15)) * 16)); sc = MFMA32(kf, qf[d0], sc); }
        float mx = -INFINITY;
#pragma unroll
        for (int r = 0; r < 16; ++r) { const int dist = isub - (32 * jt + crow(r, hi));
            const float v = (dist >= 0 && dist <= 128) ? fmaf(sc[r], c2, -slope2 * (float)dist) : -INFINITY; sc[r] = v; mx = fmaxf(mx, v); }
        mx = xmax32(mx);
        const float mn = fmaxf(m, mx), al = ex2(m - mn);
        float sum = 0.f;
#pragma unroll
        for (int r = 0; r < 16; ++r) { sc[r] = ex2(sc[r] - mn); sum += sc[r]; }
        sum = xsum32(sum); l = l * al + sum; m = mn;
#pragma unroll
        for (int dt = 0; dt < 4; ++dt)
#pragma unroll
            for (int r = 0; r < 16; ++r) o[dt][r] *= al;
        const bf16x8 pf0 = pack8(sc, 0), pf1 = pack8(sc, 8);
#pragma unroll
        for (int dt = 0; dt < 4; ++dt) { o[dt] = MFMA32(vfrag(vp + dt * 2048), pf0, o[dt]); o[dt] = MFMA32(vfrag(vp + dt * 2048 + 1024), pf1, o[dt]); }
    }
#undef DIL_LOAD
    const float inv = 1.0f / l;
#pragma unroll
    for (int dt = 0; dt < 4; ++dt)
#pragma unroll
        for (int c = 0; c < 4; ++c) { const int d = 32 * dt + 8 * c + 4 * hi;
            v2u o2; o2.x = pg8::cvt_pk_bf16(o[dt][4 * c] * inv, o[dt][4 * c + 1] * inv); o2.y = pg8::cvt_pk_bf16(o[dt][4 * c + 2] * inv, o[dt][4 * c + 3] * inv);
            if (!dry) *(v2u*)(Q + trow * 1536 + hh * 128 + d) = o2; else asm volatile("" :: "v"(o2.x), "v"(o2.y)); }
    if (hi == 0 && !dry) LSE[((size_t)grp * T_ + trow) * 4 + h] = (m + __builtin_amdgcn_logf(l)) * LN2;
}

__device__ __forceinline__ void lru_unit(const Params& p, LAS unsigned char* lds, int unit) {
    const int tid = fresh_tid(), lane = tid & 63, r32 = lane & 31, hi = lane >> 5, w = __builtin_amdgcn_readfirstlane(tid >> 6);
    const int hh = unit & 1, blk = (unit >> 1) & 15, b = unit >> 5;
    const int cj = blk * 64 + hh * 32 + r32;
    const bf16_t* xaza = (const bf16_t*)p.out; bf16_t* Y0 = (bf16_t*)(p.ws + OFF_Y0);
    LAS float* cw = (LAS float*)lds; LAS float* tot = (LAS float*)(lds + 2048); LAS float* xcs = (LAS float*)(lds + 8192 + w * 8704);
    LAS unsigned char* xst = lds + 77824; LAS unsigned char* zst = lds + 115200 + w * 2048;
    if (tid < 256) cw[tid] = p.conv_w[(tid >> 6) * 1024 + blk * 64 + (tid & 63)]; else if (tid < 320) cw[tid] = p.conv_b[blk * 64 + tid - 256];
    bf16x8 wa[4], wx[4];
#pragma unroll
    for (int ks = 0; ks < 4; ++ks) { float fa[8], fx[8];
#pragma unroll
        for (int jj = 0; jj < 8; ++jj) { const size_t wi = (size_t)blk * 4096 + (size_t)(16 * ks + 8 * hi + jj) * 64 + hh * 32 + r32; fa[jj] = p.ga_w[wi]; fx[jj] = p.gx_w[wi]; }
        v4u a4, x4; a4.x = pg8::cvt_pk_bf16(fa[0], fa[1]); a4.y = pg8::cvt_pk_bf16(fa[2], fa[3]); a4.z = pg8::cvt_pk_bf16(fa[4], fa[5]); a4.w = pg8::cvt_pk_bf16(fa[6], fa[7]);
        x4.x = pg8::cvt_pk_bf16(fx[0], fx[1]); x4.y = pg8::cvt_pk_bf16(fx[2], fx[3]); x4.z = pg8::cvt_pk_bf16(fx[4], fx[5]); x4.w = pg8::cvt_pk_bf16(fx[6], fx[7]);
        wa[ks] = __builtin_bit_cast(bf16x8, a4); wx[ks] = __builtin_bit_cast(bf16x8, x4); }
    const float ba = p.ga_b[cj], bx = p.gx_b[cj], sp8 = -8.0f * log1pf(expf(-p.lam[cj]));
    v4u xr[5], zr[2];
#define LRU_LOAD(c_) do { const int t0c_ = (c_) * 256; \
        _Pragma("unroll") for (int i = 0; i < 5; ++i) { const int e = tid + 512 * i, row = e >> 3, tt = t0c_ - 3 + row; xr[i] = (v4u){0u, 0u, 0u, 0u}; \
            if (e < 2072 && tt >= 0) xr[i] = *(const v4u*)(xaza + ((size_t)b * SEQ + tt) * 2048 + blk * 64 + (e & 7) * 8); } \
        _Pragma("unroll") for (int i = 0; i < 2; ++i) { const int e = lane + 64 * i; zr[i] = *(const v4u*)(xaza + ((size_t)b * SEQ + t0c_ + w * 32 + (e >> 2)) * 2048 + 1024 + blk * 64 + hh * 32 + (e & 3) * 8); } } while (0)
    LRU_LOAD(0);
    float hchunk = 0.f;
#pragma unroll 1
    for (int c = 0; c < 8; ++c) {
        const int t0 = c * 256 + w * 32;
        const size_t rowb = (size_t)b * SEQ + t0;
#pragma unroll
        for (int i = 0; i < 5; ++i) { const int e = tid + 512 * i; if (e < 2072) *(LAS v4u*)(xst + (e >> 3) * 144 + (e & 7) * 16) = xr[i]; }
#pragma unroll
        for (int i = 0; i < 2; ++i) { const int e = lane + 64 * i; *(LAS v4u*)(zst + (e >> 2) * 64 + (e & 3) * 16) = zr[i]; }
        __syncthreads();
        if (c < 7) LRU_LOAD(c + 1);
        bf16x8 af[4];
#pragma unroll
        for (int ks = 0; ks < 4; ++ks) { const int i0 = 16 * ks + 8 * hi; float acc[8];
            { const f32x4 b0 = *(const LAS f32x4*)(cw + 256 + i0), b1 = *(const LAS f32x4*)(cw + 256 + i0 + 4); acc[0] = b0[0]; acc[1] = b0[1]; acc[2] = b0[2]; acc[3] = b0[3]; acc[4] = b1[0]; acc[5] = b1[1]; acc[6] = b1[2]; acc[7] = b1[3]; }
#pragma unroll
            for (int k = 0; k < 4; ++k) { const v4u v = *(const LAS v4u*)(xst + (w * 32 + r32 + k) * 144 + i0 * 2);
                const f32x4 w0 = *(const LAS f32x4*)(cw + k * 64 + i0), w1 = *(const LAS f32x4*)(cw + k * 64 + i0 + 4);
                acc[0] += w0[0] * lo16(v.x); acc[1] += w0[1] * hi16(v.x); acc[2] += w0[2] * lo16(v.y); acc[3] += w0[3] * hi16(v.y);
                acc[4] += w1[0] * lo16(v.z); acc[5] += w1[1] * hi16(v.z); acc[6] += w1[2] * lo16(v.w); acc[7] += w1[3] * hi16(v.w); }
            *(LAS f32x4*)(xcs + r32 * 68 + i0) = (f32x4){acc[0], acc[1], acc[2], acc[3]}; *(LAS f32x4*)(xcs + r32 * 68 + i0 + 4) = (f32x4){acc[4], acc[5], acc[6], acc[7]};
            v4u pk; pk.x = pg8::cvt_pk_bf16(acc[0], acc[1]); pk.y = pg8::cvt_pk_bf16(acc[2], acc[3]); pk.z = pg8::cvt_pk_bf16(acc[4], acc[5]); pk.w = pg8::cvt_pk_bf16(acc[6], acc[7]);
            af[ks] = __builtin_bit_cast(bf16x8, pk); }
        f32x16 ra, rx;
#pragma unroll
        for (int r = 0; r < 16; ++r) { ra[r] = 0.f; rx[r] = 0.f; }
#pragma unroll
        for (int ks = 0; ks < 4; ++ks) { ra = MFMA32(af[ks], wa[ks], ra); rx = MFMA32(af[ks], wx[ks], rx); }
        asm volatile("s_waitcnt lgkmcnt(0)" ::: "memory");
        float a[16], u[16];
#pragma unroll
        for (int r = 0; r < 16; ++r) { const int tl = crow(r, hi); const float xc = xcs[tl * 68 + hh * 32 + r32];
            const float rg = sigm_(ra[r] + ba), ig = sigm_(rx[r] + bx), la = sp8 * rg;
            a[r] = ex2(la * LOG2E);
            const float om = fmaf(-a[r], a[r], 1.0f);
            const float mult = (t0 + tl == 0) ? 1.0f : __builtin_amdgcn_sqrtf(om);
            u[r] = xc * ig * mult; }
        float EA[8], EU[8];
#pragma unroll
        for (int cg = 0; cg < 4; ++cg) { const int r0 = 4 * cg;
            const float GA = (a[r0] * a[r0 + 1]) * (a[r0 + 2] * a[r0 + 3]), GU = ((u[r0] * a[r0 + 1] + u[r0 + 1]) * a[r0 + 2] + u[r0 + 2]) * a[r0 + 3] + u[r0 + 3];
            const float PA = __shfl_xor(GA, 32), PU = __shfl_xor(GU, 32);
            EA[2 * cg] = hi ? PA : GA; EU[2 * cg] = hi ? PU : GU; EA[2 * cg + 1] = hi ? GA : PA; EU[2 * cg + 1] = hi ? GU : PU; }
        float TA = 1.f, TU = 0.f;
#pragma unroll
        for (int g = 0; g < 8; ++g) { TU = EA[g] * TU + EU[g]; TA *= EA[g]; }
        LAS float* tt2 = tot + (c & 1) * 512;
        if (hi == 0) { tt2[(w * 32 + r32) * 2] = TA; tt2[(w * 32 + r32) * 2 + 1] = TU; }
        __syncthreads();
        float h = hchunk, hin = 0.f;
#pragma unroll
        for (int ww = 0; ww < 8; ++ww) { if (ww == w) hin = h; h = tt2[(ww * 32 + r32) * 2] * h + tt2[(ww * 32 + r32) * 2 + 1]; }
        hchunk = h;
        float hown[4], hg = hin;
#pragma unroll
        for (int g = 0; g < 8; ++g) { if ((g & 1) == hi) hown[g >> 1] = hg; hg = EA[g] * hg + EU[g]; }
        LAS bf16_t* zy = (LAS bf16_t*)zst;
#pragma unroll
        for (int cg = 0; cg < 4; ++cg) { float hc = hown[cg];
#pragma unroll
            for (int q = 0; q < 4; ++q) { const int r = 4 * cg + q; hc = a[r] * hc + u[r];
                const int tl = crow(r, hi); const float z = bf2f(zy[tl * 32 + r32]); zy[tl * 32 + r32] = f2bf(hc * z); } }
        asm volatile("s_waitcnt lgkmcnt(0)" ::: "memory");
#pragma unroll
        for (int i = 0; i < 2; ++i) { const int e = lane + 64 * i; const v4u yv = *(const LAS v4u*)(zst + (e >> 2) * 64 + (e & 3) * 16);
            *(v4u*)(Y0 + (rowb + (e >> 2)) * 1792 + blk * 64 + hh * 32 + (e & 3) * 8) = yv; }
        asm volatile("s_waitcnt lgkmcnt(0)" ::: "memory");
    }
#undef LRU_LOAD
    __syncthreads();
}

__device__ __forceinline__ void cmp1_task(const Params& p, int task, int lane) {
    const int r32 = lane & 31, hi = lane >> 5;
    const int ct = task & 7, rt = (task >> 3) & 3, g = (task >> 5) & 1, b = (task >> 6) & 7, kv = task >> 9;
    const bf16_t* KV = (const bf16_t*)(p.ws + OFF_KV1); const bf16_t* w1 = (const bf16_t*)(p.ws + OFF_PHIW1) + (size_t)kv * 256 * 2048; bf16_t* hid = (bf16_t*)(p.ws + OFF_CMPH);
    const float* peb = (const float*)(p.ws + OFF_PEB) + kv * 256;
    const int n = rt * 32 + r32;
    const bf16_t* ar = KV + ((size_t)b * SEQ + 16 * n) * 768 + kv * 128 + g * 64 + hi * 8;
    const bf16_t* br = w1 + (size_t)(ct * 32 + r32) * 2048 + hi * 8;
    f32x16 acc;
#pragma unroll
    for (int r = 0; r < 16; ++r) acc[r] = 0.f;
#pragma unroll 4
    for (int i = 0; i < 32; ++i) {
#pragma unroll
        for (int q = 0; q < 4; ++q) { const bf16x8 af = *(const bf16x8*)(ar + (size_t)i * 768 + 16 * q), bf = *(const bf16x8*)(br + i * 64 + 16 * q); acc = MFMA32(af, bf, acc); }
    }
    float pb = 0.f;
#pragma unroll 8
    for (int c = 0; c < 64; ++c) pb += peb[c * 512 + ct * 32 + r32];
    const size_t rowbase = (((size_t)kv * NB + b) * 2 + g) * 128 + rt * 32;
#pragma unroll
    for (int r = 0; r < 16; ++r) { const float v = acc[r] + pb; hid[(rowbase + crow(r, hi)) * 256 + ct * 32 + r32] = f2bf(v * sigm_(v)); }
}
__device__ __forceinline__ void cmp2_task(const Params& p, int task, int lane) {
    const int r32 = lane & 31, hi = lane >> 5;
    const int dtile = task & 1, rt = (task >> 1) & 63, kv = task >> 7;
    const bf16_t* hid = (const bf16_t*)(p.ws + OFF_CMPH) + ((size_t)kv * 2048 + rt * 32 + r32) * 256 + hi * 8;
    const bf16_t* w2 = (const bf16_t*)(p.ws + OFF_PHIW2) + ((size_t)kv * 64 + dtile * 32 + r32) * 256 + hi * 8;
    bf16_t* ckv = (bf16_t*)(p.ws + OFF_CMPKV) + ((size_t)kv * 2048 + rt * 32) * 64 + dtile * 32 + r32;
    f32x16 acc;
#pragma unroll
    for (int r = 0; r < 16; ++r) acc[r] = 0.f;
#pragma unroll
    for (int ks = 0; ks < 16; ++ks) acc = MFMA32(*(const bf16x8*)(hid + 16 * ks), *(const bf16x8*)(w2 + 16 * ks), acc);
#pragma unroll
    for (int r = 0; r < 16; ++r) { const int row = rt * 32 + crow(r, hi); ckv[(size_t)crow(r, hi) * 64] = f2bf((row & 127) == 127 ? 0.f : acc[r]); }
}

__device__ __forceinline__ void memkv_task(const Params& p, int task, int lane) {
    const int r32 = lane & 31, hi = lane >> 5;
    const int ct = task & 15, rt = (task >> 4) & 63, l = task >> 10;
    const float* ar = p.mem + (size_t)(rt * 32 + r32) * DM + hi * 8;
    const bf16_t* br = (const bf16_t*)(p.ws + OFF_WMKV) + ((size_t)l * 512 + ct * 32 + r32) * DM + hi * 8;
    bf16_t* mkv = (bf16_t*)(p.ws + OFF_MEMKV) + (size_t)l * NB * NMEM * 512;
    f32x16 acc; float ss = 0.f;
#pragma unroll
    for (int r = 0; r < 16; ++r) acc[r] = 0.f;
#pragma unroll 4
    for (int ks = 0; ks < DM / 16; ++ks) { const f32x4 x0 = *(const f32x4*)(ar + 16 * ks), x1 = *(const f32x4*)(ar + 16 * ks + 4);
        ss += (x0[0] * x0[0] + x0[1] * x0[1]) + (x0[2] * x0[2] + x0[3] * x0[3]) + (x1[0] * x1[0] + x1[1] * x1[1]) + (x1[2] * x1[2] + x1[3] * x1[3]);
        v4u pk; pk.x = pg8::cvt_pk_bf16(x0[0], x0[1]); pk.y = pg8::cvt_pk_bf16(x0[2], x0[3]); pk.z = pg8::cvt_pk_bf16(x1[0], x1[1]); pk.w = pg8::cvt_pk_bf16(x1[2], x1[3]);
        acc = MFMA32(__builtin_bit_cast(bf16x8, pk), *(const bf16x8*)(br + 16 * ks), acc); }
    ss = xsum32(ss);
    const float rs = 1.0f / sqrtf(ss * (1.0f / DM) + EPS);
#pragma unroll
    for (int r = 0; r < 16; ++r) { const float rr = __shfl(rs, crow(r, hi)); mkv[(size_t)(rt * 32 + crow(r, hi)) * 512 + ct * 32 + r32] = f2bf(acc[r] * rr); }
}

#define XB_TMO      128
#define XB_XCNT(j)  (256  + 64 * (j))
#define XB_XSUB(j)  (1280 + 64 * (j))
#define XB_XGEN(j)  (2304 + 64 * (j))
#define XB_TOP      3328
#define XB_TOPGEN   3392
#define XCD_BAR_WORDS 3456
#define XB_SPIN_CAP (1u << 18)
__device__ __forceinline__ unsigned xb_ld(unsigned* p)              { return __hip_atomic_load(p, __ATOMIC_RELAXED, __HIP_MEMORY_SCOPE_AGENT); }
__device__ __forceinline__ unsigned xb_add(unsigned* p, unsigned v) { return __hip_atomic_fetch_add(p, v, __ATOMIC_RELAXED, __HIP_MEMORY_SCOPE_AGENT); }
__device__ __forceinline__ unsigned xb_xcc_id() { return (unsigned)__builtin_amdgcn_s_getreg((3 << 11) | 20) & 0xFu; }
#define XB_SPIN(cond, bar) do { unsigned _sp = 0; while (cond) { __builtin_amdgcn_s_sleep(1); \
    if ((++_sp & 255u) == 0u) { if (xb_ld(&(bar)[XB_TMO])) break; if (_sp > XB_SPIN_CAP) { atomicAdd(&(bar)[XB_TMO], 1u); break; } } } } while (0)
struct XcdBarrier { unsigned* bar; unsigned x; volatile LAS unsigned* st; };
__device__ __forceinline__ XcdBarrier xcd_barrier_post(unsigned* bar, volatile LAS unsigned* st) {
    XcdBarrier b; b.bar = bar; b.x = xb_xcc_id(); b.st = st;
    if (threadIdx.x == 0) (void)xb_add(&bar[XB_XCNT(b.x)], 1u);
    return b;
}
__device__ __forceinline__ void xcd_barrier_complete(unsigned* bar, unsigned x, unsigned& nloc, unsigned& nx) {
    const unsigned G = gridDim.x * gridDim.y * gridDim.z;
    unsigned sum, cnt, mine, sp = 0u;
    for (;;) {
        sum = 0u; cnt = 0u; mine = 0u;
#pragma unroll
        for (unsigned j = 0; j < 16; ++j) { const unsigned c = xb_ld(&bar[XB_XCNT(j)]); sum += c; cnt += (c > 0u) ? 1u : 0u; mine = (j == x) ? c : mine; }
        if (sum == G) break;
        __builtin_amdgcn_s_sleep(1);
        if ((++sp & 255u) == 0u) { if (xb_ld(&bar[XB_TMO])) break; if (sp > XB_SPIN_CAP) { atomicAdd(&bar[XB_TMO], 1u); break; } }
    }
    nloc = mine > 0u ? mine : 1u; nx = cnt > 0u ? cnt : 1u;
}
__device__ __forceinline__ void xcd_barrier(const XcdBarrier& b) {
    asm volatile("s_waitcnt vmcnt(0)" ::: "memory");
    __syncthreads();
    if (threadIdx.x == 0) {
        unsigned* bar = b.bar;
        __builtin_amdgcn_s_waitcnt(0);
        unsigned nloc = b.st[0], nx = b.st[1];
        if (nloc == 0u) { xcd_barrier_complete(bar, b.x, nloc, nx); b.st[0] = nloc; b.st[1] = nx; }
        const unsigned old = xb_add(&bar[XB_XSUB(b.x)], 1u);
        const unsigned gen = old / nloc;
        if (old + 1u == (gen + 1u) * nloc) {
            __builtin_amdgcn_fence(__ATOMIC_RELEASE, "agent");
            asm volatile("s_waitcnt vmcnt(0)" ::: "memory");
            const unsigned og = xb_add(&bar[XB_TOP], 1u);
            const unsigned tg = og / nx;
            if (og + 1u == (tg + 1u) * nx) xb_add(&bar[XB_TOPGEN], 1u);
            else XB_SPIN(xb_ld(&bar[XB_TOPGEN]) == tg, bar);
            __builtin_amdgcn_fence(__ATOMIC_ACQUIRE, "agent");
            xb_add(&bar[XB_XGEN(b.x)], 1u);
            asm volatile("s_waitcnt vmcnt(0)" ::: "memory");
        } else {
            XB_SPIN(xb_ld(&bar[XB_XGEN(b.x)]) == gen, bar);
            __builtin_amdgcn_fence(__ATOMIC_ACQUIRE, "agent");
            asm volatile("s_waitcnt vmcnt(0)" ::: "memory");
        }
    }
    __syncthreads();
}
#define GSYNC() xcd_barrier(bar)

__device__ __forceinline__ int fresh_tid() { int t = threadIdx.x; asm volatile("" : "+v"(t)); return t; }
#ifndef PROBE_REP
#define PROBE_REP -1
#endif
#define REP(k) for (int rep_ = 0; rep_ < ((PROBE_REP == (k)) ? 2 : 1); ++rep_)
#define PH_IDS() const int tid = fresh_tid(), lane = tid & 63, wave = __builtin_amdgcn_readfirstlane(tid >> 6); const long gt = (long)blockIdx.x * 512 + tid, nt = (long)G * 512; \
    const int gw = blockIdx.x * NWAVES + wave, NGW = G * NWAVES; (void)lane; (void)gt; (void)nt; (void)gw; (void)NGW
__device__ __forceinline__ Params load_params() {
    Params p{};
#if defined(__HIP_DEVICE_COMPILE__)
    typedef const __attribute__((address_space(4))) unsigned long long* kq_t;
    kq_t k = (kq_t)__builtin_amdgcn_kernarg_segment_ptr(); asm volatile("" : "+s"(k));
    unsigned long long* d = (unsigned long long*)&p;
#pragma unroll
    for (int i = 0; i < (int)(sizeof(Params) / 8); ++i) d[i] = k[i];
#endif
    return p;
}
#define PP() const Params p = load_params()
#ifndef PROBE_SKIP
#define PROBE_SKIP 0
#endif
#ifndef PROBE_TWICE
#define PROBE_TWICE 0
#endif
template <unsigned SKIP>
__global__ void __launch_bounds__(NWAVES * 64, 2) mega(Params p_unused_arg) {
    extern __shared__ __attribute__((aligned(16))) unsigned char lds_raw[];
    LAS unsigned char* lds = (LAS unsigned char*)lds_raw;
    const int G = gridDim.x;
    if (threadIdx.x < 4) ((LAS unsigned*)(lds + LDS_BYTES - 64))[threadIdx.x] = 0u;
    __syncthreads();
    XcdBarrier bar; { PP(); bar.bar = (unsigned*)(p.ws + OFF_CTRL); } bar.x = xb_xcc_id(); bar.st = (volatile LAS unsigned*)(lds + LDS_BYTES - 64);
    if (threadIdx.x == 0) bar.st[2] = xb_add(&bar.bar[XB_XCNT(bar.x)], 1u);

#define RUN(k) if constexpr (!((SKIP >> (k)) & 1u))
    {
    RUN(0) {
        PP(); PH_IDS();
        LAS float* scr = (LAS float*)(lds + wave * 16384);
        constexpr int I0 = (DM / 64) * (HAWK_IN / 32), I5 = (DM / 64) * (512 / 32);
        for (int it = gw; it < I0 + 2 * I5; it += NGW) {
            int r = it;
            if (r < I0) { p0_transpose_item<false>(p.hawk_w_in, DM, HAWK_IN, HAWK_IN, (bf16_t*)(p.ws + OFF_W0IN), scr, r, lane); continue; } r -= I0;
            if (r < I5) { p0_transpose_item<false>(p.hawk_w_mem_kv, DM, 512, 512, (bf16_t*)(p.ws + OFF_WMKV), scr, r, lane, p.hawk_mem_norm); continue; } r -= I5;
            p0_transpose_item<false>(p.nsa_w_mem_kv, DM, 512, 512, (bf16_t*)(p.ws + OFF_WMKV) + 512 * DM, scr, r, lane, p.nsa_mem_norm);
        }
        for (int m = gw; m < T_; m += 4 * NGW) rms_rows4_to_bf16(p.x, p.hawk_norm, (bf16_t*)(p.ws + OFF_XN), m, NGW, T_, lane);
        for (int m = gw; m < NB * NMEM; m += NGW) rms_row_to_bf16(p.mem + (size_t)m * DM, nullptr, (bf16_t*)(p.ws + OFF_MEMN) + (size_t)m * DM, lane);
    }
    GSYNC();
    if (threadIdx.x == 0) { bool even = (G % 8) == 0;
        for (unsigned j = 0; j < 16; ++j) { const unsigned c = xb_ld(&bar.bar[XB_XCNT(j)]); even = even && (c == (j < 8 ? (unsigned)G / 8u : 0u)); }
        bar.st[3] = even ? bar.st[2] * 8u + bar.x : blockIdx.x; }
    __syncthreads();
    const int vcu = (int)bar.st[3];
    RUN(2) { PP(); pg8::Gemm g{DM, DM, DM, 128, 128}; pg8::StaticOrder S; S.init((const bf16_t*)(p.ws + OFF_XN), (const bf16_t*)(p.ws + OFF_W0IN), T_, HAWK_IN, DM, G, vcu);
      S.extra((const bf16_t*)(p.ws + OFF_MEMN), (const bf16_t*)(p.ws + OFF_WMKV), NB * NMEM, 1024);
      pg8::EpiRoute E{p.ws, (bf16_t*)p.out, 0};
      pg8::gemm_phase<pg8::EpiRoute, pg8::StaticOrder, true, true>(lds, g, S, E); }
    RUN(1) {
        PP(); PH_IDS();
        constexpr int NU = (T_ / 256) * (HAWK_IN / 256) + 32;
        const int first_idle = (G > 0 && (NU % G) != 0) ? (NU % G) : 0, nidle = G - first_idle;
        const int me = vcu - first_idle;
        if (me >= 0) {
            LAS float* scr = (LAS float*)(lds + wave * 16384);
            constexpr int I1 = (HAWK_OUT / 64) * (DM / 32), I2 = (DM / 64) * (NSA_INP / 32), I3 = (NSA_OUT / 64) * (DM / 32), I4 = (2048 / 64) * (256 / 32), I6 = (256 / 64) * (64 / 32);
            for (int it = me * NWAVES + wave; it < I1 + I2 + I3 + 2 * I4 + 2 * I6; it += nidle * NWAVES) {
                int r = it;
                if (r < I1) { p0_transpose_item<false>(p.hawk_w_out, HAWK_OUT, DM, DM, (bf16_t*)(p.ws + OFF_W0OUT), scr, r, lane); continue; } r -= I1;
                if (r < I2) { p0_transpose_item<true>(p.nsa_w_in, DM, NSA_IN, NSA_INP, (bf16_t*)(p.ws + OFF_W1IN), scr, r, lane); continue; } r -= I2;
                if (r < I3) { p0_transpose_item<false>(p.nsa_w_out, NSA_OUT, DM, DM, (bf16_t*)(p.ws + OFF_W1OUT), scr, r, lane); continue; } r -= I3;
                if (r < I4) { p0_transpose_item<false>(p.phik_w1, 2048, 256, 256, (bf16_t*)(p.ws + OFF_PHIW1), scr, r, lane); continue; } r -= I4;
                if (r < I4) { p0_transpose_item<false>(p.phiv_w1, 2048, 256, 256, (bf16_t*)(p.ws + OFF_PHIW1) + 256 * 2048, scr, r, lane); continue; } r -= I4;
                if (r < I6) { p0_transpose_item<false>(p.phik_w2, 256, 64, 64, (bf16_t*)(p.ws + OFF_PHIW2), scr, r, lane); continue; } r -= I6;
                p0_transpose_item<false>(p.phiv_w2, 256, 64, 64, (bf16_t*)(p.ws + OFF_PHIW2) + 64 * 256, scr, r, lane);
            }
            for (int q = me * 512 + tid; q < 32768; q += nidle * 512) { const int o = q & 511, kv = o >> 8, j = o & 255, k0 = (q >> 9) * 32; const float* pe = kv ? p.pe_v : p.pe_k; const float* w1 = kv ? p.phiv_w1 : p.phik_w1; float a = 0.f;
#pragma unroll 8
                for (int k = 0; k < 32; ++k) a += pe[k0 + k] * w1[(size_t)(k0 + k) * 256 + j];
                ((float*)(p.ws + OFF_PEB))[q] = a; }
        }
    }
    GSYNC();
    {
        PP(); PH_IDS();
        if (gw < 512) { float v = ((const float*)(p.ws + OFF_PEB))[lane * 512 + gw]; v = wave_sum(v); if (lane == 0) ((float*)(p.ws + OFF_PEBS))[gw] = v; }
        RUN(3) for (int u = blockIdx.x; u < 256; u += G) lru_unit(p, lds, u);
        RUN(4) for (int task = gw; task < 6144; task += NGW) dil_task(p, lds + wave * 16384, task, lane);
        __syncthreads();
        RUN(5) for (int u = blockIdx.x; u < 256; u += G) mem_unit((const bf16_t*)(p.ws + OFF_MEMKV), (const bf16_t*)(p.ws + OFF_QM), (const bf16_t*)(p.ws + OFF_ZM), (bf16_t*)(p.ws + OFF_Y0) + 1536, 1792, lds, u);
    }
    GSYNC();
    RUN(6) { PP(); PH_IDS();
        const bf16_t* Q = (const bf16_t*)(p.ws + OFF_Q); const bf16_t* ZB = (const bf16_t*)(p.ws + OFF_ZB); const float* LSE = (const float*)(p.ws + OFF_LSE); bf16_t* Y0 = (bf16_t*)(p.ws + OFF_Y0);
        for (long i = gt; i < (long)T_ * 64; i += nt) { const int t = (int)(i >> 6), c8 = ((int)i & 63) * 8, h = c8 >> 7;
            const float l0 = LSE[((size_t)0 * T_ + t) * 4 + h], l1 = LSE[((size_t)1 * T_ + t) * 4 + h], l2 = LSE[((size_t)2 * T_ + t) * 4 + h];
            const float mx = fmaxf(l0, fmaxf(l1, l2)), e0 = __expf(l0 - mx), e1 = __expf(l1 - mx), e2 = __expf(l2 - mx), inv = 1.0f / (e0 + e1 + e2), w0 = e0 * inv, w1 = e1 * inv, w2 = e2 * inv;
            const v4u a = *(const v4u*)(Q + (size_t)t * 1536 + c8), b = *(const v4u*)(Q + (size_t)t * 1536 + 512 + c8), c = *(const v4u*)(Q + (size_t)t * 1536 + 1024 + c8), z = *(const v4u*)(ZB + (size_t)t * 512 + c8);
            v4u o;
#define CMB(f) { o.f = pg8::cvt_pk_bf16((w0 * lo16(a.f) + w1 * lo16(b.f) + w2 * lo16(c.f)) * lo16(z.f), (w0 * hi16(a.f) + w1 * hi16(b.f) + w2 * hi16(c.f)) * hi16(z.f)); }
            CMB(x) CMB(y) CMB(z) CMB(w)
#undef CMB
            *(v4u*)(Y0 + (size_t)t * 1792 + 1024 + c8) = o; } }
    GSYNC();
    if (G == 256) {
    RUN(7) { PP(); pg8::Gemm g{HAWK_OUT, HAWK_OUT, HAWK_OUT, 128, 128}; pg8::StaticOrder S; S.init((const bf16_t*)(p.ws + OFF_Y0), (const bf16_t*)(p.ws + OFF_W0OUT), T_, DM, HAWK_OUT, G, vcu);
      pg8::EpiResidNorm E{p.x, (float*)(p.ws + OFF_X1), nullptr, (bf16_t*)p.out, p.nsa_norm, DM, (float*)(p.ws + OFF_LSE), (unsigned*)(p.ws + OFF_CTRL + 16384)};
      pg8::gemm_phase<pg8::EpiResidNorm, pg8::StaticOrder, false, true>(lds, g, S, E); }
    GSYNC();
    } else {
    RUN(7) { PP(); pg8::Gemm g{HAWK_OUT, HAWK_OUT, HAWK_OUT, 128, 128}; pg8::StaticOrder S; S.init((const bf16_t*)(p.ws + OFF_Y0), (const bf16_t*)(p.ws + OFF_W0OUT), T_, DM, HAWK_OUT, G, vcu);
      pg8::EpiResid E{p.x, (float*)(p.ws + OFF_X1), DM};
      pg8::gemm_phase<pg8::EpiResid, pg8::StaticOrder, true, true>(lds, g, S, E); }
    GSYNC();
    RUN(8) { PP(); PH_IDS(); for (int m = gw; m < T_; m += 4 * NGW) rms_rows4_to_bf16((const float*)(p.ws + OFF_X1), p.nsa_norm, (bf16_t*)p.out, m, NGW, T_, lane); }
    GSYNC();
    }
    RUN(9) { PP(); pg8::Gemm g{DM, DM, DM, 128, 128}; pg8::StaticOrder S; S.init((const bf16_t*)p.out, (const bf16_t*)(p.ws + OFF_W1IN), T_, NSA_INP, DM, G, vcu);
      pg8::EpiRoute E{p.ws, (bf16_t*)p.out, 1};
      pg8::gemm_phase<pg8::EpiRoute, pg8::StaticOrder, true, true>(lds, g, S, E); }
    GSYNC();
    {
        PP();
        if (vcu < 16) {
            RUN(10) { const int kv = vcu >> 3, g = (vcu >> 2) & 1, rt = vcu & 3;
                pg8::Gemm gm{2048, 16 * 768, 2048, 768 * 2, 128}; pg8::OneUnit S; S.have = true; S.u.pm = rt; S.u.pn = 0; S.u.tag = kv * 2 + g;
                S.u.A = (const char*)((const bf16_t*)(p.ws + OFF_KV1) + kv * 128 + g * 64) + (size_t)rt * 256 * (16 * 768) * 2; S.u.B = (const char*)((const bf16_t*)(p.ws + OFF_PHIW1) + (size_t)kv * 256 * 2048);
                pg8::EpiCmp E{(const float*)(p.ws + OFF_PEBS), (const bf16_t*)(p.ws + OFF_PHIW2), (bf16_t*)(p.ws + OFF_CMPKV)};
                pg8::gemm_phase<pg8::EpiCmp, pg8::OneUnit, false, true>(lds, gm, S, E); }
        } else {
            RUN(11) for (int u = vcu - 16; u < 256; u += G - 16) mem_unit((const bf16_t*)(p.ws + OFF_MEMKV) + (size_t)NB * NMEM * 512, (const bf16_t*)(p.ws + OFF_QM1), (const bf16_t*)(p.ws + OFF_ZM1), (bf16_t*)(p.ws + OFF_Y1) + 1024, 1280, lds, u);
        }
    }
    GSYNC();
    RUN(13) { PP();
      if (G == 256) {
          const int ub = (vcu & 7) * 128, sl = vcu >> 3;
          auto uk = [&](int k) { return ub + (k >> 1) * 64 + ((k & 1) ? 63 - sl : sl); };
          NsaPre pre; nsa_prefetch(pre, p, uk(0), fresh_tid());
          for (int k = 0; k < 4; ++k) { NsaPre nxt; nsa_unit<(SKIP >> 16)>(p, lds, uk(k), pre, k < 3, uk(k < 3 ? k + 1 : 3), nxt); pre = nxt; }
      } else {
          NsaPre pre; if ((int)blockIdx.x < 1024) nsa_prefetch(pre, p, blockIdx.x, fresh_tid());
          for (int u = blockIdx.x; u < 1024; u += G) { NsaPre nxt; nsa_unit<(SKIP >> 16)>(p, lds, u, pre, u + G < 1024, u + G, nxt); pre = nxt; } } }
    GSYNC();
    if (G == 256) {
    RUN(14) { PP(); pg8::Gemm g{NSA_OUT, NSA_OUT, NSA_OUT, 128, 128}; pg8::StaticOrder S; S.init((const bf16_t*)(p.ws + OFF_Y1), (const bf16_t*)(p.ws + OFF_W1OUT), T_, DM, NSA_OUT, G, vcu);
      pg8::EpiResidNorm E{(const float*)(p.ws + OFF_X1), nullptr, p.out, nullptr, p.final_norm, DM, (float*)(p.ws + OFF_LSE) + (size_t)T_ * 4, (unsigned*)(p.ws + OFF_CTRL + 16384 + 16384)};
      pg8::gemm_phase<pg8::EpiResidNorm, pg8::StaticOrder, false, true>(lds, g, S, E); }
    } else {
    RUN(14) { PP(); pg8::Gemm g{NSA_OUT, NSA_OUT, NSA_OUT, 128, 128}; pg8::StaticOrder S; S.init((const bf16_t*)(p.ws + OFF_Y1), (const bf16_t*)(p.ws + OFF_W1OUT), T_, DM, NSA_OUT, G, vcu);
      pg8::EpiResid E{(const float*)(p.ws + OFF_X1), p.out, DM};
      pg8::gemm_phase<pg8::EpiResid, pg8::StaticOrder, true, true>(lds, g, S, E); }
    GSYNC();
    RUN(15) { PP(); PH_IDS(); for (int m = gw; m < T_; m += NGW) rms_row_inplace(p.out + (size_t)m * DM, p.final_norm, lane); }
    }
    }
}

extern "C" void kernel_launch(void* const* d_in, const int* in_sizes, int n_in, void* d_out, int out_size, void* d_ws, size_t ws_size, hipStream_t stream) {
    static int grid_blocks = 0;
    if (!grid_blocks) {
        int dev = 0, cus = 0, per_cu = 0;
        (void)hipGetDevice(&dev);
        (void)hipDeviceGetAttribute(&cus, hipDeviceAttributeMultiprocessorCount, dev);
        if (hipFuncSetAttribute((const void*)mega<0u>, hipFuncAttributeMaxDynamicSharedMemorySize, LDS_BYTES) != hipSuccess) fprintf(stderr, "hipFuncSetAttribute failed\n");
#if PROBE_TWICE
        (void)hipFuncSetAttribute((const void*)mega<(unsigned)PROBE_SKIP>, hipFuncAttributeMaxDynamicSharedMemorySize, LDS_BYTES);
#endif
        (void)hipOccupancyMaxActiveBlocksPerMultiprocessor(&per_cu, (const void*)mega<0u>, NWAVES * 64, LDS_BYTES);
        if (per_cu < 1) fprintf(stderr, "occupancy query reports %d blocks per CU\n", per_cu);
        grid_blocks = cus;
        if (ws_size < WS_END) fprintf(stderr, "workspace too small: %zu < %zu\n", ws_size, (size_t)WS_END);
    }
    Params p{};
    const float** f = (const float**)&p;
    for (int i = 0; i < 26; ++i) f[i] = (const float*)d_in[i];
    p.out = (float*)d_out; p.ws = (unsigned char*)d_ws;
    void* args[] = {&p};
#if PROBE_TWICE
    (void)hipMemsetAsync((unsigned char*)d_ws + OFF_CTRL, 0, 16384 + 32768, stream);
    (void)hipLaunchCooperativeKernel((void*)mega<(unsigned)PROBE_SKIP>, dim3(grid_blocks), dim3(NWAVES * 64), args, LDS_BYTES, stream);
#endif
    (void)hipMemsetAsync((unsigned char*)d_ws + OFF_CTRL, 0, 16384 + 32768, stream);
    hipError_t e = hipLaunchCooperativeKernel((void*)mega<0u>, dim3(grid_blocks), dim3(NWAVES * 64), args, LDS_BYTES, stream);
    if (e != hipSuccess) fprintf(stderr, "cooperative launch failed: %s (grid %d)\n", hipGetErrorString(e), grid_blocks);
}
#endif
```
